# Optimizing an MI355X kernel written in HIP

```python
import math
import jax, jax.numpy as jnp
from jax import lax
import numpy as np

D_MODEL = 1024
BATCH = 8
SEQ = 4096
DEPTH = 2

N_MIXERS = 2
N_A_LAYERS = (DEPTH + N_MIXERS - 1) // N_MIXERS
N_B_LAYERS = DEPTH // N_MIXERS

D_FF = 4 * D_MODEL
RMS_EPS = 1e-6
ROPE_THETA = 10000.0
N_MOD = 6

D_RNN = 1280
LRU_BLOCKS = 5
LRU_BLOCK = D_RNN // LRU_BLOCKS
CONV_WIDTH = 4
LRU_C = 8.0

N_HEADS = 16
HEAD_DIM = D_MODEL // N_HEADS
KV_DIM = HEAD_DIM
IDX_HEADS = 8
IDX_DIM = 64
TOPK_MAX = 256
Q_BLOCK = 128
B_WIDTHS = (N_HEADS * HEAD_DIM, KV_DIM, KV_DIM, IDX_HEADS * IDX_DIM, IDX_DIM, IDX_HEADS)
B_IN = sum(B_WIDTHS)
B_SPLITS = tuple(int(v) for v in np.cumsum(B_WIDTHS)[:-1])

kernel_name = "hybrid_rglru_dsa_adaln_trunk"


def rmsnorm(x, g):
    x32 = x.astype(jnp.float32)
    y = x32 * lax.rsqrt(jnp.mean(x32 * x32, axis=-1, keepdims=True) + RMS_EPS)
    return (y * g.astype(jnp.float32)).astype(x.dtype)


def rope_tables(seq, dim):
    inv = ROPE_THETA ** (-jnp.arange(0, dim, 2, dtype=jnp.float32) / dim)
    ang = jnp.arange(seq, dtype=jnp.float32)[:, None] * inv[None, :]
    return jnp.cos(ang), jnp.sin(ang)


def apply_rope(x, cos, sin):
    half = x.shape[-1] // 2
    cos = cos[:, None, :].astype(x.dtype)
    sin = sin[:, None, :].astype(x.dtype)
    x1, x2 = x[..., :half], x[..., half:]
    return jnp.concatenate([x1 * cos - x2 * sin, x2 * cos + x1 * sin], axis=-1)


def rglru_mixer(h, w_in, conv_w, conv_b, wr, br, wi, bi, lam, w_out):
    B, S, _ = h.shape
    u = h @ w_in
    xb, gb = jnp.split(u, 2, axis=-1)
    gate = jax.nn.gelu(gb)
    xc = lax.conv_general_dilated(
        xb, conv_w[:, None, :].astype(xb.dtype), window_strides=(1,),
        padding=[(CONV_WIDTH - 1, 0)], dimension_numbers=("NWC", "WIO", "NWC"),
        feature_group_count=D_RNN) + conv_b
    xr = xc.reshape(B, S, LRU_BLOCKS, LRU_BLOCK)
    r = jax.nn.sigmoid(jnp.einsum("bsnc,ncd->bsnd", xr, wr).reshape(B, S, D_RNN) + br)
    i = jax.nn.sigmoid(jnp.einsum("bsnc,ncd->bsnd", xr, wi).reshape(B, S, D_RNN) + bi)
    log_a = -LRU_C * r.astype(jnp.float32) * jax.nn.softplus(-lam.astype(jnp.float32))
    a = jnp.exp(log_a)
    b = jnp.sqrt(-jnp.expm1(2.0 * log_a)) * (i * xc).astype(jnp.float32)

    def combine(left, right):
        a_l, b_l = left
        a_r, b_r = right
        return a_l * a_r, a_r * b_l + b_r

    _, hs = lax.associative_scan(combine, (a, b), axis=1)
    y = hs.astype(h.dtype) * gate
    return y @ w_out


def dsa_mixer(h, w_in, q_g, k_g, w_out):
    B, S, _ = h.shape
    topk = min(TOPK_MAX, S // 4)
    cos, sin = rope_tables(S, HEAD_DIM)
    cos_i, sin_i = rope_tables(S, IDX_DIM)
    u = h @ w_in
    q, k, v, qi, ki, wi = jnp.split(u, B_SPLITS, axis=-1)
    q = apply_rope(rmsnorm(q.reshape(B, S, N_HEADS, HEAD_DIM), q_g), cos, sin)
    k = apply_rope(rmsnorm(k, k_g)[:, :, None, :], cos, sin)[:, :, 0]
    qi = apply_rope(qi.reshape(B, S, IDX_HEADS, IDX_DIM), cos_i, sin_i)
    ki = apply_rope(ki[:, :, None, :], cos_i, sin_i)[:, :, 0]
    wi = wi * (IDX_HEADS ** -0.5)
    pos = jnp.arange(S)
    nb = S // Q_BLOCK

    def to_blocks(t):
        return t.reshape((B, nb, Q_BLOCK) + t.shape[2:]).swapaxes(0, 1)

    def block_fn(args):
        qb, qib, wib, posb = args
        logits = jnp.einsum("bqhd,bsd->bqhs", qib, ki) * (IDX_DIM ** -0.5)
        score = jnp.einsum("bqh,bqhs->bqs", wib, jax.nn.relu(logits)).astype(jnp.float32)
        causal = pos[None, :] <= posb[:, None]
        score = jnp.where(causal[None], score, -jnp.inf)
        _, idx = lax.top_k(score, topk)
        kg = jax.vmap(lambda kk, ii: kk[ii])(k, idx)
        vg = jax.vmap(lambda vv, ii: vv[ii])(v, idx)
        valid = idx <= posb[None, :, None]
        s = jnp.einsum("bqhd,bqkd->bqhk", qb, kg).astype(jnp.float32) * (HEAD_DIM ** -0.5)
        s = jnp.where(valid[:, :, None, :], s, -jnp.inf)
        p = jax.nn.softmax(s, axis=-1).astype(vg.dtype)
        return jnp.einsum("bqhk,bqkd->bqhd", p, vg)

    out = lax.map(block_fn, (to_blocks(q), to_blocks(qi), to_blocks(wi), pos.reshape(nb, Q_BLOCK)))
    out = out.swapaxes(0, 1).reshape(B, S, N_HEADS * HEAD_DIM)
    return out @ w_out


def setup_inputs(seed: int = 0) -> dict:
    key = jax.random.key(seed)
    ks = iter(jax.random.split(key, 32))
    f32 = jnp.float32

    def nrm(shape, scale):
        return jax.random.normal(next(ks), shape, f32) * scale

    x = nrm((BATCH, SEQ, D_MODEL), 1.0)
    c = nrm((BATCH, D_MODEL), 1.0)
    norm_mix_g = 1.0 + nrm((DEPTH, D_MODEL), 0.02)
    norm_ffn_g = 1.0 + nrm((DEPTH, D_MODEL), 0.02)
    ada_w = nrm((DEPTH, D_MODEL, N_MOD * D_MODEL), D_MODEL ** -0.5)
    ada_b = nrm((DEPTH, N_MOD * D_MODEL), 0.01)
    a_w_in = nrm((N_A_LAYERS, D_MODEL, 2 * D_RNN), D_MODEL ** -0.5)
    a_conv_w = nrm((N_A_LAYERS, CONV_WIDTH, D_RNN), CONV_WIDTH ** -0.5)
    a_conv_b = nrm((N_A_LAYERS, D_RNN), 0.01)
    a_gate_r_w = nrm((N_A_LAYERS, LRU_BLOCKS, LRU_BLOCK, LRU_BLOCK), LRU_BLOCK ** -0.5)
    a_gate_r_b = nrm((N_A_LAYERS, D_RNN), 0.01)
    a_gate_i_w = nrm((N_A_LAYERS, LRU_BLOCKS, LRU_BLOCK, LRU_BLOCK), LRU_BLOCK ** -0.5)
    a_gate_i_b = nrm((N_A_LAYERS, D_RNN), 0.01)
    a_pow = jax.random.uniform(next(ks), (N_A_LAYERS, D_RNN), f32, 0.9, 0.999)
    s = a_pow ** (1.0 / LRU_C)
    a_lambda = jnp.log(s) - jnp.log1p(-s)
    a_w_out = nrm((N_A_LAYERS, D_RNN, D_MODEL), D_RNN ** -0.5)
    b_w_in = nrm((N_B_LAYERS, D_MODEL, B_IN), D_MODEL ** -0.5)
    b_q_norm_g = 1.0 + nrm((N_B_LAYERS, HEAD_DIM), 0.02)
    b_k_norm_g = 1.0 + nrm((N_B_LAYERS, KV_DIM), 0.02)
    b_w_out = nrm((N_B_LAYERS, N_HEADS * HEAD_DIM, D_MODEL), (N_HEADS * HEAD_DIM) ** -0.5)
    ffn_w1 = nrm((DEPTH, D_MODEL, D_FF), D_MODEL ** -0.5)
    ffn_w2 = nrm((DEPTH, D_FF, D_MODEL), D_FF ** -0.5)
    return {"x": x, "c": c, "norm_mix_g": norm_mix_g, "norm_ffn_g": norm_ffn_g,
            "ada_w": ada_w, "ada_b": ada_b, "a_w_in": a_w_in, "a_conv_w": a_conv_w,
            "a_conv_b": a_conv_b, "a_gate_r_w": a_gate_r_w, "a_gate_r_b": a_gate_r_b,
            "a_gate_i_w": a_gate_i_w, "a_gate_i_b": a_gate_i_b, "a_lambda": a_lambda,
            "a_w_out": a_w_out, "b_w_in": b_w_in, "b_q_norm_g": b_q_norm_g,
            "b_k_norm_g": b_k_norm_g, "b_w_out": b_w_out, "ffn_w1": ffn_w1, "ffn_w2": ffn_w2}


def reference(x, c, norm_mix_g, norm_ffn_g, ada_w, ada_b, a_w_in, a_conv_w, a_conv_b,
              a_gate_r_w, a_gate_r_b, a_gate_i_w, a_gate_i_b, a_lambda, a_w_out,
              b_w_in, b_q_norm_g, b_k_norm_g, b_w_out, ffn_w1, ffn_w2):
    cond = jax.nn.silu(c)
    for i in range(DEPTH):
        mod = (cond @ ada_w[i] + ada_b[i])[:, None, :]
        sh1, sc1, g1, sh2, sc2, g2 = jnp.split(mod, N_MOD, axis=-1)
        j = i // N_MIXERS
        h = rmsnorm(x, norm_mix_g[i]) * (1.0 + sc1) + sh1
        if i % N_MIXERS == 0:
            y = rglru_mixer(h, a_w_in[j], a_conv_w[j], a_conv_b[j], a_gate_r_w[j], a_gate_r_b[j],
                            a_gate_i_w[j], a_gate_i_b[j], a_lambda[j], a_w_out[j])
        else:
            y = dsa_mixer(h, b_w_in[j], b_q_norm_g[j], b_k_norm_g[j], b_w_out[j])
        x = x + g1 * y
        h = rmsnorm(x, norm_ffn_g[i]) * (1.0 + sc2) + sh2
        x = x + g2 * (jnp.square(jax.nn.relu(h @ ffn_w1[i])) @ ffn_w2[i])
    return x
```

```cpp
#include <hip/hip_runtime.h>
#include <cstdio>
#include <cstdint>
#include <cmath>
#ifndef MK_N_LAUNCHES
#define MK_N_LAUNCHES 15
#endif
namespace pg8 {
#define PG8_LAS __attribute__((address_space(3)))
typedef unsigned short bf16_t;
typedef short bf16x8 __attribute__((ext_vector_type(8)));
typedef float f32x4 __attribute__((ext_vector_type(4)));
typedef unsigned u32x4 __attribute__((ext_vector_type(4)));
constexpr int BM = 256, BK = 64, HALF = 128, HTB = HALF * BK * 2  , STAGE_BYTES = 8 * HTB, NXCD = 8, WGM = 8;

__host__ __device__ __forceinline__ int lds_byte(int r, int c) { const int st = (r >> 4) * 2 + (c >> 5), rr = r & 15, cc = c & 31, ob = rr * 64 + cc * 2; return st * 1024 + (ob ^ (((ob >> 9) & 1) << 5)); }
__host__ __device__ __forceinline__ void stage_rc(int b, int& R, int& C) { const int st = b / 1024, sb = b % 1024, swz = sb ^ (((sb >> 9) & 1) << 5); R = (st >> 1) * 16 + swz / 64; C = (st & 1) * 32 + (swz % 64) / 2; }
__host__ __device__ __forceinline__ int perm32(int rho) { const int n = rho >> 4, i = rho & 15; return 8 * (i >> 2) + 4 * n + (i & 3); }

struct Unit { int pm, pn; };
struct Gemm { const bf16_t* A; const bf16_t* Bt; int M, N, K; };

struct StaticOrder {
    int nM, nN, nwg, G, c;
    __host__ __device__ void init(int M, int N, int G_, int c_) { nM = M / BM; nN = N / BM; nwg = nM * nN; G = G_; c = c_; }
    __host__ __device__ bool next(int i, Unit& u) const {
        const long L = (long)i * G + c; if (L >= nwg) return false;
        int wgid = (int)L; { const int q = nwg / NXCD, r = nwg % NXCD, xcd = wgid % NXCD, off = wgid / NXCD; wgid = (xcd < r ? xcd * (q + 1) : r * (q + 1) + (xcd - r) * q) + off; }
        const int nig = WGM * nN, gid = wgid / nig, fm = gid * WGM, gsz = (nM - fm) < WGM ? (nM - fm) : WGM;
        u.pm = fm + ((wgid % nig) % gsz); u.pn = (wgid % nig) / gsz; return true;
    }
    __device__ __forceinline__ void a_ready(const Unit&) const {}
    __device__ __forceinline__ void done(const Unit&) const {}
};

__device__ __forceinline__ unsigned cvt_pk_bf16(float lo, float hi) { unsigned r; asm volatile("v_cvt_pk_bf16_f32 %0, %1, %2" : "=v"(r) : "v"(lo), "v"(hi)); return r; }
typedef float f32x2 __attribute__((ext_vector_type(2)));
template <class Epi, class Sched, bool ALIGN_EPI = false, bool SP2 = false>
__device__ __forceinline__ void gemm_phase(PG8_LAS unsigned char* lds, const Gemm g, const Sched& S, const Epi& E) {
    const int tid = threadIdx.x, wid = __builtin_amdgcn_readfirstlane(tid >> 6), lane = tid & 63, wr = wid >> 2, wc = wid & 3, fr = lane & 15, fq = lane >> 4;
    const int K = g.K, nt = K / BK;
    unsigned voffA[2], voffB[2];
#pragma unroll
    for (int i = 0; i < 2; ++i) { int R, C; stage_rc(tid * 16 + i * 8192, R, C); const int Rb = Epi::PERM ? ((R & ~31) + perm32(R & 31)) : R;
        voffA[i] = (unsigned)(R * K + C) * 2u; voffB[i] = (unsigned)(Rb * K + C) * 2u; }
    const size_t kstep = (size_t)(BK * 2);
    const size_t hstep = (size_t)HALF * K * 2;
    const size_t tstep = 2 * hstep;
    const unsigned ldsw = (unsigned)wid * 1024u;
    const int aoff = lds_byte(wr * 64 + fr, fq * 8), boff = lds_byte(wc * 32 + fr, fq * 8);
#define PG8_SA(b, h) (((b) * 2 + (h)) * HTB)
#define PG8_SB(b, h) ((4 + (b) * 2 + (h)) * HTB)
#define PG8_STAGE(bufoff, gbase, voff) do { _Pragma("unroll") for (int _i = 0; _i < 2; ++_i) \
        __builtin_amdgcn_global_load_lds((const unsigned*)((const char*)(gbase) + (voff)[_i]), (PG8_LAS unsigned*)(lds + (bufoff) + ldsw + _i * 8192), 16, 0, 0); } while (0)
#define PG8_LDA(dst, b, h) do { _Pragma("unroll") for (int m = 0; m < 4; ++m) _Pragma("unroll") for (int k = 0; k < 2; ++k) dst[m][k] = *(const PG8_LAS bf16x8*)(lds + PG8_SA(b, h) + aoff + m * 2048 + k * 1024); } while (0)
#define PG8_LDB(dst, b, h) do { _Pragma("unroll") for (int n = 0; n < 2; ++n) _Pragma("unroll") for (int k = 0; k < 2; ++k) dst[n][k] = *(const PG8_LAS bf16x8*)(lds + PG8_SB(b, h) + boff + n * 2048 + k * 1024); } while (0)
#define PG8_MMA(ai, bj, At, Bt) do { __builtin_amdgcn_s_setprio(1); _Pragma("unroll") for (int m = 0; m < 4; ++m) _Pragma("unroll") for (int n = 0; n < 2; ++n) _Pragma("unroll") for (int k = 0; k < 2; ++k) \
        acc[ai][bj][m][n] = __builtin_amdgcn_mfma_f32_16x16x32_bf16(Bt[n][k], At[m][k], acc[ai][bj][m][n], 0, 0, 0); __builtin_amdgcn_s_setprio(0); } while (0)
#define PG8_WAIT_V(n) asm volatile("s_waitcnt vmcnt(" #n ")" ::: "memory")
#define PG8_WAIT_L(n) asm volatile("s_waitcnt lgkmcnt(" #n ")" ::: "memory")
#define PG8_BAR __builtin_amdgcn_s_barrier()
#define PG8_SCHED __builtin_amdgcn_sched_barrier(0)
    Unit cur, nxt; int ui = 0;
    if (!S.next(0, cur)) return;
    f32x4 acc[2][2][4][2];
#pragma unroll
    for (int a = 0; a < 2; ++a)
#pragma unroll
        for (int b = 0; b < 2; ++b)
#pragma unroll
            for (int m = 0; m < 4; ++m)
#pragma unroll
                for (int n = 0; n < 2; ++n) acc[a][b][m][n] = (f32x4){0.f, 0.f, 0.f, 0.f};
    bf16x8 At[4][2], B0[2][2], B1[2][2];
    const char* cA = (const char*)g.A + (size_t)cur.pm * tstep; const char* cB = (const char*)g.Bt + (size_t)cur.pn * tstep;
    S.a_ready(cur);
    if constexpr (SP2) {
        PG8_STAGE(PG8_SB(0, 0), cB, voffB); PG8_STAGE(PG8_SB(0, 1), cB + hstep, voffB); PG8_STAGE(PG8_SA(0, 0), cA, voffA); PG8_STAGE(PG8_SA(0, 1), cA + hstep, voffA);
        if (wr == 1) PG8_BAR;
        PG8_WAIT_V(2); PG8_BAR;
        PG8_STAGE(PG8_SB(1, 0), cB + kstep, voffB); PG8_STAGE(PG8_SA(1, 0), cA + kstep, voffA); PG8_STAGE(PG8_SB(1, 1), cB + hstep + kstep, voffB);
        PG8_WAIT_V(6); PG8_BAR;
    } else {
        PG8_STAGE(PG8_SB(0, 0), cB, voffB); PG8_STAGE(PG8_SA(0, 0), cA, voffA); PG8_STAGE(PG8_SB(0, 1), cB + hstep, voffB); PG8_STAGE(PG8_SA(0, 1), cA + hstep, voffA);
        if (wr == 1) PG8_BAR;
        PG8_WAIT_V(4); PG8_BAR;
        PG8_STAGE(PG8_SB(1, 0), cB + kstep, voffB); PG8_STAGE(PG8_SA(1, 0), cA + kstep, voffA); PG8_STAGE(PG8_SB(1, 1), cB + hstep + kstep, voffB);
        PG8_WAIT_V(6); PG8_BAR;
    }
    for (;;) {
        const bool has_next = S.next(ui + 1, nxt);
        const char* nA = has_next ? (const char*)g.A + (size_t)nxt.pm * tstep : cA; const char* nB = has_next ? (const char*)g.Bt + (size_t)nxt.pn * tstep : cB;
        for (int t = 0; t < nt; t += 2) {
            const bool last = (t == nt - 2);
            const char* a1 = cA + (size_t)(t + 1) * kstep;
            const char* a2 = last ? nA : cA + (size_t)(t + 2) * kstep; const char* b2 = last ? nB : cB + (size_t)(t + 2) * kstep;
            const char* a3 = a2 + kstep; const char* b3 = b2 + kstep;
            if (last && has_next) S.a_ready(nxt);
            if constexpr (SP2) {
            PG8_LDB(B0, 0, 0); PG8_LDB(B1, 0, 1); PG8_SCHED; PG8_LDA(At, 0, 0); PG8_STAGE(PG8_SA(1, 1), a1 + hstep, voffA);
            PG8_WAIT_V(8); PG8_WAIT_L(0); PG8_BAR; PG8_MMA(0, 0, At, B0); PG8_MMA(0, 1, At, B1); PG8_BAR; PG8_SCHED;
            PG8_LDA(At, 0, 1); PG8_STAGE(PG8_SB(0, 0), b2, voffB); PG8_STAGE(PG8_SB(0, 1), b2 + hstep, voffB); PG8_STAGE(PG8_SA(0, 0), a2, voffA);
            PG8_WAIT_V(8); PG8_WAIT_L(0); PG8_BAR; PG8_MMA(1, 0, At, B0); PG8_MMA(1, 1, At, B1); PG8_BAR; PG8_SCHED;
            PG8_LDB(B0, 1, 0); PG8_LDB(B1, 1, 1); PG8_SCHED; PG8_LDA(At, 1, 0); PG8_STAGE(PG8_SA(0, 1), a2 + hstep, voffA);
            PG8_WAIT_V(8); PG8_WAIT_L(0); PG8_BAR; PG8_MMA(0, 0, At, B0); PG8_MMA(0, 1, At, B1); PG8_BAR; PG8_SCHED;
            PG8_LDA(At, 1, 1); PG8_STAGE(PG8_SB(1, 0), b3, voffB); PG8_STAGE(PG8_SB(1, 1), b3 + hstep, voffB); PG8_STAGE(PG8_SA(1, 0), a3, voffA);
            PG8_WAIT_V(8); PG8_WAIT_L(0); PG8_BAR; PG8_MMA(1, 0, At, B0); PG8_MMA(1, 1, At, B1); PG8_BAR; PG8_SCHED;
            } else {
            PG8_LDB(B0, 0, 0); PG8_SCHED; PG8_LDA(At, 0, 0); PG8_STAGE(PG8_SA(1, 1), a1 + hstep, voffA);
            PG8_WAIT_L(8); PG8_BAR; PG8_WAIT_L(0); PG8_MMA(0, 0, At, B0); PG8_BAR; PG8_SCHED;
            PG8_LDB(B1, 0, 1); PG8_STAGE(PG8_SB(0, 0), b2, voffB);
            PG8_BAR; PG8_WAIT_L(0); PG8_MMA(0, 1, At, B1); PG8_BAR;
            PG8_LDA(At, 0, 1); PG8_STAGE(PG8_SA(0, 0), a2, voffA);
            PG8_BAR; PG8_WAIT_L(0); PG8_MMA(1, 0, At, B0); PG8_BAR; PG8_SCHED;
            PG8_STAGE(PG8_SB(0, 1), b2 + hstep, voffB);
            PG8_WAIT_V(6); PG8_BAR; PG8_MMA(1, 1, At, B1); PG8_BAR;
            PG8_LDB(B0, 1, 0); PG8_SCHED; PG8_LDA(At, 1, 0); PG8_STAGE(PG8_SA(0, 1), a2 + hstep, voffA);
            PG8_WAIT_L(8); PG8_BAR; PG8_WAIT_L(0); PG8_MMA(0, 0, At, B0); PG8_BAR; PG8_SCHED;
            PG8_LDB(B1, 1, 1); PG8_STAGE(PG8_SB(1, 0), b3, voffB);
            PG8_BAR; PG8_WAIT_L(0); PG8_MMA(0, 1, At, B1); PG8_BAR;
            PG8_LDA(At, 1, 1); PG8_STAGE(PG8_SA(1, 0), a3, voffA);
            PG8_BAR; PG8_WAIT_L(0); PG8_MMA(1, 0, At, B0); PG8_BAR; PG8_SCHED;
            PG8_STAGE(PG8_SB(1, 1), b3 + hstep, voffB);
            PG8_WAIT_V(6); PG8_BAR; PG8_MMA(1, 1, At, B1); PG8_BAR;
            }
        }
        if constexpr (ALIGN_EPI) { if (wr == 0) PG8_BAR; }
        if constexpr (!Epi::AFTER_DRAIN) { E(acc, cur, wr, wc, fr, fq); S.done(cur); }
        if (!has_next) break;
#pragma unroll
        for (int a = 0; a < 2; ++a)
#pragma unroll
            for (int b = 0; b < 2; ++b)
#pragma unroll
                for (int m = 0; m < 4; ++m)
#pragma unroll
                    for (int n = 0; n < 2; ++n) acc[a][b][m][n] = (f32x4){0.f, 0.f, 0.f, 0.f};
        cur = nxt; cA = nA; cB = nB; ++ui;
        if constexpr (ALIGN_EPI) { if (wr == 1) PG8_BAR; }
    }
    PG8_WAIT_V(0);
    if constexpr (!ALIGN_EPI) { if (wr == 0) PG8_BAR; }
    PG8_BAR;
    if constexpr (Epi::AFTER_DRAIN) { E.fused(acc, cur, wr, wc, fr, fq, lds, wid, lane); S.done(cur); }
#undef PG8_SA
#undef PG8_SB
#undef PG8_STAGE
#undef PG8_LDA
#undef PG8_LDB
#undef PG8_MMA
#undef PG8_WAIT_V
#undef PG8_WAIT_L
#undef PG8_BAR
#undef PG8_SCHED
}
}
#define GAS __attribute__((address_space(1)))
#define LAS __attribute__((address_space(3)))
typedef unsigned short bf16;
typedef unsigned v4u __attribute__((ext_vector_type(4)));
typedef float f32x4 __attribute__((ext_vector_type(4)));
typedef short bf16x8 __attribute__((ext_vector_type(8)));
typedef GAS unsigned gu32;
typedef GAS unsigned long long gu64;
#define RLX_AGENT __ATOMIC_RELAXED, __HIP_MEMORY_SCOPE_AGENT
#define LDS_WAIT() asm volatile("s_waitcnt lgkmcnt(0)" ::: "memory")
#define VM_WAIT() asm volatile("s_waitcnt vmcnt(0)" ::: "memory")
__device__ __forceinline__ unsigned long long rt() { return __builtin_amdgcn_s_memrealtime(); }
__device__ __forceinline__ unsigned f2bf(float f) { unsigned u = __builtin_bit_cast(unsigned, f); return (u + 0x7fffu + ((u >> 16) & 1u)) >> 16; }
__device__ __forceinline__ unsigned pk2(float lo, float hi) { return f2bf(lo) | (f2bf(hi) << 16); }

#define XB_TMO      128
#define XB_XCNT(j)  (256  + 64 * (j))
#define XB_XSUB(j)  (1280 + 64 * (j))
#define XB_XGEN(j)  (2304 + 64 * (j))
#define XB_TOP      3328
#define XB_TOPGEN   3392
#define XCD_BAR_WORDS 3456
#define XB_SPIN_CAP (1u << 18)

__device__ __forceinline__ unsigned xb_ld(unsigned* p)              { return __hip_atomic_load(p, __ATOMIC_RELAXED, __HIP_MEMORY_SCOPE_AGENT); }
__device__ __forceinline__ unsigned xb_add(unsigned* p, unsigned v) { return __hip_atomic_fetch_add(p, v, __ATOMIC_RELAXED, __HIP_MEMORY_SCOPE_AGENT); }
__device__ __forceinline__ unsigned xb_xcc_id() { return (unsigned)__builtin_amdgcn_s_getreg((3 << 11) | 20) & 0xFu; }
#define XB_SPIN(cond, bar) do { unsigned _sp = 0; while (cond) { __builtin_amdgcn_s_sleep(1); \
    if ((++_sp & 255u) == 0u) { if (xb_ld(&(bar)[XB_TMO])) break; if (_sp > XB_SPIN_CAP) { atomicAdd(&(bar)[XB_TMO], 1u); break; } } } } while (0)

struct XcdBarrier {
    unsigned* bar; unsigned x;
    volatile LAS unsigned* st;
};

__device__ __forceinline__ XcdBarrier xcd_barrier_post(unsigned* bar, volatile LAS unsigned* st) {
    XcdBarrier b; b.bar = bar; b.x = xb_xcc_id(); b.st = st;
    if (threadIdx.x == 0) (void)xb_add(&bar[XB_XCNT(b.x)], 1u);
    return b;
}
__device__ __forceinline__ void xcd_barrier_complete(unsigned* bar, unsigned x, unsigned& nloc, unsigned& nx) {
    const unsigned G = gridDim.x * gridDim.y * gridDim.z;
    unsigned sum, cnt, mine, sp = 0u;
    for (;;) {
        sum = 0u; cnt = 0u; mine = 0u;
#pragma unroll
        for (unsigned j = 0; j < 16; ++j) { const unsigned c = xb_ld(&bar[XB_XCNT(j)]); sum += c; cnt += (c > 0u) ? 1u : 0u; mine = (j == x) ? c : mine; }
        if (sum == G) break;
        __builtin_amdgcn_s_sleep(1);
        if ((++sp & 255u) == 0u) { if (xb_ld(&bar[XB_TMO])) break; if (sp > XB_SPIN_CAP) { atomicAdd(&bar[XB_TMO], 1u); break; } }
    }
    nloc = mine > 0u ? mine : 1u; nx = cnt > 0u ? cnt : 1u;
}

__device__ __forceinline__ void xcd_barrier(const XcdBarrier& b) {
    asm volatile("s_waitcnt vmcnt(0)" ::: "memory");
    __syncthreads();
    if (threadIdx.x == 0) {
        unsigned* bar = b.bar;
        __builtin_amdgcn_s_waitcnt(0);
        unsigned nloc = b.st[0], nx = b.st[1];
        if (nloc == 0u) { xcd_barrier_complete(bar, b.x, nloc, nx); b.st[0] = nloc; b.st[1] = nx; }
        const unsigned old = xb_add(&bar[XB_XSUB(b.x)], 1u);
        const unsigned gen = old / nloc;
        if (old + 1u == (gen + 1u) * nloc) {
            __builtin_amdgcn_fence(__ATOMIC_RELEASE, "agent");
            asm volatile("s_waitcnt vmcnt(0)" ::: "memory");
            const unsigned og = xb_add(&bar[XB_TOP], 1u);
            const unsigned tg = og / nx;
            if (og + 1u == (tg + 1u) * nx) xb_add(&bar[XB_TOPGEN], 1u);
            else XB_SPIN(xb_ld(&bar[XB_TOPGEN]) == tg, bar);
            __builtin_amdgcn_fence(__ATOMIC_ACQUIRE, "agent");
            xb_add(&bar[XB_XGEN(b.x)], 1u);
            asm volatile("s_waitcnt vmcnt(0)" ::: "memory");
        } else {
            XB_SPIN(xb_ld(&bar[XB_XGEN(b.x)]) == gen, bar);
            __builtin_amdgcn_fence(__ATOMIC_ACQUIRE, "agent");
            asm volatile("s_waitcnt vmcnt(0)" ::: "memory");
        }
    }
    __syncthreads();
}

constexpr int NB = 8, SEQ = 4096, DM = 1024, MTOK = NB * SEQ, DFF = 4096, DRNN = 1280, NLB = 5, LBLK = 256;
constexpr int NHEAD = 16, HD = 64, IH = 8, TOPK = 256, BIN = 1736, BINP = 1792, NMOD = 6 * DM;
constexpr float RMS_EPS = 1e-6f;
constexpr int NWAVES = 8, NTHREADS = 512;
constexpr int N_PHASES = 15;
constexpr int N_LAUNCHES = MK_N_LAUNCHES;

constexpr size_t MiB = 1u << 20;
constexpr size_t WS_CTL = 0, CTL_ZERO_BYTES = 64 * 1024;
constexpr int CW_BAR = 4096;
constexpr size_t WS_MOD = 1 * MiB;
constexpr size_t WS_ROPE = 2 * MiB;
constexpr size_t WS_WAIN = 4 * MiB;
constexpr size_t WS_WAOUT = 9 * MiB;
constexpr size_t WS_WGATE = 12 * MiB;
constexpr size_t WS_WBIN = 14 * MiB;
constexpr size_t WS_WBOUT = 18 * MiB;
constexpr size_t WS_W1 = 20 * MiB;
constexpr size_t WS_W2 = 36 * MiB;
constexpr size_t WS_H = 64 * MiB;
constexpr size_t WS_BIG = 128 * MiB;
constexpr size_t WS_XB = WS_BIG, WS_GATE = WS_BIG + 80 * MiB, WS_Y = WS_BIG + 160 * MiB;
constexpr size_t WS_Q = WS_BIG, WS_QI = WS_BIG + 64 * MiB, WS_K = WS_BIG + 96 * MiB, WS_V = WS_BIG + 100 * MiB, WS_KI = WS_BIG + 104 * MiB, WS_WI = WS_BIG + 108 * MiB, WS_AO = WS_BIG + 112 * MiB;
constexpr size_t WS_END = 384 * MiB;

constexpr int LDS_BYTES = 163840;
constexpr int MISC_OFF = LDS_BYTES - 256;

typedef float f32x2v __attribute__((ext_vector_type(2)));
typedef unsigned u32x2v __attribute__((ext_vector_type(2)));
typedef short s16x4v __attribute__((ext_vector_type(4)));

__device__ __forceinline__ float wave_sum(float v) {
#pragma unroll
    for (int o = 1; o < 64; o <<= 1) v += __shfl_xor(v, o);
    return v;
}
__device__ __forceinline__ float bf2f(unsigned short h) { return __builtin_bit_cast(float, (unsigned)h << 16); }
__device__ __forceinline__ float bflo(unsigned w) { return __builtin_bit_cast(float, w << 16); }
__device__ __forceinline__ float bfhi(unsigned w) { return __builtin_bit_cast(float, w & 0xffff0000u); }
__device__ __forceinline__ float sigmoidf_(float x) { return __builtin_amdgcn_rcpf(1.f + __builtin_amdgcn_exp2f(-1.4426950408889634f * x)); }

namespace pg8 {
struct EpiXbGate {
    static constexpr bool PERM = true, AFTER_DRAIN = false;
    bf16_t* XB; bf16_t* GT;
    __device__ __forceinline__ void operator()(const f32x4 (&acc)[2][2][4][2], const Unit& u, int wr, int wc, int fr, int fq) const {
        const bool isg = u.pn >= 5; bf16_t* base = isg ? GT : XB;
        const int row0 = u.pm * BM + wr * 64 + fr, col0 = (isg ? u.pn - 5 : u.pn) * BM + wc * 32 + 8 * fq;
#pragma unroll
        for (int ai = 0; ai < 2; ++ai)
#pragma unroll
            for (int m = 0; m < 4; ++m) { bf16_t* rowp = base + (size_t)(row0 + ai * HALF + m * 16) * DRNN + col0;
#pragma unroll
                for (int bj = 0; bj < 2; ++bj) { f32x4 v0 = acc[ai][bj][m][0], v1 = acc[ai][bj][m][1];
                    if (isg) {
#pragma unroll
                        for (int j = 0; j < 4; ++j) { float x = v0[j]; v0[j] = x * __builtin_amdgcn_rcpf(1.f + __builtin_amdgcn_exp2f(-2.302208198f * (x + 0.044715f * x * x * x)));
                            x = v1[j]; v1[j] = x * __builtin_amdgcn_rcpf(1.f + __builtin_amdgcn_exp2f(-2.302208198f * (x + 0.044715f * x * x * x))); } }
                    u32x4 w; w.x = cvt_pk_bf16(v0[0], v0[1]); w.y = cvt_pk_bf16(v0[2], v0[3]); w.z = cvt_pk_bf16(v1[0], v1[1]); w.w = cvt_pk_bf16(v1[2], v1[3]);
                    *(u32x4*)(rowp + bj * HALF) = w; } }
    }
};
struct EpiRes {
    static constexpr bool PERM = false, AFTER_DRAIN = false;
    const float* res; float* out; const float* gate;
    __device__ __forceinline__ void operator()(const f32x4 (&acc)[2][2][4][2], const Unit& u, int wr, int wc, int fr, int fq) const {
        const int row0 = u.pm * BM + wr * 64 + fr, col0 = u.pn * BM + wc * 32 + 4 * fq, b = u.pm >> 4;
        f32x4 gv[2][2];
#pragma unroll
        for (int bj = 0; bj < 2; ++bj)
#pragma unroll
            for (int n = 0; n < 2; ++n) gv[bj][n] = *(const f32x4*)(gate + b * NMOD + col0 + bj * HALF + n * 16);
#pragma unroll
        for (int ai = 0; ai < 2; ++ai)
#pragma unroll
            for (int m = 0; m < 4; ++m) { const size_t off = (size_t)(row0 + ai * HALF + m * 16) * DM + col0;
                f32x4 rv[2][2];
#pragma unroll
                for (int bj = 0; bj < 2; ++bj)
#pragma unroll
                    for (int n = 0; n < 2; ++n) rv[bj][n] = *(const f32x4*)(res + off + bj * HALF + n * 16);
#pragma unroll
                for (int bj = 0; bj < 2; ++bj)
#pragma unroll
                    for (int n = 0; n < 2; ++n) *(f32x4*)(out + off + bj * HALF + n * 16) = rv[bj][n] + gv[bj][n] * acc[ai][bj][m][n];
                asm volatile("" ::: "memory"); }
    }
};
struct EpiRelu2 {
    static constexpr bool PERM = true, AFTER_DRAIN = false;
    bf16_t* O;
    __device__ __forceinline__ void operator()(const f32x4 (&acc)[2][2][4][2], const Unit& u, int wr, int wc, int fr, int fq) const {
        const int row0 = u.pm * BM + wr * 64 + fr, col0 = u.pn * BM + wc * 32 + 8 * fq;
#pragma unroll
        for (int ai = 0; ai < 2; ++ai)
#pragma unroll
            for (int m = 0; m < 4; ++m) { bf16_t* rowp = O + (size_t)(row0 + ai * HALF + m * 16) * DFF + col0;
#pragma unroll
                for (int bj = 0; bj < 2; ++bj) { f32x4 v0 = acc[ai][bj][m][0], v1 = acc[ai][bj][m][1];
#pragma unroll
                    for (int j = 0; j < 4; ++j) { const float a = fmaxf(v0[j], 0.f), b = fmaxf(v1[j], 0.f); v0[j] = a * a; v1[j] = b * b; }
                    u32x4 w; w.x = cvt_pk_bf16(v0[0], v0[1]); w.y = cvt_pk_bf16(v0[2], v0[3]); w.z = cvt_pk_bf16(v1[0], v1[1]); w.w = cvt_pk_bf16(v1[2], v1[3]);
                    *(u32x4*)(rowp + bj * HALF) = w; } }
    }
};
struct EpiIn1 {
    static constexpr bool PERM = true, AFTER_DRAIN = false;
    bf16_t *Q, *QI, *K, *V, *KI; float* WI; const float* rope; const float *qg, *kg;
    __device__ __forceinline__ void operator()(const f32x4 (&acc)[2][2][4][2], const Unit& u, int wr, int wc, int fr, int fq) const {
        const int pn = u.pn;
        int kind;
        bf16_t* dst; int pitch, hoff;
        if (pn < 4) { kind = 0; dst = Q; pitch = DM; hoff = (4 * pn + wc) * 64; }
        else if (pn < 6) { kind = 1; dst = QI; pitch = 512; hoff = (4 * (pn - 4) + wc) * 64; }
        else if (wc == 0) { kind = 2; dst = K; pitch = 64; hoff = 0; }
        else if (wc == 1) { kind = 3; dst = KI; pitch = 64; hoff = 0; }
        else if (wc == 2) { kind = 4; dst = V; pitch = 64; hoff = 0; }
        else { kind = 5; dst = nullptr; pitch = 0; hoff = 0; }
        const bool donorm = (kind == 0 || kind == 2), dorope = (kind <= 3);
        const float osc = (kind == 0) ? 0.125f * 1.4426950408889634f : 1.f;
        f32x4 g1[2], g2[2];
#pragma unroll
        for (int n = 0; n < 2; ++n) { g1[n] = (f32x4){1.f, 1.f, 1.f, 1.f}; g2[n] = g1[n]; }
        if (kind == 0) {
#pragma unroll
            for (int n = 0; n < 2; ++n) { g1[n] = *(const f32x4*)(qg + 8 * fq + 4 * n); g2[n] = *(const f32x4*)(qg + 32 + 8 * fq + 4 * n); } }
        if (kind == 2) {
#pragma unroll
            for (int n = 0; n < 2; ++n) { g1[n] = *(const f32x4*)(kg + 8 * fq + 4 * n); g2[n] = *(const f32x4*)(kg + 32 + 8 * fq + 4 * n); } }
#pragma unroll
        for (int ai = 0; ai < 2; ++ai)
#pragma unroll
            for (int m = 0; m < 4; ++m) {
                const int row = u.pm * BM + ai * HALF + wr * 64 + m * 16 + fr, pos = row & (SEQ - 1);
                f32x4 x1[2], x2[2];
#pragma unroll
                for (int n = 0; n < 2; ++n) { x1[n] = acc[ai][0][m][n]; x2[n] = acc[ai][1][m][n]; }
                if (kind == 5) {
                    if (fq == 0) { *(f32x4*)(WI + (size_t)row * 8) = x1[0]; *(f32x4*)(WI + (size_t)row * 8 + 4) = x1[1]; }
                    continue;
                }
                if (donorm) {
                    float ss = 0.f;
#pragma unroll
                    for (int n = 0; n < 2; ++n)
#pragma unroll
                        for (int j = 0; j < 4; ++j) ss += x1[n][j] * x1[n][j] + x2[n][j] * x2[n][j];
                    ss += __shfl_xor(ss, 16); ss += __shfl_xor(ss, 32);
                    const float rs = 1.0f / sqrtf(ss * (1.f / 64.f) + RMS_EPS);
#pragma unroll
                    for (int n = 0; n < 2; ++n) { x1[n] = x1[n] * rs * g1[n]; x2[n] = x2[n] * rs * g2[n]; }
                }
                if (dorope) {
#pragma unroll
                    for (int n = 0; n < 2; ++n) { const f32x4 c = *(const f32x4*)(rope + pos * 32 + 8 * fq + 4 * n), s = *(const f32x4*)(rope + SEQ * 32 + pos * 32 + 8 * fq + 4 * n);
                        const f32x4 o1 = x1[n] * c - x2[n] * s, o2 = x2[n] * c + x1[n] * s; x1[n] = o1; x2[n] = o2; }
                }
#pragma unroll
                for (int n = 0; n < 2; ++n) { x1[n] = x1[n] * osc; x2[n] = x2[n] * osc; }
                bf16_t* rowp = dst + (size_t)row * pitch + hoff + 8 * fq;
                u32x4 w; w.x = cvt_pk_bf16(x1[0][0], x1[0][1]); w.y = cvt_pk_bf16(x1[0][2], x1[0][3]); w.z = cvt_pk_bf16(x1[1][0], x1[1][1]); w.w = cvt_pk_bf16(x1[1][2], x1[1][3]);
                *(u32x4*)(rowp) = w;
                w.x = cvt_pk_bf16(x2[0][0], x2[0][1]); w.y = cvt_pk_bf16(x2[0][2], x2[0][3]); w.z = cvt_pk_bf16(x2[1][0], x2[1][1]); w.w = cvt_pk_bf16(x2[1][2], x2[1][3]);
                *(u32x4*)(rowp + 32) = w;
            }
    }
};
}

__device__ __forceinline__ int bin_row(int c) {
    if (c < 1024) { const int h = c >> 6, d = c & 63; return 256 * (h >> 2) + 128 * (d >> 5) + 32 * (h & 3) + (d & 31); }
    if (c < 1088) { const int d = c - 1024; return 1536 + 128 * (d >> 5) + (d & 31); }
    if (c < 1152) { const int d = c - 1088; return 1536 + 128 * (d >> 5) + 64 + (d & 31); }
    if (c < 1664) { const int cc = c - 1152, h = cc >> 6, d = cc & 63; return 256 * (4 + (h >> 2)) + 128 * (d >> 5) + 32 * (h & 3) + (d & 31); }
    if (c < 1728) { const int d = c - 1664; return 1536 + 128 * (d >> 5) + 32 + (d & 31); }
    return 1536 + 96 + (c - 1728);
}
template <int MODE>
__device__ __forceinline__ void tr_item(const float* W, int K, int N, bf16* WT, int item, LAS float* scr, int lane) {
    const int nblk = (N + 31) / 32, kb = item / nblk, nb = item % nblk, k0 = 64 * kb, n0 = 32 * nb;
    const int nn = n0 + (lane & 31); const bool nok = nn < N;
#pragma unroll 8
    for (int i = 0; i < 32; ++i) { const int kk = 2 * i + (lane >> 5); scr[kk * 33 + (lane & 31)] = nok ? W[(size_t)(k0 + kk) * N + nn] : 0.f; }
    LDS_WAIT(); asm volatile("" ::: "memory");
    const int c = lane & 7;
#pragma unroll
    for (int j = 0; j < 4; ++j) { const int n = (lane >> 3) + 8 * j, ncol = n0 + n; const LAS float* s = scr + (8 * c) * 33 + n;
        v4u o; o.x = pk2(s[0 * 33], s[1 * 33]); o.y = pk2(s[2 * 33], s[3 * 33]); o.z = pk2(s[4 * 33], s[5 * 33]); o.w = pk2(s[6 * 33], s[7 * 33]);
        if (ncol < N) { const int drow = (MODE == 0) ? ncol : bin_row(ncol); *(GAS v4u*)(WT + (size_t)drow * K + k0 + 8 * c) = o; } }
    LDS_WAIT(); asm volatile("" ::: "memory");
}

struct RopeInv { float v[32]; };

__device__ __forceinline__ void phase_prep(const float* const* in, unsigned char* ws, LAS unsigned char* lds, const RopeInv& rinv, int tid, int lane, int wave, int bx, int G) {
    if (bx < 192) {
        LAS float* cond = (LAS float*)lds; LAS float* part = (LAS float*)(lds + 32768);
        const float* cin = in[1];
        for (int i = tid; i < NB * DM; i += NTHREADS) { const float v = cin[i]; cond[i] = v / (1.f + __expf(-v)); }
        __syncthreads();
        const int l = bx / 96, c0 = 64 * (bx % 96), cq = tid & 15, kg = tid >> 4;
        f32x4 a[NB];
#pragma unroll
        for (int b = 0; b < NB; ++b) a[b] = (f32x4){0.f, 0.f, 0.f, 0.f};
        const float* wp = in[4] + (size_t)l * DM * NMOD + c0 + 4 * cq;
#pragma unroll 4
        for (int kk = 0; kk < 32; ++kk) { const int k = kg * 32 + kk; const f32x4 w = *(const f32x4*)(wp + (size_t)k * NMOD);
#pragma unroll
            for (int b = 0; b < NB; ++b) { const float cv = cond[b * DM + k]; a[b] += w * cv; } }
#pragma unroll
        for (int b = 0; b < NB; ++b) *(LAS f32x4*)(part + (kg * NB + b) * 64 + 4 * cq) = a[b];
        __syncthreads();
        { const int b = tid >> 6, col = tid & 63; float s = 0.f;
#pragma unroll 8
          for (int k2 = 0; k2 < 32; ++k2) s += part[(k2 * NB + b) * 64 + col];
          ((float*)(ws + WS_MOD))[(size_t)(l * NB + b) * NMOD + c0 + col] = s + in[5][l * NMOD + c0 + col]; }
        __syncthreads();
    }
    { float* rope = (float*)(ws + WS_ROPE);
      for (int idx = bx * NTHREADS + tid; idx < SEQ * 32; idx += G * NTHREADS) { const int pos = idx >> 5, i = idx & 31;
          const float ang = (float)pos * rinv.v[i]; const double a = (double)ang; const double k = rint(a * 0.15915494309189535); const float x = (float)(a * 0.15915494309189535 - k);
          rope[idx] = __builtin_amdgcn_cosf(x); rope[SEQ * 32 + idx] = __builtin_amdgcn_sinf(x); } }
    { bf16* wb = (bf16*)(ws + WS_WBIN);
      for (int i = bx * NTHREADS + tid; i < 56 * 128; i += G * NTHREADS) { const int r = i >> 7, c8 = i & 127; const int row = r < 24 ? 1536 + 96 + 8 + r : 1536 + 128 + 96 + (r - 24);
          *(GAS v4u*)(wb + (size_t)row * DM + 8 * c8) = (v4u){0u, 0u, 0u, 0u}; } }
    LAS float* scr = (LAS float*)(lds + wave * 16384);
    const int gw = bx * NWAVES + wave, NGW = G * NWAVES;
    constexpr int I_AIN = 16 * 80, I_AOUT = 20 * 32, I_G1 = 4 * 8, I_GATES = 10 * I_G1, I_BIN = 16 * 55, I_BOUT = 16 * 32, I_W1 = 16 * 128, I_W2 = 64 * 32;
    constexpr int NITEMS = I_AIN + I_AOUT + I_GATES + I_BIN + I_BOUT + 2 * I_W1 + 2 * I_W2;
    for (int it = gw; it < NITEMS; it += NGW) {
        int r = it;
        if (r < I_W1 * 2) { const int l = r / I_W1; tr_item<0>(in[19] + (size_t)l * DM * DFF, DM, DFF, (bf16*)(ws + WS_W1) + (size_t)l * DFF * DM, r % I_W1, scr, lane); continue; } r -= 2 * I_W1;
        if (r < I_W2 * 2) { const int l = r / I_W2; tr_item<0>(in[20] + (size_t)l * DFF * DM, DFF, DM, (bf16*)(ws + WS_W2) + (size_t)l * DM * DFF, r % I_W2, scr, lane); continue; } r -= 2 * I_W2;
        if (r < I_AIN) { tr_item<0>(in[6], DM, 2 * DRNN, (bf16*)(ws + WS_WAIN), r, scr, lane); continue; } r -= I_AIN;
        if (r < I_AOUT) { tr_item<0>(in[14], DRNN, DM, (bf16*)(ws + WS_WAOUT), r, scr, lane); continue; } r -= I_AOUT;
        if (r < I_GATES) { const int mi = r / I_G1, n = mi >> 1, gsel = mi & 1;
            tr_item<0>(in[gsel ? 11 : 9] + (size_t)n * LBLK * LBLK, LBLK, LBLK, (bf16*)(ws + WS_WGATE) + (size_t)(n * 2 + gsel) * LBLK * LBLK, r % I_G1, scr, lane); continue; } r -= I_GATES;
        if (r < I_BIN) { tr_item<1>(in[15], DM, BIN, (bf16*)(ws + WS_WBIN), r, scr, lane); continue; } r -= I_BIN;
        tr_item<0>(in[18], DM, DM, (bf16*)(ws + WS_WBOUT), r, scr, lane);
    }
}

__device__ __forceinline__ void phase_norm(const float* x, const float* g, const float* mod_sh, const float* mod_sc, bf16* H, int lane, int wave, int vcu, int G) {
    const int gw = vcu * NWAVES + wave, NGW = G * NWAVES;
    for (int r0 = gw * 16; r0 < MTOK; r0 += NGW * 16) {
        const int b = r0 >> 12;
        f32x4 al[4], be[4];
#pragma unroll
        for (int j = 0; j < 4; ++j) { const int c = 4 * lane + 256 * j; const f32x4 gg = *(const f32x4*)(g + c), sc = *(const f32x4*)(mod_sc + b * NMOD + c); al[j] = gg * (sc + 1.f); be[j] = *(const f32x4*)(mod_sh + b * NMOD + c); }
#pragma unroll 2
        for (int rr = 0; rr < 16; ++rr) {
            const GAS f32x4* xr = (const GAS f32x4*)(x + (size_t)(r0 + rr) * DM) + lane;
            f32x4 v[4]; float s = 0.f;
#pragma unroll
            for (int j = 0; j < 4; ++j) { v[j] = xr[64 * j]; s += (v[j].x * v[j].x + v[j].y * v[j].y) + (v[j].z * v[j].z + v[j].w * v[j].w); }
            const float rstd = 1.0f / sqrtf(wave_sum(s) * (1.f / DM) + RMS_EPS);
            GAS unsigned long long* o8 = (GAS unsigned long long*)(H + (size_t)(r0 + rr) * DM) + lane;
#pragma unroll
            for (int j = 0; j < 4; ++j) { const f32x4 y = v[j] * rstd * al[j] + be[j]; o8[64 * j] = (unsigned long long)pk2(y.x, y.y) | ((unsigned long long)pk2(y.z, y.w) << 32); }
        }
    }
}

constexpr int RQ_CT = 128, RQ_AP = 528  , RQ_SP = 68  ;
constexpr int RQ_AT = 0, RQ_A = RQ_CT * RQ_AP, RQ_B = RQ_A + RQ_CT * RQ_SP * 4, RQ_SEG = RQ_B + RQ_CT * RQ_SP * 4, RQ_END = RQ_SEG + 8 * 64 * 8;
static_assert(RQ_END <= MISC_OFF, "rglru LDS map");
__device__ __forceinline__ void phase_rglru(const float* const* in, unsigned char* ws, LAS unsigned char* lds, int tid, int lane, int wave, int bx) {
    if (bx >= 160) return;
    const int b = bx & 7, n = (bx >> 3) >> 2, g = (bx >> 3) & 3;
    const bf16* XB = (const bf16*)(ws + WS_XB); const bf16* GT = (const bf16*)(ws + WS_GATE); bf16* Y = (bf16*)(ws + WS_Y);
    const int fr = lane & 15, fq = lane >> 4, wr = wave >> 2, wc = wave & 3;
    pg8::bf16x8 Br[8], Bi[8];
    { const bf16* wr_ = (const bf16*)(ws + WS_WGATE) + (size_t)(n * 2 + 0) * LBLK * LBLK + (size_t)(64 * g + 16 * wc + fr) * LBLK + 8 * fq;
      const bf16* wi_ = wr_ + (size_t)LBLK * LBLK;
#pragma unroll
      for (int kk = 0; kk < 8; ++kk) { Br[kk] = *(const pg8::bf16x8*)(wr_ + 32 * kk); Bi[kk] = *(const pg8::bf16x8*)(wi_ + 32 * kk); } }
    const int chl0 = 16 * wc + 4 * fq, chg0 = LBLK * n + 64 * g + chl0;
    const f32x4 brv = *(const f32x4*)(in[10] + chg0), biv = *(const f32x4*)(in[12] + chg0);
    f32x4 sp8;
    { const f32x4 lam = *(const f32x4*)(in[13] + chg0);
#pragma unroll
      for (int j = 0; j < 4; ++j) sp8[j] = 8.f * 1.4426950408889634f * log1pf(__expf(-lam[j])); }
    const int cg = tid & 31, tr = tid >> 5;
    const int cch = LBLK * n + 8 * cg;
    float cw[4][8], cb[8];
#pragma unroll
    for (int j = 0; j < 4; ++j) { const f32x4 w0 = *(const f32x4*)(in[7] + j * DRNN + cch), w1 = *(const f32x4*)(in[7] + j * DRNN + cch + 4);
#pragma unroll
        for (int e = 0; e < 4; ++e) { cw[j][e] = w0[e]; cw[j][4 + e] = w1[e]; } }
    { const f32x4 b0 = *(const f32x4*)(in[8] + cch), b1 = *(const f32x4*)(in[8] + cch + 4);
#pragma unroll
      for (int e = 0; e < 4; ++e) { cb[e] = b0[e]; cb[4 + e] = b1[e]; } }
    float hin = 0.f;
    const size_t tok0 = (size_t)b * SEQ;
    for (int c = 0; c < SEQ / RQ_CT; ++c) {
        const int t0 = c * RQ_CT;
        { v4u xr[11];
#pragma unroll
          for (int i = 0; i < 11; ++i) { const int t = t0 + 8 * tr - 3 + i; xr[i] = (t >= 0) ? *(const GAS v4u*)(XB + (tok0 + t) * DRNN + cch) : (v4u){0u, 0u, 0u, 0u}; }
#pragma unroll
          for (int tt = 0; tt < 8; ++tt) { float o[8];
#pragma unroll
              for (int e = 0; e < 8; ++e) o[e] = cb[e];
#pragma unroll
              for (int j = 0; j < 4; ++j) { const v4u w = xr[tt + j];
                  o[0] += cw[j][0] * bflo(w.x); o[1] += cw[j][1] * bfhi(w.x); o[2] += cw[j][2] * bflo(w.y); o[3] += cw[j][3] * bfhi(w.y);
                  o[4] += cw[j][4] * bflo(w.z); o[5] += cw[j][5] * bfhi(w.z); o[6] += cw[j][6] * bflo(w.w); o[7] += cw[j][7] * bfhi(w.w); }
              v4u pk; pk.x = pk2(o[0], o[1]); pk.y = pk2(o[2], o[3]); pk.z = pk2(o[4], o[5]); pk.w = pk2(o[6], o[7]);
              *(LAS v4u*)(lds + RQ_AT + (8 * tr + tt) * RQ_AP + 16 * cg) = pk; } }
        __syncthreads();
        f32x4 ar[4], ai_[4];
#pragma unroll
        for (int m = 0; m < 4; ++m) { ar[m] = (f32x4){0.f, 0.f, 0.f, 0.f}; ai_[m] = ar[m]; }
#pragma unroll
        for (int kk = 0; kk < 8; ++kk)
#pragma unroll
            for (int m = 0; m < 4; ++m) { const pg8::bf16x8 xf = *(const LAS pg8::bf16x8*)(lds + RQ_AT + (64 * wr + 16 * m + fr) * RQ_AP + (32 * kk + 8 * fq) * 2);
                ar[m] = __builtin_amdgcn_mfma_f32_16x16x32_bf16(Br[kk], xf, ar[m], 0, 0, 0); ai_[m] = __builtin_amdgcn_mfma_f32_16x16x32_bf16(Bi[kk], xf, ai_[m], 0, 0, 0); }
#pragma unroll
        for (int m = 0; m < 4; ++m) { const int tk = 64 * wr + 16 * m + fr;
            const u32x2v xw = *(const LAS u32x2v*)(lds + RQ_AT + tk * RQ_AP + (64 * g + chl0) * 2);
            const float xc[4] = {bflo(xw.x), bfhi(xw.x), bflo(xw.y), bfhi(xw.y)};
            f32x4 av, bv;
#pragma unroll
            for (int j = 0; j < 4; ++j) { const float rr = sigmoidf_(ar[m][j] + brv[j]), ii = sigmoidf_(ai_[m][j] + biv[j]);
                const float a = __builtin_amdgcn_exp2f(-sp8[j] * rr); av[j] = a; bv[j] = sqrtf(fmaxf(1.f - a * a, 0.f)) * ii * xc[j]; }
            *(LAS f32x4*)(lds + RQ_A + (tk * RQ_SP + chl0) * 4) = av; *(LAS f32x4*)(lds + RQ_B + (tk * RQ_SP + chl0) * 4) = bv; }
        unsigned short gt[16];
        { const bf16* gp = GT + (tok0 + t0 + 16 * wave) * DRNN + LBLK * n + 64 * g + lane;
#pragma unroll
          for (int t = 0; t < 16; ++t) gt[t] = gp[(size_t)t * DRNN]; }
        __syncthreads();
        float sa[16], sb[16];
#pragma unroll
        for (int t = 0; t < 16; ++t) { sa[t] = *(const LAS float*)(lds + RQ_A + ((16 * wave + t) * RQ_SP + lane) * 4); sb[t] = *(const LAS float*)(lds + RQ_B + ((16 * wave + t) * RQ_SP + lane) * 4); }
        { float A = 1.f, H = 0.f;
#pragma unroll
          for (int t = 0; t < 16; ++t) { A *= sa[t]; H = sa[t] * H + sb[t]; }
          *(LAS f32x2v*)(lds + RQ_SEG + (wave * 64 + lane) * 8) = (f32x2v){A, H}; }
        __syncthreads();
        { float h = hin, mine = 0.f;
#pragma unroll
          for (int s = 0; s < 8; ++s) { const f32x2v sh = *(const LAS f32x2v*)(lds + RQ_SEG + (s * 64 + lane) * 8); if (s == wave) mine = h; h = sh.x * h + sh.y; }
          hin = h;
          float hh = mine; bf16* yp = Y + (tok0 + t0 + 16 * wave) * DRNN + LBLK * n + 64 * g + lane;
#pragma unroll
          for (int t = 0; t < 16; ++t) { hh = sa[t] * hh + sb[t]; yp[(size_t)t * DRNN] = (bf16)f2bf(hh * bf2f(gt[t])); } }
    }
}

constexpr int DS_SCP = 8224;
constexpr int DS_VST = 0, DS_IDX = 131072, DS_HIST = DS_IDX + 8 * 512, DS_END = DS_HIST + 8 * 1024;
static_assert(DS_END <= MISC_OFF && 8 * DS_SCP <= DS_IDX, "dsa LDS map");

__device__ __forceinline__ unsigned mbcnt64(unsigned long long m) { return __builtin_amdgcn_mbcnt_hi((unsigned)(m >> 32), __builtin_amdgcn_mbcnt_lo((unsigned)m, 0u)); }
__device__ __forceinline__ void wave_prefix4(unsigned x, unsigned& pre, unsigned& tot) {
    pre = 0u; tot = 0u;
#pragma unroll
    for (int bit = 0; bit < 4; ++bit) { const unsigned long long m = __ballot((x >> bit) & 1u); pre += mbcnt64(m) << bit; tot += (unsigned)__popcll(m) << bit; }
}
__device__ __forceinline__ void hist_find(const LAS unsigned* hist, unsigned need, int lane, unsigned& B, unsigned& above) {
    const v4u c4 = *(const LAS v4u*)(hist + 4 * lane);
    const unsigned s = c4.x + c4.y + c4.z + c4.w;
    unsigned S = s;
#pragma unroll
    for (int o = 1; o < 64; o <<= 1) { const unsigned t = __shfl_down(S, o); if (lane + o < 64) S += t; }
    const unsigned long long mk = __ballot(S >= need);
    const int L = 63 - __builtin_clzll(mk | 1ull);
    unsigned cum = S - s, bin, ab;
    if (cum + c4.w >= need) { bin = 4 * lane + 3; ab = cum; }
    else { cum += c4.w; if (cum + c4.z >= need) { bin = 4 * lane + 2; ab = cum; }
        else { cum += c4.z; if (cum + c4.y >= need) { bin = 4 * lane + 1; ab = cum; } else { cum += c4.y; bin = 4 * lane; ab = cum; } } }
    B = __builtin_amdgcn_readlane(bin, L); above = __builtin_amdgcn_readlane(ab, L);
}
__device__ __forceinline__ unsigned score_key(float s) {
    s = fminf(fmaxf(s, -60000.f), 60000.f);
    unsigned h = (unsigned)__builtin_bit_cast(unsigned short, (_Float16)s); if (h == 0x8000u) h = 0u;
    return (h & 0x8000u) ? (~h & 0xffffu) : (h | 0x8000u);
}

__device__ __forceinline__ void phase_dsa(unsigned char* ws, LAS unsigned char* lds, int tid, int lane, int wave, int bx, int G) {
    const bf16* Qb = (const bf16*)(ws + WS_Q); const bf16* QIb = (const bf16*)(ws + WS_QI); const bf16* Kb = (const bf16*)(ws + WS_K); const bf16* Vb = (const bf16*)(ws + WS_V);
    const bf16* KIb = (const bf16*)(ws + WS_KI); const float* WIb = (const float*)(ws + WS_WI); bf16* AO = (bf16*)(ws + WS_AO);
    const int fr = lane & 15, fq = lane >> 4;
    const int b = bx & 7, jj = bx >> 3, nj = G >> 3;
    LAS unsigned short* idx = (LAS unsigned short*)(lds + DS_IDX + wave * 512);
    LAS unsigned* hist = (LAS unsigned*)(lds + DS_HIST + wave * 1024);
    const size_t tokb = (size_t)b * SEQ;
    for (int i = 0; ; ++i) {
        const int qb = ((i & 1) ? (nj - 1 - jj) : jj) + nj * i;
        if (qb >= SEQ / 8) break;
        const int p0 = 8 * qb, nk16 = (p0 + 8 + 15) & ~15, NT = nk16 >> 4;
        {
            pg8::bf16x8 QA[2][2][2];
#pragma unroll
            for (int grp = 0; grp < 2; ++grp)
#pragma unroll
                for (int hf = 0; hf < 2; ++hf)
#pragma unroll
                    for (int ks = 0; ks < 2; ++ks)
                        QA[grp][hf][ks] = *(const pg8::bf16x8*)(QIb + (tokb + p0 + 4 * grp + (fr >> 2)) * 512 + (4 * hf + (fr & 3)) * 64 + 32 * ks + 8 * fq);
            f32x4 wq[2][2];
#pragma unroll
            for (int grp = 0; grp < 2; ++grp)
#pragma unroll
                for (int hf = 0; hf < 2; ++hf) wq[grp][hf] = *(const f32x4*)(WIb + (tokb + p0 + 4 * grp + fq) * 8 + 4 * hf);
            for (int kt = wave; kt < NT; kt += NWAVES) {
                const bf16* kp = KIb + (tokb + 16 * kt + fr) * 64 + 8 * fq;
                const pg8::bf16x8 k0 = *(const pg8::bf16x8*)(kp), k1 = *(const pg8::bf16x8*)(kp + 32);
                const int key = 16 * kt + fr;
#pragma unroll
                for (int grp = 0; grp < 2; ++grp) {
                    f32x4 d0 = (f32x4){0.f, 0.f, 0.f, 0.f}, d1 = d0;
                    d0 = __builtin_amdgcn_mfma_f32_16x16x32_bf16(QA[grp][0][0], k0, d0, 0, 0, 0); d0 = __builtin_amdgcn_mfma_f32_16x16x32_bf16(QA[grp][0][1], k1, d0, 0, 0, 0);
                    d1 = __builtin_amdgcn_mfma_f32_16x16x32_bf16(QA[grp][1][0], k0, d1, 0, 0, 0); d1 = __builtin_amdgcn_mfma_f32_16x16x32_bf16(QA[grp][1][1], k1, d1, 0, 0, 0);
                    float s = 0.f;
#pragma unroll
                    for (int r = 0; r < 4; ++r) s += wq[grp][0][r] * fmaxf(d0[r], 0.f) + wq[grp][1][r] * fmaxf(d1[r], 0.f);
                    const int q = 4 * grp + fq;
                    const unsigned kk = (key <= p0 + q) ? score_key(s) : 0u;
                    *(LAS unsigned short*)(lds + q * DS_SCP + key * 2) = (unsigned short)kk;
                }
            }
        }
        __syncthreads();
        const int p = p0 + wave, nvalid = p + 1;
        int nsel;
        if (nvalid <= TOPK) {
#pragma unroll
            for (int r = 0; r < 4; ++r) { const int s = lane + 64 * r; idx[s] = (unsigned short)(s < nvalid ? s : 0); }
            nsel = nvalid;
        } else {
            const LAS unsigned char* row = lds + wave * DS_SCP;
            const int nit = (nk16 + 511) >> 9;
            *(LAS v4u*)(hist + 4 * lane) = (v4u){0u, 0u, 0u, 0u};
            for (int it = 0; it < nit; ++it) { const int e0 = it * 512 + lane * 8;
                if (e0 < nk16) { const v4u v = *(const LAS v4u*)(row + e0 * 2);
#pragma unroll
                    for (int x = 0; x < 4; ++x) { const unsigned w = v[x]; __hip_atomic_fetch_add(hist + ((w >> 8) & 255u), 1u, __ATOMIC_RELAXED, __HIP_MEMORY_SCOPE_WORKGROUP); __hip_atomic_fetch_add(hist + (w >> 24), 1u, __ATOMIC_RELAXED, __HIP_MEMORY_SCOPE_WORKGROUP); } } }
            LDS_WAIT();
            unsigned B1, above1; hist_find(hist, (unsigned)TOPK, lane, B1, above1);
            const unsigned need1 = (unsigned)TOPK - above1;
            LDS_WAIT();
            *(LAS v4u*)(hist + 4 * lane) = (v4u){0u, 0u, 0u, 0u};
            for (int it = 0; it < nit; ++it) { const int e0 = it * 512 + lane * 8;
                if (e0 < nk16) { const v4u v = *(const LAS v4u*)(row + e0 * 2);
#pragma unroll
                    for (int x = 0; x < 4; ++x) { const unsigned w = v[x];
                        if (((w >> 8) & 255u) == B1) __hip_atomic_fetch_add(hist + (w & 255u), 1u, __ATOMIC_RELAXED, __HIP_MEMORY_SCOPE_WORKGROUP);
                        if ((w >> 24) == B1) __hip_atomic_fetch_add(hist + ((w >> 16) & 255u), 1u, __ATOMIC_RELAXED, __HIP_MEMORY_SCOPE_WORKGROUP); } } }
            LDS_WAIT();
            unsigned B2, above2; hist_find(hist, need1, lane, B2, above2);
            const unsigned T = (B1 << 8) | B2, need_eq = need1 - above2;
            unsigned cnt = 0u, eqc = 0u;
            for (int it = 0; it < nit; ++it) { const int e0 = it * 512 + lane * 8;
                v4u v = (v4u){0u, 0u, 0u, 0u};
                if (e0 < nk16) v = *(const LAS v4u*)(row + e0 * 2);
                unsigned kv[8];
#pragma unroll
                for (int x = 0; x < 4; ++x) { kv[2 * x] = v[x] & 0xffffu; kv[2 * x + 1] = v[x] >> 16; }
                unsigned neq = 0u;
#pragma unroll
                for (int k = 0; k < 8; ++k) neq += (kv[k] == T) ? 1u : 0u;
                unsigned preq, toteq; wave_prefix4(neq, preq, toteq);
                unsigned run = eqc + preq, selm = 0u, ns = 0u;
#pragma unroll
                for (int k = 0; k < 8; ++k) { const bool eq = kv[k] == T; const bool sel = (kv[k] > T) || (eq && run < need_eq); run += eq ? 1u : 0u; selm |= sel ? (1u << k) : 0u; ns += sel ? 1u : 0u; }
                unsigned pres, tots; wave_prefix4(ns, pres, tots);
                unsigned pos = cnt + pres;
#pragma unroll
                for (int k = 0; k < 8; ++k) if ((selm >> k) & 1u) { if (pos < (unsigned)TOPK) idx[pos] = (unsigned short)(e0 + k); ++pos; }
                cnt += tots; eqc += toteq; }
            nsel = TOPK;
        }
        LDS_WAIT();
        __syncthreads();
        {
            const unsigned vbase = DS_VST + wave * 16384;
            const pg8::bf16x8 q0 = *(const pg8::bf16x8*)(Qb + (tokb + p) * DM + fr * 64 + 8 * fq), q1 = *(const pg8::bf16x8*)(Qb + (tokb + p) * DM + fr * 64 + 32 + 8 * fq);
#define DS_VGATHER(half) do { _Pragma("unroll") for (int u_ = 0; u_ < 16; ++u_) { const int r_ = 8 * u_ + (lane >> 3), cp_ = lane & 7; \
                const int kk_ = idx[128 * (half) + r_]; const int sc_ = ((((cp_ >> 1) ^ ((r_ >> 1) & 3)) << 1) | (cp_ & 1)); \
                __builtin_amdgcn_global_load_lds((const unsigned*)(Vb + (tokb + kk_) * 64 + 8 * sc_), (LAS unsigned*)(lds + vbase + u_ * 1024), 16, 0, 0); } } while (0)
            DS_VGATHER(0);
            f32x4 sc[16];
#pragma unroll
            for (int t = 0; t < 16; ++t) { const int kk = idx[16 * t + fr]; const bf16* kp = Kb + (tokb + kk) * 64 + 8 * fq;
                const pg8::bf16x8 k0 = *(const pg8::bf16x8*)(kp), k1 = *(const pg8::bf16x8*)(kp + 32);
                f32x4 d = (f32x4){0.f, 0.f, 0.f, 0.f};
                d = __builtin_amdgcn_mfma_f32_16x16x32_bf16(k0, q0, d, 0, 0, 0); d = __builtin_amdgcn_mfma_f32_16x16x32_bf16(k1, q1, d, 0, 0, 0);
                sc[t] = d; }
            float mx = -INFINITY;
#pragma unroll
            for (int t = 0; t < 16; ++t)
#pragma unroll
                for (int r = 0; r < 4; ++r) { if (16 * t + 4 * fq + r >= nsel) sc[t][r] = -INFINITY; mx = fmaxf(mx, sc[t][r]); }
            mx = fmaxf(mx, __shfl_xor(mx, 16)); mx = fmaxf(mx, __shfl_xor(mx, 32));
            float sum = 0.f;
#pragma unroll
            for (int t = 0; t < 16; ++t)
#pragma unroll
                for (int r = 0; r < 4; ++r) { const float e = __builtin_amdgcn_exp2f(sc[t][r] - mx); sc[t][r] = e; sum += e; }
            sum += __shfl_xor(sum, 16); sum += __shfl_xor(sum, 32);
            const float rinv = 1.f / sum;
            pg8::bf16x8 pf[8];
#pragma unroll
            for (int s2 = 0; s2 < 8; ++s2) { v4u w; w.x = pg8::cvt_pk_bf16(sc[2 * s2][0], sc[2 * s2][1]); w.y = pg8::cvt_pk_bf16(sc[2 * s2][2], sc[2 * s2][3]);
                w.z = pg8::cvt_pk_bf16(sc[2 * s2 + 1][0], sc[2 * s2 + 1][1]); w.w = pg8::cvt_pk_bf16(sc[2 * s2 + 1][2], sc[2 * s2 + 1][3]); pf[s2] = __builtin_bit_cast(pg8::bf16x8, w); }
            f32x4 o[4];
#pragma unroll
            for (int dt = 0; dt < 4; ++dt) o[dt] = (f32x4){0.f, 0.f, 0.f, 0.f};
            const int trow = 4 * fq + (fr >> 2), tsw = (trow >> 1) & 3;
            const unsigned tbase = vbase + trow * 128 + (fr & 3) * 8;
#pragma unroll
            for (int half = 0; half < 2; ++half) {
                asm volatile("s_waitcnt vmcnt(0)" ::: "memory");
#pragma unroll
                for (int s2l = 0; s2l < 4; ++s2l)
#pragma unroll
                    for (int dt = 0; dt < 4; ++dt) { const unsigned a0 = tbase + s2l * 4096 + ((dt ^ tsw) << 5);
                        const s16x4v lo = __builtin_bit_cast(s16x4v, __builtin_amdgcn_ds_read_tr16_b64_v4i16((LAS s16x4v*)(lds + a0)));
                        const s16x4v hi = __builtin_bit_cast(s16x4v, __builtin_amdgcn_ds_read_tr16_b64_v4i16((LAS s16x4v*)(lds + a0 + 2048)));
                        const pg8::bf16x8 vf = __builtin_shufflevector(lo, hi, 0, 1, 2, 3, 4, 5, 6, 7);
                        o[dt] = __builtin_amdgcn_mfma_f32_16x16x32_bf16(vf, pf[4 * half + s2l], o[dt], 0, 0, 0); }
                if (half == 0) { asm volatile("s_waitcnt lgkmcnt(0)" ::: "memory"); DS_VGATHER(1); }
            }
#undef DS_VGATHER
            bf16* op = AO + (tokb + p) * DM + fr * 64 + 4 * fq;
#pragma unroll
            for (int dt = 0; dt < 4; ++dt) { u32x2v w; w.x = pg8::cvt_pk_bf16(o[dt][0] * rinv, o[dt][1] * rinv); w.y = pg8::cvt_pk_bf16(o[dt][2] * rinv, o[dt][3] * rinv); *(u32x2v*)(op + 16 * dt) = w; }
        }
        asm volatile("s_waitcnt vmcnt(0) lgkmcnt(0)" ::: "memory");
        __syncthreads();
    }
}

struct Args { const float* in[21]; float* out; unsigned char* ws; RopeInv rinv; int ph_lo, ph_hi; };
static_assert(sizeof(Args) == 21 * 8 + 8 + 8 + 128 + 8, "Args has no padding");

__global__ void __launch_bounds__(NTHREADS, 2) mk_fwd(Args args) {
    extern __shared__ __attribute__((aligned(16))) unsigned char lds_raw[];
    LAS unsigned char* lds = (LAS unsigned char*)lds_raw;
    const int tid = threadIdx.x, lane = tid & 63, wave = __builtin_amdgcn_readfirstlane(tid >> 6);
    const int G = gridDim.x, bx = blockIdx.x;
    const int vcu = (G % 8 == 0) ? (bx % 8) * (G / 8) + bx / 8 : bx;
    unsigned char* ws = args.ws;
    volatile LAS unsigned* MISC = (volatile LAS unsigned*)(lds + MISC_OFF);
    if (tid < 64) MISC[tid] = 0u;
    __syncthreads();
    const int lo = args.ph_lo, hi = args.ph_hi;
    XcdBarrier bar; bar.bar = (unsigned*)(ws + WS_CTL) + CW_BAR; bar.x = 0; bar.st = nullptr;
    if (hi - lo > 1) bar = xcd_barrier_post((unsigned*)(ws + WS_CTL) + CW_BAR, MISC + 8);
#define IN(k) (lo <= (k) && (k) < hi)
#define SEAM(k) do { if (IN(k) && IN((k) + 1)) xcd_barrier(bar); } while (0)
    const float* mod = (const float*)(ws + WS_MOD);
    bf16* H = (bf16*)(ws + WS_H);
    const float* x_in = args.in[0]; float* xo = args.out;

    if (IN(0)) { phase_prep(args.in, ws, lds, args.rinv, tid, lane, wave, bx, G); } SEAM(0);
    if (IN(1)) { phase_norm(x_in, args.in[2], mod + 0 * DM, mod + 1 * DM, H, lane, wave, vcu, G); } SEAM(1);
    if (IN(2)) { pg8::Gemm g{H, (const bf16*)(ws + WS_WAIN), MTOK, 2 * DRNN, DM}; pg8::StaticOrder S; S.init(MTOK, 2 * DRNN, G, bx);
        pg8::EpiXbGate E{(bf16*)(ws + WS_XB), (bf16*)(ws + WS_GATE)};
        pg8::gemm_phase<pg8::EpiXbGate, pg8::StaticOrder, true, true>(lds, g, S, E); } SEAM(2);
    if (IN(3)) { phase_rglru(args.in, ws, lds, tid, lane, wave, bx); } SEAM(3);
    if (IN(4)) { pg8::Gemm g{(const bf16*)(ws + WS_Y), (const bf16*)(ws + WS_WAOUT), MTOK, DM, DRNN}; pg8::StaticOrder S; S.init(MTOK, DM, G, bx);
        pg8::EpiRes E{x_in, xo, mod + 2 * DM};
        pg8::gemm_phase<pg8::EpiRes, pg8::StaticOrder, true, true>(lds, g, S, E); } SEAM(4);
    if (IN(5)) { phase_norm(xo, args.in[3], mod + 3 * DM, mod + 4 * DM, H, lane, wave, vcu, G); } SEAM(5);
    if (IN(6)) { pg8::Gemm g{H, (const bf16*)(ws + WS_W1), MTOK, DFF, DM}; pg8::StaticOrder S; S.init(MTOK, DFF, G, bx);
        pg8::EpiRelu2 E{(bf16*)(ws + WS_BIG)};
        pg8::gemm_phase<pg8::EpiRelu2, pg8::StaticOrder, true, true>(lds, g, S, E); } SEAM(6);
    if (IN(7)) { pg8::Gemm g{(const bf16*)(ws + WS_BIG), (const bf16*)(ws + WS_W2), MTOK, DM, DFF}; pg8::StaticOrder S; S.init(MTOK, DM, G, bx);
        pg8::EpiRes E{xo, xo, mod + 5 * DM};
        pg8::gemm_phase<pg8::EpiRes, pg8::StaticOrder, true, true>(lds, g, S, E); } SEAM(7);
    const float* mod1 = mod + NB * NMOD;
    if (IN(8)) { phase_norm(xo, args.in[2] + DM, mod1 + 0 * DM, mod1 + 1 * DM, H, lane, wave, vcu, G); } SEAM(8);
    if (IN(9)) { pg8::Gemm g{H, (const bf16*)(ws + WS_WBIN), MTOK, BINP, DM}; pg8::StaticOrder S; S.init(MTOK, BINP, G, bx);
        pg8::EpiIn1 E{(bf16*)(ws + WS_Q), (bf16*)(ws + WS_QI), (bf16*)(ws + WS_K), (bf16*)(ws + WS_V), (bf16*)(ws + WS_KI), (float*)(ws + WS_WI), (const float*)(ws + WS_ROPE), args.in[16], args.in[17]};
        pg8::gemm_phase<pg8::EpiIn1, pg8::StaticOrder, true, true>(lds, g, S, E); } SEAM(9);
    if (IN(10)) { phase_dsa(ws, lds, tid, lane, wave, bx, G); } SEAM(10);
    if (IN(11)) { pg8::Gemm g{(const bf16*)(ws + WS_AO), (const bf16*)(ws + WS_WBOUT), MTOK, DM, DM}; pg8::StaticOrder S; S.init(MTOK, DM, G, bx);
        pg8::EpiRes E{xo, xo, mod1 + 2 * DM};
        pg8::gemm_phase<pg8::EpiRes, pg8::StaticOrder, true, true>(lds, g, S, E); } SEAM(11);
    if (IN(12)) { phase_norm(xo, args.in[3] + DM, mod1 + 3 * DM, mod1 + 4 * DM, H, lane, wave, vcu, G); } SEAM(12);
    if (IN(13)) { pg8::Gemm g{H, (const bf16*)(ws + WS_W1) + (size_t)DFF * DM, MTOK, DFF, DM}; pg8::StaticOrder S; S.init(MTOK, DFF, G, bx);
        pg8::EpiRelu2 E{(bf16*)(ws + WS_BIG)};
        pg8::gemm_phase<pg8::EpiRelu2, pg8::StaticOrder, true, true>(lds, g, S, E); } SEAM(13);
    if (IN(14)) { pg8::Gemm g{(const bf16*)(ws + WS_BIG), (const bf16*)(ws + WS_W2) + (size_t)DM * DFF, MTOK, DM, DFF}; pg8::StaticOrder S; S.init(MTOK, DM, G, bx);
        pg8::EpiRes E{xo, xo, mod1 + 5 * DM};
        pg8::gemm_phase<pg8::EpiRes, pg8::StaticOrder, true, true>(lds, g, S, E); }
#undef IN
#undef SEAM
}

extern "C" void kernel_launch(void* const* d_in, const int* in_sizes, int n_in, void* d_out, int out_size, void* d_ws, size_t ws_size, hipStream_t stream) {
    static int grid = 0;
    if (grid == 0) {
        if (n_in != 21 || in_sizes[0] != MTOK * DM || out_size != MTOK * DM || ws_size < WS_END) {
            fprintf(stderr, "kernel_launch: unexpected shapes: n_in %d in0 %d out %d ws %zu (need >= %zu); nothing launched\n", n_in, n_in > 0 ? in_sizes[0] : -1, out_size, ws_size, (size_t)WS_END); grid = -1; return; }
        int dev = 0, cus = 0, per_cu = 0;
        if (hipGetDevice(&dev) != hipSuccess || hipDeviceGetAttribute(&cus, hipDeviceAttributeMultiprocessorCount, dev) != hipSuccess) { fprintf(stderr, "kernel_launch: device query failed\n"); grid = -1; return; }
        if (hipFuncSetAttribute((const void*)mk_fwd, hipFuncAttributeMaxDynamicSharedMemorySize, LDS_BYTES) != hipSuccess) { fprintf(stderr, "kernel_launch: hipFuncSetAttribute(%d B LDS) failed\n", LDS_BYTES); grid = -1; return; }
        if (hipOccupancyMaxActiveBlocksPerMultiprocessor(&per_cu, (const void*)mk_fwd, NTHREADS, LDS_BYTES) != hipSuccess || per_cu < 1)
            fprintf(stderr, "kernel_launch: note: occupancy query reports %d workgroups per CU\n", per_cu);
        (void)hipGetLastError();
        grid = cus;
    }
    if (grid < 0) return;
    if (hipMemsetAsync((char*)d_ws + WS_CTL, 0, CTL_ZERO_BYTES, stream) != hipSuccess) { fprintf(stderr, "kernel_launch: memset failed\n"); return; }
    Args a{};
    for (int i = 0; i < 21; ++i) a.in[i] = (const float*)d_in[i];
    a.out = (float*)d_out; a.ws = (unsigned char*)d_ws;
    for (int i = 0; i < 32; ++i) a.rinv.v[i] = powf(10000.0f, -(float)(2 * i) / 64.0f);
    for (int li = 0; li < N_LAUNCHES; ++li) {
        if (N_LAUNCHES == 1) { a.ph_lo = 0; a.ph_hi = N_PHASES; } else { a.ph_lo = li; a.ph_hi = li + 1; }
        hipLaunchKernelGGL(mk_fwd, dim3(grid), dim3(NTHREADS), LDS_BYTES, stream, a);
        const hipError_t le = hipPeekAtLastError();
        if (le != hipSuccess) { fprintf(stderr, "kernel_launch: launch %d failed: %s\n", li, hipGetErrorName(le)); break; }
    }
}
```

```cpp
#include <hip/hip_runtime.h>
#include <cstdio>
#include <cstdint>
#include <cmath>
#define MK_N_LAUNCHES 1
#define PROBE_PH -1
#define PROBE_N 1
#define PROBE_MASK 7
namespace pg8 {
#define PG8_LAS __attribute__((address_space(3)))
typedef unsigned short bf16_t;
typedef short bf16x8 __attribute__((ext_vector_type(8)));
typedef float f32x4 __attribute__((ext_vector_type(4)));
typedef unsigned u32x4 __attribute__((ext_vector_type(4)));
constexpr int BM = 256, BK = 64, HALF = 128, HTB = HALF * BK * 2  , STAGE_BYTES = 8 * HTB, NXCD = 8, WGM = 8;

__host__ __device__ __forceinline__ int lds_byte(int r, int c) { const int st = (r >> 4) * 2 + (c >> 5), rr = r & 15, cc = c & 31, ob = rr * 64 + cc * 2; return st * 1024 + (ob ^ (((ob >> 9) & 1) << 5)); }
__host__ __device__ __forceinline__ void stage_rc(int b, int& R, int& C) { const int st = b / 1024, sb = b % 1024, swz = sb ^ (((sb >> 9) & 1) << 5); R = (st >> 1) * 16 + swz / 64; C = (st & 1) * 32 + (swz % 64) / 2; }
__host__ __device__ __forceinline__ int perm32(int rho) { const int n = rho >> 4, i = rho & 15; return 8 * (i >> 2) + 4 * n + (i & 3); }

struct Unit { int pm, pn; };
struct Gemm { const bf16_t* A; const bf16_t* Bt; int M, N, K; };

struct StaticOrder {
    int nM, nN, nwg, G, c;
    __host__ __device__ void init(int M, int N, int G_, int c_) { nM = M / BM; nN = N / BM; nwg = nM * nN; G = G_; c = c_; }
    __host__ __device__ bool next(int i, Unit& u) const {
        const long L = (long)i * G + c; if (L >= nwg) return false;
        int wgid = (int)L; { const int q = nwg / NXCD, r = nwg % NXCD, xcd = wgid % NXCD, off = wgid / NXCD; wgid = (xcd < r ? xcd * (q + 1) : r * (q + 1) + (xcd - r) * q) + off; }
        const int nig = WGM * nN, gid = wgid / nig, fm = gid * WGM, gsz = (nM - fm) < WGM ? (nM - fm) : WGM;
        u.pm = fm + ((wgid % nig) % gsz); u.pn = (wgid % nig) / gsz; return true;
    }
    __device__ __forceinline__ void a_ready(const Unit&) const {}
    __device__ __forceinline__ void done(const Unit&) const {}
};

__device__ __forceinline__ unsigned cvt_pk_bf16(float lo, float hi) { unsigned r; asm volatile("v_cvt_pk_bf16_f32 %0, %1, %2" : "=v"(r) : "v"(lo), "v"(hi)); return r; }
typedef float f32x2 __attribute__((ext_vector_type(2)));
template <class Epi, class Sched, bool ALIGN_EPI = false, bool SP2 = false>
__device__ __forceinline__ void gemm_phase(PG8_LAS unsigned char* lds, const Gemm g, const Sched& S, const Epi& E) {
    const int tid = threadIdx.x, wid = __builtin_amdgcn_readfirstlane(tid >> 6), lane = tid & 63, wr = wid >> 2, wc = wid & 3, fr = lane & 15, fq = lane >> 4;
    const int K = g.K, nt = K / BK;
    unsigned voffA[2], voffB[2];
#pragma unroll
    for (int i = 0; i < 2; ++i) { int R, C; stage_rc(tid * 16 + i * 8192, R, C); const int Rb = Epi::PERM ? ((R & ~31) + perm32(R & 31)) : R;
        voffA[i] = (unsigned)(R * K + C) * 2u; voffB[i] = (unsigned)(Rb * K + C) * 2u; }
    const size_t kstep = (size_t)(BK * 2);
    const size_t hstep = (size_t)HALF * K * 2;
    const size_t tstep = 2 * hstep;
    const unsigned ldsw = (unsigned)wid * 1024u;
    const int aoff = lds_byte(wr * 64 + fr, fq * 8), boff = lds_byte(wc * 32 + fr, fq * 8);
#define PG8_SA(b, h) (((b) * 2 + (h)) * HTB)
#define PG8_SB(b, h) ((4 + (b) * 2 + (h)) * HTB)
#define PG8_STAGE(bufoff, gbase, voff) do { _Pragma("unroll") for (int _i = 0; _i < 2; ++_i) \
        __builtin_amdgcn_global_load_lds((const unsigned*)((const char*)(gbase) + (voff)[_i]), (PG8_LAS unsigned*)(lds + (bufoff) + ldsw + _i * 8192), 16, 0, 0); } while (0)
#define PG8_LDA(dst, b, h) do { _Pragma("unroll") for (int m = 0; m < 4; ++m) _Pragma("unroll") for (int k = 0; k < 2; ++k) dst[m][k] = *(const PG8_LAS bf16x8*)(lds + PG8_SA(b, h) + aoff + m * 2048 + k * 1024); } while (0)
#define PG8_LDB(dst, b, h) do { _Pragma("unroll") for (int n = 0; n < 2; ++n) _Pragma("unroll") for (int k = 0; k < 2; ++k) dst[n][k] = *(const PG8_LAS bf16x8*)(lds + PG8_SB(b, h) + boff + n * 2048 + k * 1024); } while (0)
#define PG8_MMA(ai, bj, At, Bt) do { __builtin_amdgcn_s_setprio(1); _Pragma("unroll") for (int m = 0; m < 4; ++m) _Pragma("unroll") for (int n = 0; n < 2; ++n) _Pragma("unroll") for (int k = 0; k < 2; ++k) \
        acc[ai][bj][m][n] = __builtin_amdgcn_mfma_f32_16x16x32_bf16(Bt[n][k], At[m][k], acc[ai][bj][m][n], 0, 0, 0); __builtin_amdgcn_s_setprio(0); } while (0)
#define PG8_WAIT_V(n) asm volatile("s_waitcnt vmcnt(" #n ")" ::: "memory")
#define PG8_WAIT_L(n) asm volatile("s_waitcnt lgkmcnt(" #n ")" ::: "memory")
#define PG8_BAR __builtin_amdgcn_s_barrier()
#define PG8_SCHED __builtin_amdgcn_sched_barrier(0)
    Unit cur, nxt; int ui = 0;
    if (!S.next(0, cur)) return;
    f32x4 acc[2][2][4][2];
#pragma unroll
    for (int a = 0; a < 2; ++a)
#pragma unroll
        for (int b = 0; b < 2; ++b)
#pragma unroll
            for (int m = 0; m < 4; ++m)
#pragma unroll
                for (int n = 0; n < 2; ++n) acc[a][b][m][n] = (f32x4){0.f, 0.f, 0.f, 0.f};
    bf16x8 At[4][2], B0[2][2], B1[2][2];
    const char* cA = (const char*)g.A + (size_t)cur.pm * tstep; const char* cB = (const char*)g.Bt + (size_t)cur.pn * tstep;
    S.a_ready(cur);
    if constexpr (SP2) {
        PG8_STAGE(PG8_SB(0, 0), cB, voffB); PG8_STAGE(PG8_SB(0, 1), cB + hstep, voffB); PG8_STAGE(PG8_SA(0, 0), cA, voffA); PG8_STAGE(PG8_SA(0, 1), cA + hstep, voffA);
        if (wr == 1) PG8_BAR;
        PG8_WAIT_V(2); PG8_BAR;
        PG8_STAGE(PG8_SB(1, 0), cB + kstep, voffB); PG8_STAGE(PG8_SA(1, 0), cA + kstep, voffA); PG8_STAGE(PG8_SB(1, 1), cB + hstep + kstep, voffB);
        PG8_WAIT_V(6); PG8_BAR;
    } else {
        PG8_STAGE(PG8_SB(0, 0), cB, voffB); PG8_STAGE(PG8_SA(0, 0), cA, voffA); PG8_STAGE(PG8_SB(0, 1), cB + hstep, voffB); PG8_STAGE(PG8_SA(0, 1), cA + hstep, voffA);
        if (wr == 1) PG8_BAR;
        PG8_WAIT_V(4); PG8_BAR;
        PG8_STAGE(PG8_SB(1, 0), cB + kstep, voffB); PG8_STAGE(PG8_SA(1, 0), cA + kstep, voffA); PG8_STAGE(PG8_SB(1, 1), cB + hstep + kstep, voffB);
        PG8_WAIT_V(6); PG8_BAR;
    }
    for (;;) {
        const bool has_next = S.next(ui + 1, nxt);
        const char* nA = has_next ? (const char*)g.A + (size_t)nxt.pm * tstep : cA; const char* nB = has_next ? (const char*)g.Bt + (size_t)nxt.pn * tstep : cB;
        for (int t = 0; t < nt; t += 2) {
            const bool last = (t == nt - 2);
            const char* a1 = cA + (size_t)(t + 1) * kstep;
            const char* a2 = last ? nA : cA + (size_t)(t + 2) * kstep; const char* b2 = last ? nB : cB + (size_t)(t + 2) * kstep;
            const char* a3 = a2 + kstep; const char* b3 = b2 + kstep;
            if (last && has_next) S.a_ready(nxt);
            if constexpr (SP2) {
            PG8_LDB(B0, 0, 0); PG8_LDB(B1, 0, 1); PG8_SCHED; PG8_LDA(At, 0, 0); PG8_STAGE(PG8_SA(1, 1), a1 + hstep, voffA);
            PG8_WAIT_V(8); PG8_WAIT_L(0); PG8_BAR; PG8_MMA(0, 0, At, B0); PG8_MMA(0, 1, At, B1); PG8_BAR; PG8_SCHED;
            PG8_LDA(At, 0, 1); PG8_STAGE(PG8_SB(0, 0), b2, voffB); PG8_STAGE(PG8_SB(0, 1), b2 + hstep, voffB); PG8_STAGE(PG8_SA(0, 0), a2, voffA);
            PG8_WAIT_V(8); PG8_WAIT_L(0); PG8_BAR; PG8_MMA(1, 0, At, B0); PG8_MMA(1, 1, At, B1); PG8_BAR; PG8_SCHED;
            PG8_LDB(B0, 1, 0); PG8_LDB(B1, 1, 1); PG8_SCHED; PG8_LDA(At, 1, 0); PG8_STAGE(PG8_SA(0, 1), a2 + hstep, voffA);
            PG8_WAIT_V(8); PG8_WAIT_L(0); PG8_BAR; PG8_MMA(0, 0, At, B0); PG8_MMA(0, 1, At, B1); PG8_BAR; PG8_SCHED;
            PG8_LDA(At, 1, 1); PG8_STAGE(PG8_SB(1, 0), b3, voffB); PG8_STAGE(PG8_SB(1, 1), b3 + hstep, voffB); PG8_STAGE(PG8_SA(1, 0), a3, voffA);
            PG8_WAIT_V(8); PG8_WAIT_L(0); PG8_BAR; PG8_MMA(1, 0, At, B0); PG8_MMA(1, 1, At, B1); PG8_BAR; PG8_SCHED;
            } else {
            PG8_LDB(B0, 0, 0); PG8_SCHED; PG8_LDA(At, 0, 0); PG8_STAGE(PG8_SA(1, 1), a1 + hstep, voffA);
            PG8_WAIT_L(8); PG8_BAR; PG8_WAIT_L(0); PG8_MMA(0, 0, At, B0); PG8_BAR; PG8_SCHED;
            PG8_LDB(B1, 0, 1); PG8_STAGE(PG8_SB(0, 0), b2, voffB);
            PG8_BAR; PG8_WAIT_L(0); PG8_MMA(0, 1, At, B1); PG8_BAR;
            PG8_LDA(At, 0, 1); PG8_STAGE(PG8_SA(0, 0), a2, voffA);
            PG8_BAR; PG8_WAIT_L(0); PG8_MMA(1, 0, At, B0); PG8_BAR; PG8_SCHED;
            PG8_STAGE(PG8_SB(0, 1), b2 + hstep, voffB);
            PG8_WAIT_V(6); PG8_BAR; PG8_MMA(1, 1, At, B1); PG8_BAR;
            PG8_LDB(B0, 1, 0); PG8_SCHED; PG8_LDA(At, 1, 0); PG8_STAGE(PG8_SA(0, 1), a2 + hstep, voffA);
            PG8_WAIT_L(8); PG8_BAR; PG8_WAIT_L(0); PG8_MMA(0, 0, At, B0); PG8_BAR; PG8_SCHED;
            PG8_LDB(B1, 1, 1); PG8_STAGE(PG8_SB(1, 0), b3, voffB);
            PG8_BAR; PG8_WAIT_L(0); PG8_MMA(0, 1, At, B1); PG8_BAR;
            PG8_LDA(At, 1, 1); PG8_STAGE(PG8_SA(1, 0), a3, voffA);
            PG8_BAR; PG8_WAIT_L(0); PG8_MMA(1, 0, At, B0); PG8_BAR; PG8_SCHED;
            PG8_STAGE(PG8_SB(1, 1), b3 + hstep, voffB);
            PG8_WAIT_V(6); PG8_BAR; PG8_MMA(1, 1, At, B1); PG8_BAR;
            }
        }
        if constexpr (ALIGN_EPI) { if (wr == 0) PG8_BAR; }
        if constexpr (!Epi::AFTER_DRAIN) { E(acc, cur, wr, wc, fr, fq); S.done(cur); }
        if (!has_next) break;
#pragma unroll
        for (int a = 0; a < 2; ++a)
#pragma unroll
            for (int b = 0; b < 2; ++b)
#pragma unroll
                for (int m = 0; m < 4; ++m)
#pragma unroll
                    for (int n = 0; n < 2; ++n) acc[a][b][m][n] = (f32x4){0.f, 0.f, 0.f, 0.f};
        cur = nxt; cA = nA; cB = nB; ++ui;
        if constexpr (ALIGN_EPI) { if (wr == 1) PG8_BAR; }
    }
    PG8_WAIT_V(0);
    if constexpr (!ALIGN_EPI) { if (wr == 0) PG8_BAR; }
    PG8_BAR;
    if constexpr (Epi::AFTER_DRAIN) { E.fused(acc, cur, wr, wc, fr, fq, lds, wid, lane); S.done(cur); }
#undef PG8_SA
#undef PG8_SB
#undef PG8_STAGE
#undef PG8_LDA
#undef PG8_LDB
#undef PG8_MMA
#undef PG8_WAIT_V
#undef PG8_WAIT_L
#undef PG8_BAR
#undef PG8_SCHED
}
}
#define GAS __attribute__((address_space(1)))
#define LAS __attribute__((address_space(3)))
typedef unsigned short bf16;
typedef unsigned v4u __attribute__((ext_vector_type(4)));
typedef float f32x4 __attribute__((ext_vector_type(4)));
typedef short bf16x8 __attribute__((ext_vector_type(8)));
typedef GAS unsigned gu32;
typedef GAS unsigned long long gu64;
#define RLX_AGENT __ATOMIC_RELAXED, __HIP_MEMORY_SCOPE_AGENT
#define LDS_WAIT() asm volatile("s_waitcnt lgkmcnt(0)" ::: "memory")
#define VM_WAIT() asm volatile("s_waitcnt vmcnt(0)" ::: "memory")
__device__ __forceinline__ unsigned long long rt() { return __builtin_amdgcn_s_memrealtime(); }
__device__ __forceinline__ unsigned f2bf(float f) { unsigned u = __builtin_bit_cast(unsigned, f); return (u + 0x7fffu + ((u >> 16) & 1u)) >> 16; }
__device__ __forceinline__ unsigned pk2(float lo, float hi) { return f2bf(lo) | (f2bf(hi) << 16); }

#define XB_TMO      128
#define XB_XCNT(j)  (256  + 64 * (j))
#define XB_XSUB(j)  (1280 + 64 * (j))
#define XB_XGEN(j)  (2304 + 64 * (j))
#define XB_TOP      3328
#define XB_TOPGEN   3392
#define XCD_BAR_WORDS 3456
#define XB_SPIN_CAP (1u << 18)

__device__ __forceinline__ unsigned xb_ld(unsigned* p)              { return __hip_atomic_load(p, __ATOMIC_RELAXED, __HIP_MEMORY_SCOPE_AGENT); }
__device__ __forceinline__ unsigned xb_add(unsigned* p, unsigned v) { return __hip_atomic_fetch_add(p, v, __ATOMIC_RELAXED, __HIP_MEMORY_SCOPE_AGENT); }
__device__ __forceinline__ unsigned xb_xcc_id() { return (unsigned)__builtin_amdgcn_s_getreg((3 << 11) | 20) & 0xFu; }
#define XB_SPIN(cond, bar) do { unsigned _sp = 0; while (cond) { __builtin_amdgcn_s_sleep(1); \
    if ((++_sp & 255u) == 0u) { if (xb_ld(&(bar)[XB_TMO])) break; if (_sp > XB_SPIN_CAP) { atomicAdd(&(bar)[XB_TMO], 1u); break; } } } } while (0)

struct XcdBarrier {
    unsigned* bar; unsigned x;
    volatile LAS unsigned* st;
};

__device__ __forceinline__ XcdBarrier xcd_barrier_post(unsigned* bar, volatile LAS unsigned* st) {
    XcdBarrier b; b.bar = bar; b.x = xb_xcc_id(); b.st = st;
    if (threadIdx.x == 0) (void)xb_add(&bar[XB_XCNT(b.x)], 1u);
    return b;
}
__device__ __forceinline__ void xcd_barrier_complete(unsigned* bar, unsigned x, unsigned& nloc, unsigned& nx) {
    const unsigned G = gridDim.x * gridDim.y * gridDim.z;
    unsigned sum, cnt, mine, sp = 0u;
    for (;;) {
        sum = 0u; cnt = 0u; mine = 0u;
#pragma unroll
        for (unsigned j = 0; j < 16; ++j) { const unsigned c = xb_ld(&bar[XB_XCNT(j)]); sum += c; cnt += (c > 0u) ? 1u : 0u; mine = (j == x) ? c : mine; }
        if (sum == G) break;
        __builtin_amdgcn_s_sleep(1);
        if ((++sp & 255u) == 0u) { if (xb_ld(&bar[XB_TMO])) break; if (sp > XB_SPIN_CAP) { atomicAdd(&bar[XB_TMO], 1u); break; } }
    }
    nloc = mine > 0u ? mine : 1u; nx = cnt > 0u ? cnt : 1u;
}

__device__ __forceinline__ void xcd_barrier(const XcdBarrier& b) {
    asm volatile("s_waitcnt vmcnt(0)" ::: "memory");
    __syncthreads();
    if (threadIdx.x == 0) {
        unsigned* bar = b.bar;
        __builtin_amdgcn_s_waitcnt(0);
        unsigned nloc = b.st[0], nx = b.st[1];
        if (nloc == 0u) { xcd_barrier_complete(bar, b.x, nloc, nx); b.st[0] = nloc; b.st[1] = nx; }
        const unsigned old = xb_add(&bar[XB_XSUB(b.x)], 1u);
        const unsigned gen = old / nloc;
        if (old + 1u == (gen + 1u) * nloc) {
            __builtin_amdgcn_fence(__ATOMIC_RELEASE, "agent");
            asm volatile("s_waitcnt vmcnt(0)" ::: "memory");
            const unsigned og = xb_add(&bar[XB_TOP], 1u);
            const unsigned tg = og / nx;
            if (og + 1u == (tg + 1u) * nx) xb_add(&bar[XB_TOPGEN], 1u);
            else XB_SPIN(xb_ld(&bar[XB_TOPGEN]) == tg, bar);
            __builtin_amdgcn_fence(__ATOMIC_ACQUIRE, "agent");
            xb_add(&bar[XB_XGEN(b.x)], 1u);
            asm volatile("s_waitcnt vmcnt(0)" ::: "memory");
        } else {
            XB_SPIN(xb_ld(&bar[XB_XGEN(b.x)]) == gen, bar);
            __builtin_amdgcn_fence(__ATOMIC_ACQUIRE, "agent");
            asm volatile("s_waitcnt vmcnt(0)" ::: "memory");
        }
    }
    __syncthreads();
}

constexpr int NB = 8, SEQ = 4096, DM = 1024, MTOK = NB * SEQ, DFF = 4096, DRNN = 1280, NLB = 5, LBLK = 256;
constexpr int NHEAD = 16, HD = 64, IH = 8, TOPK = 256, BIN = 1736, BINP = 1792, NMOD = 6 * DM;
constexpr float RMS_EPS = 1e-6f;
constexpr int NWAVES = 8, NTHREADS = 512;
constexpr int N_PHASES = 15;
constexpr int N_LAUNCHES = MK_N_LAUNCHES;

constexpr size_t MiB = 1u << 20;
constexpr size_t WS_CTL = 0, CTL_ZERO_BYTES = 64 * 1024;
constexpr int CW_BAR = 4096;
constexpr size_t WS_MOD = 1 * MiB;
constexpr size_t WS_ROPE = 2 * MiB;
constexpr size_t WS_WAIN = 4 * MiB;
constexpr size_t WS_WAOUT = 9 * MiB;
constexpr size_t WS_WGATE = 12 * MiB;
constexpr size_t WS_WBIN = 14 * MiB;
constexpr size_t WS_WBOUT = 18 * MiB;
constexpr size_t WS_W1 = 20 * MiB;
constexpr size_t WS_W2 = 36 * MiB;
constexpr size_t WS_H = 64 * MiB;
constexpr size_t WS_BIG = 128 * MiB;
constexpr size_t WS_XB = WS_BIG, WS_GATE = WS_BIG + 80 * MiB, WS_Y = WS_BIG + 160 * MiB;
constexpr size_t WS_Q = WS_BIG, WS_QI = WS_BIG + 64 * MiB, WS_KV = WS_BIG + 96 * MiB  , WS_KI = WS_BIG + 104 * MiB, WS_WI = WS_BIG + 108 * MiB, WS_AO = WS_BIG + 112 * MiB;
constexpr size_t WS_XR = 384 * MiB;
constexpr size_t WS_END = 448 * MiB;

constexpr int LDS_BYTES = 163840;
constexpr int MISC_OFF = LDS_BYTES - 256;

typedef float f32x2v __attribute__((ext_vector_type(2)));
typedef __bf16 bf16x2_t __attribute__((ext_vector_type(2)));
__device__ __forceinline__ unsigned cvtpk(float lo, float hi) { const f32x2v v = {lo, hi}; return __builtin_bit_cast(unsigned, __builtin_convertvector(v, bf16x2_t)); }
#define pk2 cvtpk
typedef unsigned u32x2v __attribute__((ext_vector_type(2)));
typedef short s16x4v __attribute__((ext_vector_type(4)));

__device__ __forceinline__ float wave_sum(float v) {
#pragma unroll
    for (int o = 1; o < 64; o <<= 1) v += __shfl_xor(v, o);
    return v;
}
__device__ __forceinline__ float bf2f(unsigned short h) { return __builtin_bit_cast(float, (unsigned)h << 16); }
__device__ __forceinline__ float bflo(unsigned w) { return __builtin_bit_cast(float, w << 16); }
__device__ __forceinline__ float bfhi(unsigned w) { return __builtin_bit_cast(float, w & 0xffff0000u); }
__device__ __forceinline__ float sigmoidf_(float x) { return __builtin_amdgcn_rcpf(1.f + __builtin_amdgcn_exp2f(-1.4426950408889634f * x)); }

namespace pg8 {
__device__ __forceinline__ f32x2 gelu_tanh2(f32x2 x) {
    f32x2 u = (x * ((x * x) * 0.044715f + 1.0f)) * -2.302208198f;
    u.x = __builtin_amdgcn_exp2f(u.x); u.y = __builtin_amdgcn_exp2f(u.y); u = u + 1.0f;
    f32x2 r; r.x = __builtin_amdgcn_rcpf(u.x); r.y = __builtin_amdgcn_rcpf(u.y); return x * r;
}
struct EpiXbGate {
    static constexpr bool PERM = true, AFTER_DRAIN = false;
    bf16_t* XB; bf16_t* GT;
    __device__ __forceinline__ void operator()(const f32x4 (&acc)[2][2][4][2], const Unit& u, int wr, int wc, int fr, int fq) const {
        const bool isg = u.pn >= 5; bf16_t* base = isg ? GT : XB;
        const int row0 = u.pm * BM + wr * 64 + fr, col0 = (isg ? u.pn - 5 : u.pn) * BM + wc * 32 + 8 * fq;
#pragma unroll
        for (int ai = 0; ai < 2; ++ai)
#pragma unroll
            for (int m = 0; m < 4; ++m) { bf16_t* rowp = base + (size_t)(row0 + ai * HALF + m * 16) * DRNN + col0;
#pragma unroll
                for (int bj = 0; bj < 2; ++bj) { const f32x4 v0 = acc[ai][bj][m][0], v1 = acc[ai][bj][m][1];
                    f32x2 p0 = (f32x2){v0[0], v0[1]}, p1 = (f32x2){v0[2], v0[3]}, p2 = (f32x2){v1[0], v1[1]}, p3 = (f32x2){v1[2], v1[3]};
                    if (isg) { p0 = gelu_tanh2(p0); p1 = gelu_tanh2(p1); p2 = gelu_tanh2(p2); p3 = gelu_tanh2(p3); }
                    u32x4 w; w.x = cvtpk(p0.x, p0.y); w.y = cvtpk(p1.x, p1.y); w.z = cvtpk(p2.x, p2.y); w.w = cvtpk(p3.x, p3.y);
                    *(u32x4*)(rowp + bj * HALF) = w; } }
    }
};
template <bool RB, bool OB> struct EpiRes {
    static constexpr bool PERM = OB, AFTER_DRAIN = false;
    const void* res; void* out; const float* gate;
    __device__ __forceinline__ void operator()(const f32x4 (&acc)[2][2][4][2], const Unit& u, int wr, int wc, int fr, int fq) const {
        const int row0 = u.pm * BM + wr * 64 + fr, b = u.pm >> 4;
        const int colb = u.pn * BM + wc * 32 + (PERM ? 8 * fq : 4 * fq), nst = PERM ? 4 : 16;
        f32x2 gv[2][2][2];
#pragma unroll
        for (int bj = 0; bj < 2; ++bj)
#pragma unroll
            for (int n = 0; n < 2; ++n) { const f32x4 t = *(const f32x4*)(gate + b * NMOD + colb + bj * HALF + n * nst); gv[bj][n][0] = (f32x2){t[0], t[1]}; gv[bj][n][1] = (f32x2){t[2], t[3]}; }
#pragma unroll
        for (int ai = 0; ai < 2; ++ai)
#pragma unroll
            for (int m = 0; m < 4; ++m) { const size_t off = (size_t)(row0 + ai * HALF + m * 16) * DM + colb;
                f32x2 rv[2][2][2];
#pragma unroll
                for (int bj = 0; bj < 2; ++bj) {
                    if (RB && PERM) { const u32x4 w = *(const u32x4*)((const bf16_t*)res + off + bj * HALF);
                        rv[bj][0][0] = (f32x2){__builtin_bit_cast(float, w.x << 16), __builtin_bit_cast(float, w.x & 0xffff0000u)}; rv[bj][0][1] = (f32x2){__builtin_bit_cast(float, w.y << 16), __builtin_bit_cast(float, w.y & 0xffff0000u)};
                        rv[bj][1][0] = (f32x2){__builtin_bit_cast(float, w.z << 16), __builtin_bit_cast(float, w.z & 0xffff0000u)}; rv[bj][1][1] = (f32x2){__builtin_bit_cast(float, w.w << 16), __builtin_bit_cast(float, w.w & 0xffff0000u)}; }
                    else {
#pragma unroll
                        for (int n = 0; n < 2; ++n) {
                            if (RB) { const unsigned long long w = *(const unsigned long long*)((const bf16_t*)res + off + bj * HALF + n * nst); const unsigned lo = (unsigned)w, hi = (unsigned)(w >> 32);
                                rv[bj][n][0] = (f32x2){__builtin_bit_cast(float, lo << 16), __builtin_bit_cast(float, lo & 0xffff0000u)}; rv[bj][n][1] = (f32x2){__builtin_bit_cast(float, hi << 16), __builtin_bit_cast(float, hi & 0xffff0000u)}; }
                            else { const f32x4 t = *(const f32x4*)((const float*)res + off + bj * HALF + n * nst); rv[bj][n][0] = (f32x2){t[0], t[1]}; rv[bj][n][1] = (f32x2){t[2], t[3]}; } } } }
#pragma unroll
                for (int bj = 0; bj < 2; ++bj) { f32x2 o[2][2];
#pragma unroll
                    for (int n = 0; n < 2; ++n) { const f32x4 a = acc[ai][bj][m][n]; o[n][0] = rv[bj][n][0] + gv[bj][n][0] * (f32x2){a[0], a[1]}; o[n][1] = rv[bj][n][1] + gv[bj][n][1] * (f32x2){a[2], a[3]}; }
                    if (OB) { u32x4 w; w.x = cvtpk(o[0][0].x, o[0][0].y); w.y = cvtpk(o[0][1].x, o[0][1].y); w.z = cvtpk(o[1][0].x, o[1][0].y); w.w = cvtpk(o[1][1].x, o[1][1].y);
                        *(u32x4*)((bf16_t*)out + off + bj * HALF) = w; }
                    else { *(f32x4*)((float*)out + off + bj * HALF) = (f32x4){o[0][0].x, o[0][0].y, o[0][1].x, o[0][1].y}; *(f32x4*)((float*)out + off + bj * HALF + nst) = (f32x4){o[1][0].x, o[1][0].y, o[1][1].x, o[1][1].y}; } }
                asm volatile("" ::: "memory"); }
    }
};
struct EpiRelu2 {
    static constexpr bool PERM = true, AFTER_DRAIN = false;
    bf16_t* O;
    __device__ __forceinline__ void operator()(const f32x4 (&acc)[2][2][4][2], const Unit& u, int wr, int wc, int fr, int fq) const {
        const int row0 = u.pm * BM + wr * 64 + fr, col0 = u.pn * BM + wc * 32 + 8 * fq;
#pragma unroll
        for (int ai = 0; ai < 2; ++ai)
#pragma unroll
            for (int m = 0; m < 4; ++m) { bf16_t* rowp = O + (size_t)(row0 + ai * HALF + m * 16) * DFF + col0;
#pragma unroll
                for (int bj = 0; bj < 2; ++bj) { const f32x4 v0 = acc[ai][bj][m][0], v1 = acc[ai][bj][m][1];
                    f32x2 p0 = (f32x2){__builtin_amdgcn_fmed3f(v0[0], 0.f, 3.0e38f), __builtin_amdgcn_fmed3f(v0[1], 0.f, 3.0e38f)}, p1 = (f32x2){__builtin_amdgcn_fmed3f(v0[2], 0.f, 3.0e38f), __builtin_amdgcn_fmed3f(v0[3], 0.f, 3.0e38f)};
                    f32x2 p2 = (f32x2){__builtin_amdgcn_fmed3f(v1[0], 0.f, 3.0e38f), __builtin_amdgcn_fmed3f(v1[1], 0.f, 3.0e38f)}, p3 = (f32x2){__builtin_amdgcn_fmed3f(v1[2], 0.f, 3.0e38f), __builtin_amdgcn_fmed3f(v1[3], 0.f, 3.0e38f)};
                    p0 = p0 * p0; p1 = p1 * p1; p2 = p2 * p2; p3 = p3 * p3;
                    u32x4 w; w.x = cvtpk(p0.x, p0.y); w.y = cvtpk(p1.x, p1.y); w.z = cvtpk(p2.x, p2.y); w.w = cvtpk(p3.x, p3.y);
                    *(u32x4*)(rowp + bj * HALF) = w; } }
    }
};
struct EpiIn1 {
    static constexpr bool PERM = true, AFTER_DRAIN = false;
    bf16_t *Q, *QI, *K, *V, *KI; float* WI; const float* rope; const float *qg, *kg;
    __device__ __forceinline__ void operator()(const f32x4 (&acc)[2][2][4][2], const Unit& u, int wr, int wc, int fr, int fq) const {
        const int pn = u.pn;
        int kind;
        bf16_t* dst; int pitch, hoff;
        if (pn < 4) { kind = 0; dst = Q; pitch = DM; hoff = (4 * pn + wc) * 64; }
        else if (pn < 6) { kind = 1; dst = QI; pitch = 512; hoff = (4 * (pn - 4) + wc) * 64; }
        else if (wc == 0) { kind = 2; dst = K; pitch = 128; hoff = 0; }
        else if (wc == 1) { kind = 3; dst = KI; pitch = 64; hoff = 0; }
        else if (wc == 2) { kind = 4; dst = V; pitch = 128; hoff = 0; }
        else { kind = 5; dst = nullptr; pitch = 0; hoff = 0; }
        const bool donorm = (kind == 0 || kind == 2), dorope = (kind <= 3);
        const float osc = (kind == 0) ? 0.125f * 1.4426950408889634f : 1.f;
        f32x4 g1[2], g2[2];
#pragma unroll
        for (int n = 0; n < 2; ++n) { g1[n] = (f32x4){1.f, 1.f, 1.f, 1.f}; g2[n] = g1[n]; }
        if (kind == 0) {
#pragma unroll
            for (int n = 0; n < 2; ++n) { g1[n] = *(const f32x4*)(qg + 8 * fq + 4 * n); g2[n] = *(const f32x4*)(qg + 32 + 8 * fq + 4 * n); } }
        if (kind == 2) {
#pragma unroll
            for (int n = 0; n < 2; ++n) { g1[n] = *(const f32x4*)(kg + 8 * fq + 4 * n); g2[n] = *(const f32x4*)(kg + 32 + 8 * fq + 4 * n); } }
#pragma unroll
        for (int ai = 0; ai < 2; ++ai)
#pragma unroll
            for (int m = 0; m < 4; ++m) {
                const int row = u.pm * BM + ai * HALF + wr * 64 + m * 16 + fr, pos = row & (SEQ - 1);
                f32x4 x1[2], x2[2];
#pragma unroll
                for (int n = 0; n < 2; ++n) { x1[n] = acc[ai][0][m][n]; x2[n] = acc[ai][1][m][n]; }
                if (kind == 5) {
                    if (fq == 0) { *(f32x4*)(WI + (size_t)row * 8) = x1[0]; *(f32x4*)(WI + (size_t)row * 8 + 4) = x1[1]; }
                    continue;
                }
                if (donorm) {
                    float ss = 0.f;
#pragma unroll
                    for (int n = 0; n < 2; ++n)
#pragma unroll
                        for (int j = 0; j < 4; ++j) ss += x1[n][j] * x1[n][j] + x2[n][j] * x2[n][j];
                    ss += __shfl_xor(ss, 16); ss += __shfl_xor(ss, 32);
                    const float rs = 1.0f / sqrtf(ss * (1.f / 64.f) + RMS_EPS);
#pragma unroll
                    for (int n = 0; n < 2; ++n) { x1[n] = x1[n] * rs * g1[n]; x2[n] = x2[n] * rs * g2[n]; }
                }
                if (dorope) {
#pragma unroll
                    for (int n = 0; n < 2; ++n) { const f32x4 c = *(const f32x4*)(rope + pos * 32 + 8 * fq + 4 * n), s = *(const f32x4*)(rope + SEQ * 32 + pos * 32 + 8 * fq + 4 * n);
                        const f32x4 o1 = x1[n] * c - x2[n] * s, o2 = x2[n] * c + x1[n] * s; x1[n] = o1; x2[n] = o2; }
                }
#pragma unroll
                for (int n = 0; n < 2; ++n) { x1[n] = x1[n] * osc; x2[n] = x2[n] * osc; }
                bf16_t* rowp = (kind == 3) ? dst + (size_t)(row >> 4) * 1024 + fq * 128 + (row & 15) * 8 : dst + (size_t)row * pitch + hoff + 8 * fq;
                const int hi_off = (kind == 3) ? 512 : 32;
                u32x4 w; w.x = cvt_pk_bf16(x1[0][0], x1[0][1]); w.y = cvt_pk_bf16(x1[0][2], x1[0][3]); w.z = cvt_pk_bf16(x1[1][0], x1[1][1]); w.w = cvt_pk_bf16(x1[1][2], x1[1][3]);
                *(u32x4*)(rowp) = w;
                w.x = cvt_pk_bf16(x2[0][0], x2[0][1]); w.y = cvt_pk_bf16(x2[0][2], x2[0][3]); w.z = cvt_pk_bf16(x2[1][0], x2[1][1]); w.w = cvt_pk_bf16(x2[1][2], x2[1][3]);
                *(u32x4*)(rowp + hi_off) = w;
            }
    }
};
}

__device__ __forceinline__ int bin_row(int c) {
    if (c < 1024) { const int h = c >> 6, d = c & 63; return 256 * (h >> 2) + 128 * (d >> 5) + 32 * (h & 3) + (d & 31); }
    if (c < 1088) { const int d = c - 1024; return 1536 + 128 * (d >> 5) + (d & 31); }
    if (c < 1152) { const int d = c - 1088; return 1536 + 128 * (d >> 5) + 64 + (d & 31); }
    if (c < 1664) { const int cc = c - 1152, h = cc >> 6, d = cc & 63; return 256 * (4 + (h >> 2)) + 128 * (d >> 5) + 32 * (h & 3) + (d & 31); }
    if (c < 1728) { const int d = c - 1664; return 1536 + 128 * (d >> 5) + 32 + (d & 31); }
    return 1536 + 96 + (c - 1728);
}
template <int MODE>
__device__ __forceinline__ void tr_item(const float* W, int K, int N, bf16* WT, int item, LAS float* scr, int lane) {
    const int nblk = (N + 31) / 32, kb = item / nblk, nb = item % nblk, k0 = 64 * kb, n0 = 32 * nb;
    const int nn = n0 + (lane & 31); const bool nok = nn < N;
#pragma unroll 8
    for (int i = 0; i < 32; ++i) { const int kk = 2 * i + (lane >> 5); scr[kk * 33 + (lane & 31)] = nok ? W[(size_t)(k0 + kk) * N + nn] : 0.f; }
    LDS_WAIT(); asm volatile("" ::: "memory");
    const int c = lane & 7;
#pragma unroll
    for (int j = 0; j < 4; ++j) { const int n = (lane >> 3) + 8 * j, ncol = n0 + n; const LAS float* s = scr + (8 * c) * 33 + n;
        v4u o; o.x = pk2(s[0 * 33], s[1 * 33]); o.y = pk2(s[2 * 33], s[3 * 33]); o.z = pk2(s[4 * 33], s[5 * 33]); o.w = pk2(s[6 * 33], s[7 * 33]);
        if (ncol < N) { const int drow = (MODE == 0) ? ncol : bin_row(ncol); *(GAS v4u*)(WT + (size_t)drow * K + k0 + 8 * c) = o; } }
    LDS_WAIT(); asm volatile("" ::: "memory");
}

struct RopeInv { float v[32]; };

template <bool LATE>
__device__ __forceinline__ void phase_prep(const float* const* in, unsigned char* ws, LAS unsigned char* lds, const RopeInv& rinv, int tid, int lane, int wave, int bx, int G) {
  if (!LATE) {
    if (bx < 192) {
        LAS float* cond = (LAS float*)lds; LAS float* part = (LAS float*)(lds + 32768);
        const float* cin = in[1];
        for (int i = tid; i < NB * DM; i += NTHREADS) { const float v = cin[i]; cond[i] = v / (1.f + __expf(-v)); }
        __syncthreads();
        const int l = bx / 96, c0 = 64 * (bx % 96), cq = tid & 15, kg = tid >> 4;
        f32x4 a[NB];
#pragma unroll
        for (int b = 0; b < NB; ++b) a[b] = (f32x4){0.f, 0.f, 0.f, 0.f};
        const float* wp = in[4] + (size_t)l * DM * NMOD + c0 + 4 * cq;
#pragma unroll 4
        for (int kk = 0; kk < 32; ++kk) { const int k = kg * 32 + kk; const f32x4 w = *(const f32x4*)(wp + (size_t)k * NMOD);
#pragma unroll
            for (int b = 0; b < NB; ++b) { const float cv = cond[b * DM + k]; a[b] += w * cv; } }
#pragma unroll
        for (int b = 0; b < NB; ++b) *(LAS f32x4*)(part + (kg * NB + b) * 64 + 4 * cq) = a[b];
        __syncthreads();
        { const int b = tid >> 6, col = tid & 63; float s = 0.f;
#pragma unroll 8
          for (int k2 = 0; k2 < 32; ++k2) s += part[(k2 * NB + b) * 64 + col];
          ((float*)(ws + WS_MOD))[(size_t)(l * NB + b) * NMOD + c0 + col] = s + in[5][l * NMOD + c0 + col]; }
        __syncthreads();
    }
  } else {
    { float* rope = (float*)(ws + WS_ROPE);
      for (int idx = bx * NTHREADS + tid; idx < SEQ * 32; idx += G * NTHREADS) { const int pos = idx >> 5, i = idx & 31;
          const float ang = (float)pos * rinv.v[i]; const double a = (double)ang; const double k = rint(a * 0.15915494309189535); const float x = (float)(a * 0.15915494309189535 - k);
          rope[idx] = __builtin_amdgcn_cosf(x); rope[SEQ * 32 + idx] = __builtin_amdgcn_sinf(x); } }
    { bf16* wb = (bf16*)(ws + WS_WBIN);
      for (int i = bx * NTHREADS + tid; i < 56 * 128; i += G * NTHREADS) { const int r = i >> 7, c8 = i & 127; const int row = r < 24 ? 1536 + 96 + 8 + r : 1536 + 128 + 96 + (r - 24);
          *(GAS v4u*)(wb + (size_t)row * DM + 8 * c8) = (v4u){0u, 0u, 0u, 0u}; } }
  }
    LAS float* scr = (LAS float*)(lds + wave * 16384);
    const int gw = bx * NWAVES + wave, NGW = G * NWAVES;
    constexpr int I_AIN = 16 * 80, I_AOUT = 20 * 32, I_G1 = 4 * 8, I_GATES = 10 * I_G1, I_BIN = 16 * 55, I_BOUT = 16 * 32, I_W1 = 16 * 128, I_W2 = 64 * 32;
    constexpr int NEARLY = I_AIN + I_GATES, NLATE = 2 * I_W1 + 2 * I_W2 + I_AOUT + I_BIN + I_BOUT;
    for (int it = gw; it < (LATE ? NLATE : NEARLY); it += NGW) {
        int r = it;
        if (!LATE) {
            if (r < I_AIN) { tr_item<0>(in[6], DM, 2 * DRNN, (bf16*)(ws + WS_WAIN), r, scr, lane); continue; } r -= I_AIN;
            { const int mi = r / I_G1, n = mi >> 1, gsel = mi & 1;
              tr_item<0>(in[gsel ? 11 : 9] + (size_t)n * LBLK * LBLK, LBLK, LBLK, (bf16*)(ws + WS_WGATE) + (size_t)(n * 2 + gsel) * LBLK * LBLK, r % I_G1, scr, lane); continue; }
        }
        if (r < I_W1 * 2) { const int l = r / I_W1; tr_item<0>(in[19] + (size_t)l * DM * DFF, DM, DFF, (bf16*)(ws + WS_W1) + (size_t)l * DFF * DM, r % I_W1, scr, lane); continue; } r -= 2 * I_W1;
        if (r < I_W2 * 2) { const int l = r / I_W2; tr_item<0>(in[20] + (size_t)l * DFF * DM, DFF, DM, (bf16*)(ws + WS_W2) + (size_t)l * DM * DFF, r % I_W2, scr, lane); continue; } r -= 2 * I_W2;
        if (r < I_AOUT) { tr_item<0>(in[14], DRNN, DM, (bf16*)(ws + WS_WAOUT), r, scr, lane); continue; } r -= I_AOUT;
        if (r < I_BIN) { tr_item<1>(in[15], DM, BIN, (bf16*)(ws + WS_WBIN), r, scr, lane); continue; } r -= I_BIN;
        tr_item<0>(in[18], DM, DM, (bf16*)(ws + WS_WBOUT), r, scr, lane);
    }
}

template <bool XB16>
__device__ __forceinline__ void phase_norm(const void* x, const float* g, const float* mod_sh, const float* mod_sc, bf16* H, int lane, int wave, int vcu, int G) {
    const int gw = vcu * NWAVES + wave, NGW = G * NWAVES;
    for (int r0 = gw * 16; r0 < MTOK; r0 += NGW * 16) {
        const int b = r0 >> 12;
        f32x4 al[4], be[4];
#pragma unroll
        for (int j = 0; j < 4; ++j) { const int c = XB16 ? 8 * lane + 512 * (j >> 1) + 4 * (j & 1) : 4 * lane + 256 * j;
            const f32x4 gg = *(const f32x4*)(g + c), sc = *(const f32x4*)(mod_sc + b * NMOD + c); al[j] = gg * (sc + 1.f); be[j] = *(const f32x4*)(mod_sh + b * NMOD + c); }
#pragma unroll 2
        for (int rr = 0; rr < 16; ++rr) {
            f32x4 v[4]; float s = 0.f;
            if (XB16) {
                const GAS v4u* xr = (const GAS v4u*)((const bf16*)x + (size_t)(r0 + rr) * DM) + lane;
#pragma unroll
                for (int j = 0; j < 2; ++j) { const v4u w = xr[64 * j];
                    v[2 * j] = (f32x4){bflo(w.x), bfhi(w.x), bflo(w.y), bfhi(w.y)}; v[2 * j + 1] = (f32x4){bflo(w.z), bfhi(w.z), bflo(w.w), bfhi(w.w)}; }
            } else {
                const GAS f32x4* xr = (const GAS f32x4*)((const float*)x + (size_t)(r0 + rr) * DM) + lane;
#pragma unroll
                for (int j = 0; j < 4; ++j) v[j] = xr[64 * j];
            }
#pragma unroll
            for (int j = 0; j < 4; ++j) s += (v[j].x * v[j].x + v[j].y * v[j].y) + (v[j].z * v[j].z + v[j].w * v[j].w);
            const float rstd = 1.0f / sqrtf(wave_sum(s) * (1.f / DM) + RMS_EPS);
            f32x4 y[4];
#pragma unroll
            for (int j = 0; j < 4; ++j) y[j] = v[j] * rstd * al[j] + be[j];
            if (XB16) {
                GAS v4u* o16 = (GAS v4u*)(H + (size_t)(r0 + rr) * DM) + lane;
#pragma unroll
                for (int j = 0; j < 2; ++j) { v4u o; o.x = pk2(y[2 * j].x, y[2 * j].y); o.y = pk2(y[2 * j].z, y[2 * j].w); o.z = pk2(y[2 * j + 1].x, y[2 * j + 1].y); o.w = pk2(y[2 * j + 1].z, y[2 * j + 1].w); o16[64 * j] = o; }
            } else {
                GAS unsigned long long* o8 = (GAS unsigned long long*)(H + (size_t)(r0 + rr) * DM) + lane;
#pragma unroll
                for (int j = 0; j < 4; ++j) o8[64 * j] = (unsigned long long)pk2(y[j].x, y[j].y) | ((unsigned long long)pk2(y[j].z, y[j].w) << 32);
            }
        }
    }
}

constexpr int RQ_CT = 128, RQ_AP = 528  , RQ_SP = 68  ;
constexpr int RQ_AT = 0, RQ_A = RQ_CT * RQ_AP, RQ_B = RQ_A + RQ_CT * RQ_SP * 4, RQ_SEG = RQ_B + RQ_CT * RQ_SP * 4, RQ_END = RQ_SEG + 16 * 32 * 16;
static_assert(RQ_END <= MISC_OFF, "rglru LDS map");
__device__ __forceinline__ f32x2v bf2x(unsigned w) { return (f32x2v){__builtin_bit_cast(float, w << 16), __builtin_bit_cast(float, w & 0xffff0000u)}; }
__device__ __forceinline__ void phase_rglru(const float* const* in, unsigned char* ws, LAS unsigned char* lds, int tid, int lane, int wave, int bx) {
    if (bx >= 160) return;
    const int b = bx & 7, n = (bx >> 3) >> 2, g = (bx >> 3) & 3;
    const bf16* XB = (const bf16*)(ws + WS_XB); const bf16* GT = (const bf16*)(ws + WS_GATE); bf16* Y = (bf16*)(ws + WS_Y);
    const int fr = lane & 15, fq = lane >> 4, wr = wave >> 2, wc = wave & 3;
    pg8::bf16x8 Br[8], Bi[8];
    { const bf16* wr_ = (const bf16*)(ws + WS_WGATE) + (size_t)(n * 2 + 0) * LBLK * LBLK + (size_t)(64 * g + 16 * wc + fr) * LBLK + 8 * fq;
      const bf16* wi_ = wr_ + (size_t)LBLK * LBLK;
#pragma unroll
      for (int kk = 0; kk < 8; ++kk) { Br[kk] = *(const pg8::bf16x8*)(wr_ + 32 * kk); Bi[kk] = *(const pg8::bf16x8*)(wi_ + 32 * kk); } }
    const int chl0 = 16 * wc + 4 * fq, chg0 = LBLK * n + 64 * g + chl0;
    f32x2v brv[2], biv[2], nsp[2];
    { const f32x4 x = *(const f32x4*)(in[10] + chg0), y = *(const f32x4*)(in[12] + chg0), lam = *(const f32x4*)(in[13] + chg0);
      brv[0] = (f32x2v){x[0], x[1]}; brv[1] = (f32x2v){x[2], x[3]}; biv[0] = (f32x2v){y[0], y[1]}; biv[1] = (f32x2v){y[2], y[3]};
      float t[4];
#pragma unroll
      for (int j = 0; j < 4; ++j) t[j] = -8.f * 1.4426950408889634f * log1pf(__expf(-lam[j]));
      nsp[0] = (f32x2v){t[0], t[1]}; nsp[1] = (f32x2v){t[2], t[3]}; }
    const int cq = lane;
    const int cch = LBLK * n + 4 * cq;
    f32x2v cw[4][2], cb[2];
#pragma unroll
    for (int j = 0; j < 4; ++j) { const f32x4 w0 = *(const f32x4*)(in[7] + j * DRNN + cch); cw[j][0] = (f32x2v){w0[0], w0[1]}; cw[j][1] = (f32x2v){w0[2], w0[3]}; }
    { const f32x4 b0 = *(const f32x4*)(in[8] + cch); cb[0] = (f32x2v){b0[0], b0[1]}; cb[1] = (f32x2v){b0[2], b0[3]}; }
    const int cp = tid & 31, sg = tid >> 5;
    f32x2v hin = (f32x2v){0.f, 0.f};
    const size_t tok0 = (size_t)b * SEQ;
    u32x2v xr[19];
#define RQ_LOADX(t0_) do { _Pragma("unroll") for (int i_ = 0; i_ < 19; ++i_) { const int t_ = (t0_) + 16 * wave - 3 + i_; \
        xr[i_] = (t_ >= 0) ? *(const GAS u32x2v*)(XB + (tok0 + t_) * DRNN + cch) : (u32x2v){0u, 0u}; } } while (0)
    RQ_LOADX(0);
    for (int c = 0; c < SEQ / RQ_CT; ++c) {
        const int t0 = c * RQ_CT;
        { f32x2v xf[19][2];
#pragma unroll
          for (int i = 0; i < 19; ++i) { xf[i][0] = bf2x(xr[i].x); xf[i][1] = bf2x(xr[i].y); }
#pragma unroll
          for (int tt = 0; tt < 16; ++tt) { f32x2v o0 = cb[0], o1 = cb[1];
#pragma unroll
              for (int j = 0; j < 4; ++j) { o0 += cw[j][0] * xf[tt + j][0]; o1 += cw[j][1] * xf[tt + j][1]; }
              u32x2v pk; pk.x = pk2(o0.x, o0.y); pk.y = pk2(o1.x, o1.y);
              *(LAS u32x2v*)(lds + RQ_AT + (16 * wave + tt) * RQ_AP + 8 * cq) = pk; } }
        if (c + 1 < SEQ / RQ_CT) RQ_LOADX(t0 + RQ_CT);
        unsigned gt[8];
        { const bf16* gp = GT + (tok0 + t0 + 8 * sg) * DRNN + LBLK * n + 64 * g + 2 * cp;
#pragma unroll
          for (int t = 0; t < 8; ++t) gt[t] = *(const GAS unsigned*)(gp + (size_t)t * DRNN); }
        __syncthreads();
        f32x4 ar[4], ai_[4];
#pragma unroll
        for (int m = 0; m < 4; ++m) { ar[m] = (f32x4){0.f, 0.f, 0.f, 0.f}; ai_[m] = ar[m]; }
#pragma unroll
        for (int kk = 0; kk < 8; ++kk)
#pragma unroll
            for (int m = 0; m < 4; ++m) { const pg8::bf16x8 xf = *(const LAS pg8::bf16x8*)(lds + RQ_AT + (64 * wr + 16 * m + fr) * RQ_AP + (32 * kk + 8 * fq) * 2);
                ar[m] = __builtin_amdgcn_mfma_f32_16x16x32_bf16(Br[kk], xf, ar[m], 0, 0, 0); ai_[m] = __builtin_amdgcn_mfma_f32_16x16x32_bf16(Bi[kk], xf, ai_[m], 0, 0, 0); }
#pragma unroll
        for (int m = 0; m < 4; ++m) { const int tk = 64 * wr + 16 * m + fr;
            const u32x2v xw = *(const LAS u32x2v*)(lds + RQ_AT + tk * RQ_AP + (64 * g + chl0) * 2);
            f32x4 av, bv;
#pragma unroll
            for (int h = 0; h < 2; ++h) { const f32x2v xc = bf2x(h ? xw.y : xw.x);
                f32x2v tr_ = ((f32x2v){ar[m][2 * h], ar[m][2 * h + 1]} + brv[h]) * -1.4426950408889634f, ti_ = ((f32x2v){ai_[m][2 * h], ai_[m][2 * h + 1]} + biv[h]) * -1.4426950408889634f;
                tr_.x = __builtin_amdgcn_exp2f(tr_.x); tr_.y = __builtin_amdgcn_exp2f(tr_.y); ti_.x = __builtin_amdgcn_exp2f(ti_.x); ti_.y = __builtin_amdgcn_exp2f(ti_.y);
                tr_ = tr_ + 1.0f; ti_ = ti_ + 1.0f;
                f32x2v rr, ii; rr.x = __builtin_amdgcn_rcpf(tr_.x); rr.y = __builtin_amdgcn_rcpf(tr_.y); ii.x = __builtin_amdgcn_rcpf(ti_.x); ii.y = __builtin_amdgcn_rcpf(ti_.y);
                f32x2v la = rr * nsp[h], a; a.x = __builtin_amdgcn_exp2f(la.x); a.y = __builtin_amdgcn_exp2f(la.y);
                f32x2v q = 1.0f - a * a, s; s.x = __builtin_amdgcn_sqrtf(__builtin_fabsf(q.x)); s.y = __builtin_amdgcn_sqrtf(__builtin_fabsf(q.y));
                const f32x2v bb = s * (ii * xc);
                av[2 * h] = a.x; av[2 * h + 1] = a.y; bv[2 * h] = bb.x; bv[2 * h + 1] = bb.y; }
            *(LAS f32x4*)(lds + RQ_A + (tk * RQ_SP + chl0) * 4) = av; *(LAS f32x4*)(lds + RQ_B + (tk * RQ_SP + chl0) * 4) = bv; }
        __syncthreads();
        f32x2v sa[8], sb[8];
#pragma unroll
        for (int t = 0; t < 8; ++t) { sa[t] = *(const LAS f32x2v*)(lds + RQ_A + ((8 * sg + t) * RQ_SP + 2 * cp) * 4); sb[t] = *(const LAS f32x2v*)(lds + RQ_B + ((8 * sg + t) * RQ_SP + 2 * cp) * 4); }
        { f32x2v A = sa[0], H = sb[0];
#pragma unroll
          for (int t = 1; t < 8; ++t) { A = A * sa[t]; H = sa[t] * H + sb[t]; }
          *(LAS f32x4*)(lds + RQ_SEG + (sg * 32 + cp) * 16) = (f32x4){A.x, A.y, H.x, H.y}; }
        __syncthreads();
        { f32x2v h = hin, mine = hin;
#pragma unroll
          for (int s = 0; s < 16; ++s) { const f32x4 sh = *(const LAS f32x4*)(lds + RQ_SEG + (s * 32 + cp) * 16); if (s == sg) mine = h; h = (f32x2v){sh[0], sh[1]} * h + (f32x2v){sh[2], sh[3]}; }
          hin = h;
          f32x2v hh = mine; bf16* yp = Y + (tok0 + t0 + 8 * sg) * DRNN + LBLK * n + 64 * g + 2 * cp;
#pragma unroll
          for (int t = 0; t < 8; ++t) { hh = sa[t] * hh + sb[t]; const f32x2v yv = hh * bf2x(gt[t]); *(GAS unsigned*)(yp + (size_t)t * DRNN) = pk2(yv.x, yv.y); } }
    }
#undef RQ_LOADX
}

constexpr int DS_SCP = 8224;
constexpr int DS_H1 = 8 * DS_SCP, DS_H2 = DS_H1 + 8 * 4096, DS_BNC = 0, DS_IDX = 8 * 16384, DS_DMY = DS_IDX + 8 * 1024, DS_END = DS_DMY + 8 * 256;
static_assert(DS_END <= MISC_OFF && DS_H2 + 8 * 2048 <= DS_IDX, "dsa LDS map");

__device__ __forceinline__ unsigned mbcnt64(unsigned long long m) { return __builtin_amdgcn_mbcnt_hi((unsigned)(m >> 32), __builtin_amdgcn_mbcnt_lo((unsigned)m, 0u)); }
__device__ __forceinline__ void wave_prefix4(unsigned x, unsigned& pre, unsigned& tot) {
    pre = 0u; tot = 0u;
#pragma unroll
    for (int bit = 0; bit < 4; ++bit) { const unsigned long long m = __ballot((x >> bit) & 1u); pre += mbcnt64(m) << bit; tot += (unsigned)__popcll(m) << bit; }
}
__device__ __forceinline__ unsigned row_scan_u32(unsigned v) {
    v += (unsigned)__builtin_amdgcn_update_dpp(0, (int)v, 0x111, 0xf, 0xf, true);
    v += (unsigned)__builtin_amdgcn_update_dpp(0, (int)v, 0x112, 0xf, 0xf, true);
    v += (unsigned)__builtin_amdgcn_update_dpp(0, (int)v, 0x114, 0xf, 0xf, true);
    v += (unsigned)__builtin_amdgcn_update_dpp(0, (int)v, 0x118, 0xf, 0xf, true);
    return v;
}
__device__ __forceinline__ void hist_find4(v4u c4, unsigned need, int lane, unsigned& B, unsigned& above, unsigned& atb) {
    const unsigned s = c4.x + c4.y + c4.z + c4.w;
    const unsigned inc = row_scan_u32(s);
    const unsigned t0 = (unsigned)__builtin_amdgcn_readlane((int)inc, 15), t1 = (unsigned)__builtin_amdgcn_readlane((int)inc, 31), t2 = (unsigned)__builtin_amdgcn_readlane((int)inc, 47), t3 = (unsigned)__builtin_amdgcn_readlane((int)inc, 63);
    const int row = lane >> 4;
    const unsigned before = (row > 0 ? t0 : 0u) + (row > 1 ? t1 : 0u) + (row > 2 ? t2 : 0u) + (inc - s);
    const unsigned total = (t0 + t1) + (t2 + t3);
    const unsigned S = total - before;
    const unsigned long long mk = __ballot(S >= need);
    const int L = 63 - __builtin_clzll(mk | 1ull);
    unsigned cum = S - s, bin, ab, at;
    if (cum + c4.w >= need) { bin = 4 * lane + 3; ab = cum; at = c4.w; }
    else { cum += c4.w; if (cum + c4.z >= need) { bin = 4 * lane + 2; ab = cum; at = c4.z; }
        else { cum += c4.z; if (cum + c4.y >= need) { bin = 4 * lane + 1; ab = cum; at = c4.y; } else { cum += c4.y; bin = 4 * lane; ab = cum; at = c4.x; } } }
    B = __builtin_amdgcn_readlane(bin, L); above = __builtin_amdgcn_readlane(ab, L); atb = __builtin_amdgcn_readlane(at, L);
}
__device__ __forceinline__ void pk_count4(unsigned& a0, unsigned& a1, unsigned& a2, unsigned& a3, unsigned k0, unsigned k1, unsigned k2, unsigned k3, unsigned cm) {
    unsigned t0, t1, t2, t3;
    asm("v_pk_sub_u16 %4, %8, %12 clamp\n\tv_pk_sub_u16 %5, %9, %12 clamp\n\tv_pk_sub_u16 %6, %10, %12 clamp\n\tv_pk_sub_u16 %7, %11, %12 clamp\n\t"
        "v_pk_min_u16 %4, %4, 1 op_sel_hi:[1,0]\n\tv_pk_min_u16 %5, %5, 1 op_sel_hi:[1,0]\n\tv_pk_min_u16 %6, %6, 1 op_sel_hi:[1,0]\n\tv_pk_min_u16 %7, %7, 1 op_sel_hi:[1,0]\n\t"
        "v_pk_add_u16 %0, %0, %4\n\tv_pk_add_u16 %1, %1, %5\n\tv_pk_add_u16 %2, %2, %6\n\tv_pk_add_u16 %3, %3, %7"
        : "+v"(a0), "+v"(a1), "+v"(a2), "+v"(a3), "=&v"(t0), "=&v"(t1), "=&v"(t2), "=&v"(t3) : "v"(k0), "v"(k1), "v"(k2), "v"(k3), "v"(cm));
}
__device__ __forceinline__ unsigned pk_bin2(unsigned w, unsigned b1p) {
    unsigned t, g;
    asm("v_pk_sub_u16 %0, %2, %3\n\tv_and_or_b32 %1, %0, %4, %5\n\tv_pk_min_u16 %0, %0, %1" : "=&v"(t), "=&v"(g) : "v"(w), "v"(b1p), "v"(0x00ff00ffu), "v"(0x01000100u));
    return t;
}
typedef _Float16 h16x2 __attribute__((ext_vector_type(2)));
__device__ __forceinline__ h16x2 pkrtz(float a, float b) { return __builtin_bit_cast(h16x2, __builtin_amdgcn_cvt_pkrtz(a, b)); }
__device__ __forceinline__ unsigned score_key(float s) {
    const int h = (int)(short)__builtin_bit_cast(unsigned short, (_Float16)s);
    return ((unsigned)h ^ ((unsigned)(h >> 15) | 0x8000u)) & 0xffffu;
}

__device__ __forceinline__ void phase_dsa(unsigned char* ws, LAS unsigned char* lds, int tid, int lane, int wave, int bx, int G, int mask) {
    const bf16* Qb = (const bf16*)(ws + WS_Q); const bf16* QIb = (const bf16*)(ws + WS_QI); const bf16* KVb = (const bf16*)(ws + WS_KV);
    const bf16* KIb = (const bf16*)(ws + WS_KI); const float* WIb = (const float*)(ws + WS_WI); bf16* AO = (bf16*)(ws + WS_AO);
    const int lane0 = lane;
    const int b = bx & 7, jj = bx >> 3, nj = G >> 3;
    const size_t tokb = (size_t)b * SEQ;
    for (int i = 0; ; ++i) {
        const int qb = ((i & 1) ? (nj - 1 - jj) : jj) + nj * i;
        if (qb >= SEQ / 8) break;
        const int p0 = 8 * qb, nk16 = (p0 + 8 + 15) & ~15, NT = nk16 >> 4;
        if (mask & 1) {
            int lane = lane0; asm volatile("" : "+v"(lane));
            const int fr = lane & 15, fq = lane >> 4;
            pg8::bf16x8 QA[2][2][2];
#pragma unroll
            for (int grp = 0; grp < 2; ++grp)
#pragma unroll
                for (int hf = 0; hf < 2; ++hf)
#pragma unroll
                    for (int ks = 0; ks < 2; ++ks)
                        QA[grp][hf][ks] = *(const pg8::bf16x8*)(QIb + (tokb + p0 + 4 * grp + (fr >> 2)) * 512 + (4 * hf + (fr & 3)) * 64 + 32 * ks + 8 * fq);
            h16x2 wq[2][4];
#pragma unroll
            for (int grp = 0; grp < 2; ++grp) { const f32x4 w0 = *(const f32x4*)(WIb + (tokb + p0 + 4 * grp + fq) * 8), w1 = *(const f32x4*)(WIb + (tokb + p0 + 4 * grp + fq) * 8 + 4);
                wq[grp][0] = pkrtz(w0[0], w0[1]); wq[grp][1] = pkrtz(w0[2], w0[3]); wq[grp][2] = pkrtz(w1[0], w1[1]); wq[grp][3] = pkrtz(w1[2], w1[3]); }
            const int ntw = NT > wave ? (NT - wave + 7) >> 3 : 0, ng = (ntw + 3) >> 2;
            const char* kibase = (const char*)(KIb + tokb * 64);
            const unsigned koff = (unsigned)lane * 16u;
            const h16x2 hz = {(_Float16)0.f, (_Float16)0.f};
            pg8::bf16x8 ka[4][2], kb[4][2];
#define DS_A_LOAD(buf, g) do { _Pragma("unroll") for (int u_ = 0; u_ < 4; ++u_) { int kt_ = wave + 8 * (4 * (g) + u_); kt_ = kt_ < NT ? kt_ : NT - 1; const unsigned o_ = koff + (unsigned)kt_ * 2048u; \
                buf[u_][0] = *(const pg8::bf16x8*)(kibase + o_); buf[u_][1] = *(const pg8::bf16x8*)(kibase + o_ + 1024u); } } while (0)
#define DS_A_COMP(buf, g) do { f32x4 d_[4][2][2]; \
                _Pragma("unroll") for (int u_ = 0; u_ < 4; ++u_) _Pragma("unroll") for (int grp = 0; grp < 2; ++grp) _Pragma("unroll") for (int hf = 0; hf < 2; ++hf) { \
                    f32x4 z_ = (f32x4){0.f, 0.f, 0.f, 0.f}; z_ = __builtin_amdgcn_mfma_f32_16x16x32_bf16(QA[grp][hf][0], buf[u_][0], z_, 0, 0, 0); d_[u_][grp][hf] = __builtin_amdgcn_mfma_f32_16x16x32_bf16(QA[grp][hf][1], buf[u_][1], z_, 0, 0, 0); } \
                _Pragma("unroll") for (int u_ = 0; u_ < 4; ++u_) { const int kt_ = wave + 8 * (4 * (g) + u_); const int key_ = 16 * kt_ + fr; \
                    _Pragma("unroll") for (int grp = 0; grp < 2; ++grp) { float s_ = 0.f; \
                        _Pragma("unroll") for (int hf = 0; hf < 2; ++hf) { \
                            s_ = __builtin_amdgcn_fdot2(__builtin_elementwise_max(pkrtz(d_[u_][grp][hf][0], d_[u_][grp][hf][1]), hz), wq[grp][2 * hf], s_, false); \
                            s_ = __builtin_amdgcn_fdot2(__builtin_elementwise_max(pkrtz(d_[u_][grp][hf][2], d_[u_][grp][hf][3]), hz), wq[grp][2 * hf + 1], s_, false); } \
                        const int q_ = 4 * grp + fq; const unsigned kk_ = (key_ <= p0 + q_) ? score_key(s_) : 0u; \
                        if (kt_ < NT) *(LAS unsigned short*)(lds + q_ * DS_SCP + key_ * 2) = (unsigned short)kk_; } } } while (0)
            DS_A_LOAD(ka, 0);
            DS_A_LOAD(kb, 1);
            for (int g = 0; g < ng; g += 2) {
                DS_A_COMP(ka, g);
                DS_A_LOAD(ka, g + 2);
                if (g + 1 < ng) DS_A_COMP(kb, g + 1);
                DS_A_LOAD(kb, g + 3);
            }
#undef DS_A_LOAD
#undef DS_A_COMP
        }
        LDS_WAIT();
        __syncthreads();
        const int p = p0 + wave, nvalid = p + 1;
        LAS unsigned* idx = (LAS unsigned*)(lds + DS_IDX + wave * 1024);
        int nsel = 1;
        if (!(mask & 2)) { }
        else if (nvalid <= TOPK) {
#pragma unroll
            for (int r = 0; r < 4; ++r) { const int s = lane0 + 64 * r; idx[s] = (unsigned)(s < nvalid ? s : 0) << 8; }
            nsel = nvalid;
        } else {
            int lane = lane0; asm volatile("" : "+v"(lane));
            const LAS unsigned char* row = lds + wave * DS_SCP;
            const int nit = (nk16 + 511) >> 9;
            unsigned kp[8][4];
#pragma unroll
            for (int it = 0; it < 8; ++it) { v4u v = (v4u){0u, 0u, 0u, 0u};
                if (it < nit) { const int e0 = it * 512 + lane * 8; if (e0 < nk16) v = *(const LAS v4u*)(row + e0 * 2); }
#pragma unroll
                for (int x = 0; x < 4; ++x) kp[it][x] = v[x]; }
            const unsigned h1w = DS_H1 + wave * 4096, h2w = DS_H2 + wave * 2048;
#pragma unroll
            for (int r = 0; r < 4; ++r) *(LAS v4u*)(lds + h1w + r * 1024 + lane * 16) = (v4u){0u, 0u, 0u, 0u};
#pragma unroll
            for (int r = 0; r < 2; ++r) *(LAS v4u*)(lds + h2w + r * 1024 + lane * 16) = (v4u){0u, 0u, 0u, 0u};
            LDS_WAIT();
            const unsigned h1l = h1w + (unsigned)(lane & 3) * 1024u;
#pragma unroll
            for (int it = 0; it < 8; ++it) if (it < nit) {
#pragma unroll
                for (int x = 0; x < 4; ++x) { const unsigned w = kp[it][x];
                    __hip_atomic_fetch_add((LAS unsigned*)(lds + h1l + ((w >> 6) & 0x3fcu)), 1u, __ATOMIC_RELAXED, __HIP_MEMORY_SCOPE_WORKGROUP);
                    __hip_atomic_fetch_add((LAS unsigned*)(lds + h1l + ((w >> 22) & 0x3fcu)), 1u, __ATOMIC_RELAXED, __HIP_MEMORY_SCOPE_WORKGROUP); } }
            LDS_WAIT();
            unsigned B1, above1, at1;
            { const v4u c0 = *(const LAS v4u*)(lds + h1w + lane * 16), c1 = *(const LAS v4u*)(lds + h1w + 1024 + lane * 16), c2 = *(const LAS v4u*)(lds + h1w + 2048 + lane * 16), c3 = *(const LAS v4u*)(lds + h1w + 3072 + lane * 16);
              hist_find4((c0 + c1) + (c2 + c3), (unsigned)TOPK, lane, B1, above1, at1); }
            const unsigned need1 = (unsigned)TOPK - above1;
            const unsigned b1p = B1 * 0x01000100u;
#pragma unroll
            for (int it = 0; it < 8; ++it) if (it < nit) {
#pragma unroll
                for (int x = 0; x < 4; ++x) { const unsigned m = pk_bin2(kp[it][x], b1p);
                    __hip_atomic_fetch_add((LAS unsigned*)(lds + h2w + ((m & 0xffffu) << 2)), 1u, __ATOMIC_RELAXED, __HIP_MEMORY_SCOPE_WORKGROUP);
                    __hip_atomic_fetch_add((LAS unsigned*)(lds + h2w + ((m >> 16) << 2)), 1u, __ATOMIC_RELAXED, __HIP_MEMORY_SCOPE_WORKGROUP); } }
            LDS_WAIT();
            unsigned B2, above2, at2;
            hist_find4(*(const LAS v4u*)(lds + h2w + lane * 16), need1, lane, B2, above2, at2);
            const unsigned T = (B1 << 8) | B2, need_eq = need1 - above2;
            if (need_eq == at2) {
                unsigned a0 = 0u, a1 = 0u, a2 = 0u, a3 = 0u; const unsigned cm = (T - 1u) * 0x10001u;
#pragma unroll
                for (int it = 0; it < 8; ++it) if (it < nit) pk_count4(a0, a1, a2, a3, kp[it][0], kp[it][1], kp[it][2], kp[it][3], cm);
                const unsigned a_ = (a0 + a1) + (a2 + a3), cl = (a_ & 0xffffu) + (a_ >> 16);
                const unsigned inc = row_scan_u32(cl);
                const unsigned t0 = (unsigned)__builtin_amdgcn_readlane((int)inc, 15), t1 = (unsigned)__builtin_amdgcn_readlane((int)inc, 31), t2 = (unsigned)__builtin_amdgcn_readlane((int)inc, 47);
                const int rw = lane >> 4;
                unsigned pa = DS_IDX + wave * 1024 + 4u * ((rw > 0 ? t0 : 0u) + (rw > 1 ? t1 : 0u) + (rw > 2 ? t2 : 0u) + (inc - cl));
                const unsigned eb = (unsigned)lane * 2048u;
#pragma unroll
                for (int it = 0; it < 8; ++it) if (it < nit) {
#pragma unroll
                    for (int k = 0; k < 8; ++k) { const unsigned kk_ = (k & 1) ? (kp[it][k >> 1] >> 16) : (kp[it][k >> 1] & 0xffffu);
                        if (kk_ >= T) { *(LAS unsigned*)(lds + pa) = eb + (unsigned)((it * 512 + k) << 8); pa += 4u; } } }
            } else {
                unsigned cnt = 0u, eqc = 0u;
#pragma unroll
                for (int it = 0; it < 8; ++it) if (it < nit) {
                    unsigned gtm = 0u, eqm = 0u;
#pragma unroll
                    for (int k = 0; k < 8; ++k) { const unsigned kk_ = (k & 1) ? (kp[it][k >> 1] >> 16) : (kp[it][k >> 1] & 0xffffu); gtm |= (kk_ > T) ? (1u << k) : 0u; eqm |= (kk_ == T) ? (1u << k) : 0u; }
                    unsigned selm = gtm;
                    if (__ballot(eqm != 0u)) { unsigned pre, tot; wave_prefix4((unsigned)__popc(eqm), pre, tot); unsigned run = eqc + pre;
#pragma unroll
                        for (int k = 0; k < 8; ++k) if ((eqm >> k) & 1u) { if (run < need_eq) selm |= (1u << k); ++run; }
                        eqc += tot; }
                    if (__ballot(selm != 0u)) { unsigned pre, tot; wave_prefix4((unsigned)__popc(selm), pre, tot); unsigned pos = cnt + pre; const int e0 = it * 512 + lane * 8;
#pragma unroll
                        for (int k = 0; k < 8; ++k) if ((selm >> k) & 1u) { idx[pos & 255u] = (unsigned)(e0 + k) << 8; ++pos; }
                        cnt += tot; }
                }
            }
            nsel = TOPK;
        }
        LDS_WAIT();
        __syncthreads();
        if (mask & 4) {
            int lane = lane0; asm volatile("" : "+v"(lane));
            const int fr = lane & 15, fq = lane >> 4;
            const unsigned kbn = DS_BNC + wave * 16384, vbn = kbn + 8192;
            const pg8::bf16x8 q0 = *(const pg8::bf16x8*)(Qb + (tokb + p) * DM + fr * 64 + 8 * fq), q1 = *(const pg8::bf16x8*)(Qb + (tokb + p) * DM + fr * 64 + 32 + 8 * fq);
            const char* kvbase = (const char*)(KVb + tokb * 128);
            const int gr = lane >> 3, gc = lane & 7;
#define DS_ROFF(g_, ro_) do { const v4u i0_ = *(const LAS v4u*)((const LAS unsigned char*)idx + (64 * (g_) + 8 * gr) * 4), i1_ = *(const LAS v4u*)((const LAS unsigned char*)idx + (64 * (g_) + 8 * gr) * 4 + 16); \
                _Pragma("unroll") for (int j = 0; j < 4; ++j) { ro_[j] = i0_[j] + (unsigned)gc * 16u; ro_[4 + j] = i1_[j] + (unsigned)gc * 16u; } } while (0)
            v4u kreg[3][8], vreg[4][8];
#pragma unroll
            for (int g = 0; g < 3; ++g) { unsigned ro[8]; DS_ROFF(g, ro);
#pragma unroll
                for (int j = 0; j < 8; ++j) kreg[g][j] = *(const v4u*)(kvbase + ro[j]); }
            pg8::bf16x8 pf[8];
            const unsigned kfr = kbn + fr * 128;
            const int ksw = (fr >> 1) & 7;
#pragma unroll
            for (int g = 0; g < 4; ++g) {
                asm volatile("s_waitcnt lgkmcnt(0)" ::: "memory");
#pragma unroll
                for (int j = 0; j < 8; ++j) { const int rl = 8 * j + gr; *(LAS v4u*)(lds + kbn + rl * 128 + ((gc ^ ((rl >> 1) & 7)) << 4)) = kreg[g == 3 ? 0 : g][j]; }
                asm volatile("s_waitcnt lgkmcnt(0)" ::: "memory");
                f32x4 pt[4];
#pragma unroll
                for (int tt = 0; tt < 4; ++tt) {
                    const pg8::bf16x8 k0 = *(const LAS pg8::bf16x8*)(lds + kfr + tt * 2048 + ((fq ^ ksw) << 4)), k1 = *(const LAS pg8::bf16x8*)(lds + kfr + tt * 2048 + (((4 + fq) ^ ksw) << 4));
                    f32x4 d = (f32x4){0.f, 0.f, 0.f, 0.f};
                    d = __builtin_amdgcn_mfma_f32_16x16x32_bf16(k0, q0, d, 0, 0, 0); pt[tt] = __builtin_amdgcn_mfma_f32_16x16x32_bf16(k1, q1, d, 0, 0, 0); }
#pragma unroll
                for (int tt = 0; tt < 4; ++tt) {
#pragma unroll
                    for (int r = 0; r < 4; ++r) pt[tt][r] = __builtin_amdgcn_exp2f(pt[tt][r]);
                    if (nsel < TOPK) {
#pragma unroll
                        for (int r = 0; r < 4; ++r) { const int rl = 16 * tt + 4 * fq + r; if (64 * g + 8 * (rl & 7) + (rl >> 3) >= nsel) pt[tt][r] = 0.f; } } }
#pragma unroll
                for (int h2 = 0; h2 < 2; ++h2) { v4u w; w.x = pg8::cvt_pk_bf16(pt[2 * h2][0], pt[2 * h2][1]); w.y = pg8::cvt_pk_bf16(pt[2 * h2][2], pt[2 * h2][3]);
                    w.z = pg8::cvt_pk_bf16(pt[2 * h2 + 1][0], pt[2 * h2 + 1][1]); w.w = pg8::cvt_pk_bf16(pt[2 * h2 + 1][2], pt[2 * h2 + 1][3]); pf[2 * g + h2] = __builtin_bit_cast(pg8::bf16x8, w); }
                if (g == 0) { unsigned ro[8]; DS_ROFF(3, ro);
#pragma unroll
                    for (int j = 0; j < 8; ++j) kreg[0][j] = *(const v4u*)(kvbase + ro[j]); }
                else { unsigned ro[8]; DS_ROFF(g - 1, ro);
#pragma unroll
                  for (int j = 0; j < 8; ++j) vreg[g - 1][j] = *(const v4u*)(kvbase + ro[j] + 128u); }
            }
            f32x4 o[4], osum = (f32x4){0.f, 0.f, 0.f, 0.f};
#pragma unroll
            for (int dt = 0; dt < 4; ++dt) o[dt] = (f32x4){0.f, 0.f, 0.f, 0.f};
            pg8::bf16x8 ones;
#pragma unroll
            for (int e = 0; e < 8; ++e) ones[e] = (short)0x3f80;
            const int trow = 4 * fq + (fr >> 2), tsw = (trow >> 1) & 3;
            const unsigned tbase = vbn + trow * 128 + (fr & 3) * 8;
#pragma unroll
            for (int g = 0; g < 4; ++g) {
                asm volatile("s_waitcnt lgkmcnt(0)" ::: "memory");
#pragma unroll
                for (int j = 0; j < 8; ++j) { const int rl = 8 * j + gr; *(LAS v4u*)(lds + vbn + rl * 128 + (((((gc >> 1) ^ ((rl >> 1) & 3)) << 1) | (gc & 1)) << 4)) = vreg[g][j]; }
                if (g == 0) { unsigned ro[8]; DS_ROFF(3, ro);
#pragma unroll
                    for (int j = 0; j < 8; ++j) vreg[3][j] = *(const v4u*)(kvbase + ro[j] + 128u); }
                asm volatile("s_waitcnt lgkmcnt(0)" ::: "memory");
#pragma unroll
                for (int s2l = 0; s2l < 2; ++s2l) {
#pragma unroll
                    for (int dt = 0; dt < 4; ++dt) { const unsigned a0 = tbase + s2l * 4096 + ((dt ^ tsw) << 5);
                        const s16x4v lo = __builtin_bit_cast(s16x4v, __builtin_amdgcn_ds_read_tr16_b64_v4i16((LAS s16x4v*)(lds + a0)));
                        const s16x4v hi = __builtin_bit_cast(s16x4v, __builtin_amdgcn_ds_read_tr16_b64_v4i16((LAS s16x4v*)(lds + a0 + 2048)));
                        const pg8::bf16x8 vf = __builtin_shufflevector(lo, hi, 0, 1, 2, 3, 4, 5, 6, 7);
                        o[dt] = __builtin_amdgcn_mfma_f32_16x16x32_bf16(vf, pf[2 * g + s2l], o[dt], 0, 0, 0); }
                    osum = __builtin_amdgcn_mfma_f32_16x16x32_bf16(ones, pf[2 * g + s2l], osum, 0, 0, 0);
                }
            }
#undef DS_ROFF
            const float rinv = 1.f / osum[0];
            bf16* op = AO + (tokb + p) * DM + fr * 64 + 4 * fq;
#pragma unroll
            for (int dt = 0; dt < 4; ++dt) { u32x2v w; w.x = pg8::cvt_pk_bf16(o[dt][0] * rinv, o[dt][1] * rinv); w.y = pg8::cvt_pk_bf16(o[dt][2] * rinv, o[dt][3] * rinv); *(u32x2v*)(op + 16 * dt) = w; }
        }
        asm volatile("s_waitcnt vmcnt(0) lgkmcnt(0)" ::: "memory");
        __syncthreads();
    }
}

struct Args { const float* in[21]; float* out; unsigned char* ws; RopeInv rinv; int ph_lo, ph_hi, dsa_mask, pad; };
static_assert(sizeof(Args) == 21 * 8 + 8 + 8 + 128 + 16, "Args has no padding");

__global__ void __launch_bounds__(NTHREADS, 2) mk_fwd(Args args) {
    extern __shared__ __attribute__((aligned(16))) unsigned char lds_raw[];
    LAS unsigned char* lds = (LAS unsigned char*)lds_raw;
    const int tid = threadIdx.x, lane = tid & 63, wave = __builtin_amdgcn_readfirstlane(tid >> 6);
    const int G = gridDim.x, bx = blockIdx.x;
    const int vcu = (G % 8 == 0) ? (bx % 8) * (G / 8) + bx / 8 : bx;
    unsigned char* ws = args.ws;
    volatile LAS unsigned* MISC = (volatile LAS unsigned*)(lds + MISC_OFF);
    if (tid < 64) MISC[tid] = 0u;
    __syncthreads();
    const int lo = args.ph_lo, hi = args.ph_hi;
    XcdBarrier bar; bar.bar = (unsigned*)(ws + WS_CTL) + CW_BAR; bar.x = 0; bar.st = nullptr;
    if (hi - lo > 1) bar = xcd_barrier_post((unsigned*)(ws + WS_CTL) + CW_BAR, MISC + 8);
#define IN(k) (lo <= (k) && (k) < hi)
#define SEAM(k) do { if (IN(k) && IN((k) + 1)) xcd_barrier(bar); } while (0)
    const float* mod = (const float*)(ws + WS_MOD);
    bf16* H = (bf16*)(ws + WS_H);
    const float* x_in = args.in[0]; float* xo = args.out;
    bf16* XR = (bf16*)(ws + WS_XR);

    if (IN(0)) { phase_prep<false>(args.in, ws, lds, args.rinv, tid, lane, wave, bx, G); } SEAM(0);
    if (IN(1)) { phase_norm<false>(x_in, args.in[2], mod + 0 * DM, mod + 1 * DM, H, lane, wave, vcu, G); } SEAM(1);
    if (IN(2)) { pg8::Gemm g{H, (const bf16*)(ws + WS_WAIN), MTOK, 2 * DRNN, DM}; pg8::StaticOrder S; S.init(MTOK, 2 * DRNN, G, bx);
        pg8::EpiXbGate E{(bf16*)(ws + WS_XB), (bf16*)(ws + WS_GATE)};
        pg8::gemm_phase<pg8::EpiXbGate, pg8::StaticOrder, true, true>(lds, g, S, E); } SEAM(2);
    if (IN(3)) { if (bx < 160) phase_rglru(args.in, ws, lds, tid, lane, wave, bx); else phase_prep<true>(args.in, ws, lds, args.rinv, tid, lane, wave, bx - 160, G - 160); } SEAM(3);
    if (IN(4)) { pg8::Gemm g{(const bf16*)(ws + WS_Y), (const bf16*)(ws + WS_WAOUT), MTOK, DM, DRNN}; pg8::StaticOrder S; S.init(MTOK, DM, G, bx);
        pg8::EpiRes<false, true> E{x_in, XR, mod + 2 * DM};
        pg8::gemm_phase<pg8::EpiRes<false, true>, pg8::StaticOrder, true, true>(lds, g, S, E); } SEAM(4);
    if (IN(5)) { phase_norm<true>(XR, args.in[3], mod + 3 * DM, mod + 4 * DM, H, lane, wave, vcu, G); } SEAM(5);
    if (IN(6)) { pg8::Gemm g{H, (const bf16*)(ws + WS_W1), MTOK, DFF, DM}; pg8::StaticOrder S; S.init(MTOK, DFF, G, bx);
        pg8::EpiRelu2 E{(bf16*)(ws + WS_BIG)};
        pg8::gemm_phase<pg8::EpiRelu2, pg8::StaticOrder, true, true>(lds, g, S, E); } SEAM(6);
    if (IN(7)) { pg8::Gemm g{(const bf16*)(ws + WS_BIG), (const bf16*)(ws + WS_W2), MTOK, DM, DFF}; pg8::StaticOrder S; S.init(MTOK, DM, G, bx);
        pg8::EpiRes<true, true> E{XR, XR, mod + 5 * DM};
        pg8::gemm_phase<pg8::EpiRes<true, true>, pg8::StaticOrder, true, true>(lds, g, S, E); } SEAM(7);
    const float* mod1 = mod + NB * NMOD;
    if (IN(8)) { phase_norm<true>(XR, args.in[2] + DM, mod1 + 0 * DM, mod1 + 1 * DM, H, lane, wave, vcu, G); } SEAM(8);
    if (IN(9)) { pg8::Gemm g{H, (const bf16*)(ws + WS_WBIN), MTOK, BINP, DM}; pg8::StaticOrder S; S.init(MTOK, BINP, G, bx);
        pg8::EpiIn1 E{(bf16*)(ws + WS_Q), (bf16*)(ws + WS_QI), (bf16*)(ws + WS_KV), (bf16*)(ws + WS_KV) + 64, (bf16*)(ws + WS_KI), (float*)(ws + WS_WI), (const float*)(ws + WS_ROPE), args.in[16], args.in[17]};
        pg8::gemm_phase<pg8::EpiIn1, pg8::StaticOrder, true, true>(lds, g, S, E); } SEAM(9);
    if (IN(10)) { phase_dsa(ws, lds, tid, lane, wave, bx, G, args.dsa_mask); } SEAM(10);
    if (IN(11)) { pg8::Gemm g{(const bf16*)(ws + WS_AO), (const bf16*)(ws + WS_WBOUT), MTOK, DM, DM}; pg8::StaticOrder S; S.init(MTOK, DM, G, bx);
        pg8::EpiRes<true, true> E{XR, XR, mod1 + 2 * DM};
        pg8::gemm_phase<pg8::EpiRes<true, true>, pg8::StaticOrder, true, true>(lds, g, S, E); } SEAM(11);
    if (IN(12)) { phase_norm<true>(XR, args.in[3] + DM, mod1 + 3 * DM, mod1 + 4 * DM, H, lane, wave, vcu, G); } SEAM(12);
    if (IN(13)) { pg8::Gemm g{H, (const bf16*)(ws + WS_W1) + (size_t)DFF * DM, MTOK, DFF, DM}; pg8::StaticOrder S; S.init(MTOK, DFF, G, bx);
        pg8::EpiRelu2 E{(bf16*)(ws + WS_BIG)};
        pg8::gemm_phase<pg8::EpiRelu2, pg8::StaticOrder, true, true>(lds, g, S, E); } SEAM(13);
    if (IN(14)) { pg8::Gemm g{(const bf16*)(ws + WS_BIG), (const bf16*)(ws + WS_W2) + (size_t)DM * DFF, MTOK, DM, DFF}; pg8::StaticOrder S; S.init(MTOK, DM, G, bx);
        pg8::EpiRes<true, false> E{XR, xo, mod1 + 5 * DM};
        pg8::gemm_phase<pg8::EpiRes<true, false>, pg8::StaticOrder, true, true>(lds, g, S, E); }
#undef IN
#undef SEAM
}

extern "C" void kernel_launch(void* const* d_in, const int* in_sizes, int n_in, void* d_out, int out_size, void* d_ws, size_t ws_size, hipStream_t stream) {
    static int grid = 0;
    if (grid == 0) {
        if (n_in != 21 || in_sizes[0] != MTOK * DM || out_size != MTOK * DM || ws_size < WS_END) {
            fprintf(stderr, "kernel_launch: unexpected shapes: n_in %d in0 %d out %d ws %zu (need >= %zu); nothing launched\n", n_in, n_in > 0 ? in_sizes[0] : -1, out_size, ws_size, (size_t)WS_END); grid = -1; return; }
        int dev = 0, cus = 0, per_cu = 0;
        if (hipGetDevice(&dev) != hipSuccess || hipDeviceGetAttribute(&cus, hipDeviceAttributeMultiprocessorCount, dev) != hipSuccess) { fprintf(stderr, "kernel_launch: device query failed\n"); grid = -1; return; }
        if (hipFuncSetAttribute((const void*)mk_fwd, hipFuncAttributeMaxDynamicSharedMemorySize, LDS_BYTES) != hipSuccess) { fprintf(stderr, "kernel_launch: hipFuncSetAttribute(%d B LDS) failed\n", LDS_BYTES); grid = -1; return; }
        if (hipOccupancyMaxActiveBlocksPerMultiprocessor(&per_cu, (const void*)mk_fwd, NTHREADS, LDS_BYTES) != hipSuccess || per_cu < 1)
            fprintf(stderr, "kernel_launch: note: occupancy query reports %d workgroups per CU\n", per_cu);
        (void)hipGetLastError();
        grid = cus;
    }
    if (grid < 0) return;
    if (hipMemsetAsync((char*)d_ws + WS_CTL, 0, CTL_ZERO_BYTES, stream) != hipSuccess) { fprintf(stderr, "kernel_launch: memset failed\n"); return; }
    Args a{};
    for (int i = 0; i < 21; ++i) a.in[i] = (const float*)d_in[i];
    a.out = (float*)d_out; a.ws = (unsigned char*)d_ws; a.dsa_mask = 7;
    for (int i = 0; i < 32; ++i) a.rinv.v[i] = powf(10000.0f, -(float)(2 * i) / 64.0f);
    for (int li = 0; li < N_LAUNCHES; ++li) {
        if (N_LAUNCHES == 1) { a.ph_lo = 0; a.ph_hi = N_PHASES; } else { a.ph_lo = li; a.ph_hi = li + 1; }
        const int reps = (N_LAUNCHES != 1 && li == PROBE_PH) ? PROBE_N : 1;
        for (int r = 0; r < reps; ++r) {
            a.dsa_mask = (r + 1 < reps) ? PROBE_MASK : 7;
            hipLaunchKernelGGL(mk_fwd, dim3(grid), dim3(NTHREADS), LDS_BYTES, stream, a);
            const hipError_t le = hipPeekAtLastError();
            if (le != hipSuccess) { fprintf(stderr, "kernel_launch: launch %d failed: %s\n", li, hipGetErrorName(le)); break; }
        }
    }
}
```

```cpp
#include <hip/hip_runtime.h>
#include <cstdio>
#include <cstdint>
#include <cmath>
#define MK_N_LAUNCHES 1
#define PROBE_PH -1
#define PROBE_N 1
#define PROBE_MASK 7
namespace pg8 {
#define PG8_LAS __attribute__((address_space(3)))
typedef unsigned short bf16_t;
typedef short bf16x8 __attribute__((ext_vector_type(8)));
typedef float f32x4 __attribute__((ext_vector_type(4)));
typedef unsigned u32x4 __attribute__((ext_vector_type(4)));
constexpr int BM = 256, BK = 64, HALF = 128, HTB = HALF * BK * 2  , STAGE_BYTES = 8 * HTB, NXCD = 8, WGM = 8;

__host__ __device__ __forceinline__ int lds_byte(int r, int c) { const int st = (r >> 4) * 2 + (c >> 5), rr = r & 15, cc = c & 31, ob = rr * 64 + cc * 2; return st * 1024 + (ob ^ (((ob >> 9) & 1) << 5)); }
__host__ __device__ __forceinline__ void stage_rc(int b, int& R, int& C) { const int st = b / 1024, sb = b % 1024, swz = sb ^ (((sb >> 9) & 1) << 5); R = (st >> 1) * 16 + swz / 64; C = (st & 1) * 32 + (swz % 64) / 2; }
__host__ __device__ __forceinline__ int perm32(int rho) { const int n = rho >> 4, i = rho & 15; return 8 * (i >> 2) + 4 * n + (i & 3); }

struct Unit { int pm, pn; };
struct Gemm { const bf16_t* A; const bf16_t* Bt; int M, N, K; };

struct StaticOrder {
    int nM, nN, nwg, G, c;
    __host__ __device__ void init(int M, int N, int G_, int c_) { nM = M / BM; nN = N / BM; nwg = nM * nN; G = G_; c = c_; }
    __host__ __device__ bool next(int i, Unit& u) const {
        const long L = (long)i * G + c; if (L >= nwg) return false;
        int wgid = (int)L; { const int q = nwg / NXCD, r = nwg % NXCD, xcd = wgid % NXCD, off = wgid / NXCD; wgid = (xcd < r ? xcd * (q + 1) : r * (q + 1) + (xcd - r) * q) + off; }
        const int nig = WGM * nN, gid = wgid / nig, fm = gid * WGM, gsz = (nM - fm) < WGM ? (nM - fm) : WGM;
        u.pm = fm + ((wgid % nig) % gsz); u.pn = (wgid % nig) / gsz; return true;
    }
    __device__ __forceinline__ void a_ready(const Unit&) const {}
    __device__ __forceinline__ void done(const Unit&) const {}
};

__device__ __forceinline__ unsigned cvt_pk_bf16(float lo, float hi) { unsigned r; asm volatile("v_cvt_pk_bf16_f32 %0, %1, %2" : "=v"(r) : "v"(lo), "v"(hi)); return r; }
typedef float f32x2 __attribute__((ext_vector_type(2)));
template <class Epi, class Sched, bool ALIGN_EPI = false, bool SP2 = false>
__device__ __forceinline__ void gemm_phase(PG8_LAS unsigned char* lds, const Gemm g, const Sched& S, const Epi& E) {
    const int tid = threadIdx.x, wid = __builtin_amdgcn_readfirstlane(tid >> 6), lane = tid & 63, wr = wid >> 2, wc = wid & 3, fr = lane & 15, fq = lane >> 4;
    const int K = g.K, nt = K / BK;
    unsigned voffA[2], voffB[2];
#pragma unroll
    for (int i = 0; i < 2; ++i) { int R, C; stage_rc(tid * 16 + i * 8192, R, C); const int Rb = Epi::PERM ? ((R & ~31) + perm32(R & 31)) : R;
        voffA[i] = (unsigned)(R * K + C) * 2u; voffB[i] = (unsigned)(Rb * K + C) * 2u; }
    const size_t kstep = (size_t)(BK * 2);
    const size_t hstep = (size_t)HALF * K * 2;
    const size_t tstep = 2 * hstep;
    const unsigned ldsw = (unsigned)wid * 1024u;
    const int aoff = lds_byte(wr * 64 + fr, fq * 8), boff = lds_byte(wc * 32 + fr, fq * 8);
#define PG8_SA(b, h) (((b) * 2 + (h)) * HTB)
#define PG8_SB(b, h) ((4 + (b) * 2 + (h)) * HTB)
#define PG8_STAGE(bufoff, gbase, voff) do { _Pragma("unroll") for (int _i = 0; _i < 2; ++_i) \
        __builtin_amdgcn_global_load_lds((const unsigned*)((const char*)(gbase) + (voff)[_i]), (PG8_LAS unsigned*)(lds + (bufoff) + ldsw + _i * 8192), 16, 0, 0); } while (0)
#define PG8_LDA(dst, b, h) do { _Pragma("unroll") for (int m = 0; m < 4; ++m) _Pragma("unroll") for (int k = 0; k < 2; ++k) dst[m][k] = *(const PG8_LAS bf16x8*)(lds + PG8_SA(b, h) + aoff + m * 2048 + k * 1024); } while (0)
#define PG8_LDB(dst, b, h) do { _Pragma("unroll") for (int n = 0; n < 2; ++n) _Pragma("unroll") for (int k = 0; k < 2; ++k) dst[n][k] = *(const PG8_LAS bf16x8*)(lds + PG8_SB(b, h) + boff + n * 2048 + k * 1024); } while (0)
#define PG8_MMA(ai, bj, At, Bt) do { __builtin_amdgcn_s_setprio(1); _Pragma("unroll") for (int m = 0; m < 4; ++m) _Pragma("unroll") for (int n = 0; n < 2; ++n) _Pragma("unroll") for (int k = 0; k < 2; ++k) \
        acc[ai][bj][m][n] = __builtin_amdgcn_mfma_f32_16x16x32_bf16(Bt[n][k], At[m][k], acc[ai][bj][m][n], 0, 0, 0); __builtin_amdgcn_s_setprio(0); } while (0)
#define PG8_WAIT_V(n) asm volatile("s_waitcnt vmcnt(" #n ")" ::: "memory")
#define PG8_WAIT_L(n) asm volatile("s_waitcnt lgkmcnt(" #n ")" ::: "memory")
#define PG8_BAR __builtin_amdgcn_s_barrier()
#define PG8_SCHED __builtin_amdgcn_sched_barrier(0)
    Unit cur, nxt; int ui = 0;
    if (!S.next(0, cur)) return;
    f32x4 acc[2][2][4][2];
#pragma unroll
    for (int a = 0; a < 2; ++a)
#pragma unroll
        for (int b = 0; b < 2; ++b)
#pragma unroll
            for (int m = 0; m < 4; ++m)
#pragma unroll
                for (int n = 0; n < 2; ++n) acc[a][b][m][n] = (f32x4){0.f, 0.f, 0.f, 0.f};
    bf16x8 At[4][2], B0[2][2], B1[2][2];
    const char* cA = (const char*)g.A + (size_t)cur.pm * tstep; const char* cB = (const char*)g.Bt + (size_t)cur.pn * tstep;
    S.a_ready(cur);
    if constexpr (SP2) {
        PG8_STAGE(PG8_SB(0, 0), cB, voffB); PG8_STAGE(PG8_SB(0, 1), cB + hstep, voffB); PG8_STAGE(PG8_SA(0, 0), cA, voffA); PG8_STAGE(PG8_SA(0, 1), cA + hstep, voffA);
        if (wr == 1) PG8_BAR;
        PG8_WAIT_V(2); PG8_BAR;
        PG8_STAGE(PG8_SB(1, 0), cB + kstep, voffB); PG8_STAGE(PG8_SA(1, 0), cA + kstep, voffA); PG8_STAGE(PG8_SB(1, 1), cB + hstep + kstep, voffB);
        PG8_WAIT_V(6); PG8_BAR;
    } else {
        PG8_STAGE(PG8_SB(0, 0), cB, voffB); PG8_STAGE(PG8_SA(0, 0), cA, voffA); PG8_STAGE(PG8_SB(0, 1), cB + hstep, voffB); PG8_STAGE(PG8_SA(0, 1), cA + hstep, voffA);
        if (wr == 1) PG8_BAR;
        PG8_WAIT_V(4); PG8_BAR;
        PG8_STAGE(PG8_SB(1, 0), cB + kstep, voffB); PG8_STAGE(PG8_SA(1, 0), cA + kstep, voffA); PG8_STAGE(PG8_SB(1, 1), cB + hstep + kstep, voffB);
        PG8_WAIT_V(6); PG8_BAR;
    }
    for (;;) {
        const bool has_next = S.next(ui + 1, nxt);
        const char* nA = has_next ? (const char*)g.A + (size_t)nxt.pm * tstep : cA; const char* nB = has_next ? (const char*)g.Bt + (size_t)nxt.pn * tstep : cB;
        for (int t = 0; t < nt; t += 2) {
            const bool last = (t == nt - 2);
            const char* a1 = cA + (size_t)(t + 1) * kstep;
            const char* a2 = last ? nA : cA + (size_t)(t + 2) * kstep; const char* b2 = last ? nB : cB + (size_t)(t + 2) * kstep;
            const char* a3 = a2 + kstep; const char* b3 = b2 + kstep;
            if (last && has_next) S.a_ready(nxt);
            if constexpr (SP2) {
            PG8_LDB(B0, 0, 0); PG8_LDB(B1, 0, 1); PG8_SCHED; PG8_LDA(At, 0, 0); PG8_STAGE(PG8_SA(1, 1), a1 + hstep, voffA);
            PG8_WAIT_V(8); PG8_WAIT_L(0); PG8_BAR; PG8_MMA(0, 0, At, B0); PG8_MMA(0, 1, At, B1); PG8_BAR; PG8_SCHED;
            PG8_LDA(At, 0, 1); PG8_STAGE(PG8_SB(0, 0), b2, voffB); PG8_STAGE(PG8_SB(0, 1), b2 + hstep, voffB); PG8_STAGE(PG8_SA(0, 0), a2, voffA);
            PG8_WAIT_V(8); PG8_WAIT_L(0); PG8_BAR; PG8_MMA(1, 0, At, B0); PG8_MMA(1, 1, At, B1); PG8_BAR; PG8_SCHED;
            PG8_LDB(B0, 1, 0); PG8_LDB(B1, 1, 1); PG8_SCHED; PG8_LDA(At, 1, 0); PG8_STAGE(PG8_SA(0, 1), a2 + hstep, voffA);
            PG8_WAIT_V(8); PG8_WAIT_L(0); PG8_BAR; PG8_MMA(0, 0, At, B0); PG8_MMA(0, 1, At, B1); PG8_BAR; PG8_SCHED;
            PG8_LDA(At, 1, 1); PG8_STAGE(PG8_SB(1, 0), b3, voffB); PG8_STAGE(PG8_SB(1, 1), b3 + hstep, voffB); PG8_STAGE(PG8_SA(1, 0), a3, voffA);
            PG8_WAIT_V(8); PG8_WAIT_L(0); PG8_BAR; PG8_MMA(1, 0, At, B0); PG8_MMA(1, 1, At, B1); PG8_BAR; PG8_SCHED;
            } else {
            PG8_LDB(B0, 0, 0); PG8_SCHED; PG8_LDA(At, 0, 0); PG8_STAGE(PG8_SA(1, 1), a1 + hstep, voffA);
            PG8_WAIT_L(8); PG8_BAR; PG8_WAIT_L(0); PG8_MMA(0, 0, At, B0); PG8_BAR; PG8_SCHED;
            PG8_LDB(B1, 0, 1); PG8_STAGE(PG8_SB(0, 0), b2, voffB);
            PG8_BAR; PG8_WAIT_L(0); PG8_MMA(0, 1, At, B1); PG8_BAR;
            PG8_LDA(At, 0, 1); PG8_STAGE(PG8_SA(0, 0), a2, voffA);
            PG8_BAR; PG8_WAIT_L(0); PG8_MMA(1, 0, At, B0); PG8_BAR; PG8_SCHED;
            PG8_STAGE(PG8_SB(0, 1), b2 + hstep, voffB);
            PG8_WAIT_V(6); PG8_BAR; PG8_MMA(1, 1, At, B1); PG8_BAR;
            PG8_LDB(B0, 1, 0); PG8_SCHED; PG8_LDA(At, 1, 0); PG8_STAGE(PG8_SA(0, 1), a2 + hstep, voffA);
            PG8_WAIT_L(8); PG8_BAR; PG8_WAIT_L(0); PG8_MMA(0, 0, At, B0); PG8_BAR; PG8_SCHED;
            PG8_LDB(B1, 1, 1); PG8_STAGE(PG8_SB(1, 0), b3, voffB);
            PG8_BAR; PG8_WAIT_L(0); PG8_MMA(0, 1, At, B1); PG8_BAR;
            PG8_LDA(At, 1, 1); PG8_STAGE(PG8_SA(1, 0), a3, voffA);
            PG8_BAR; PG8_WAIT_L(0); PG8_MMA(1, 0, At, B0); PG8_BAR; PG8_SCHED;
            PG8_STAGE(PG8_SB(1, 1), b3 + hstep, voffB);
            PG8_WAIT_V(6); PG8_BAR; PG8_MMA(1, 1, At, B1); PG8_BAR;
            }
        }
        if constexpr (ALIGN_EPI) { if (wr == 0) PG8_BAR; }
        if constexpr (!Epi::AFTER_DRAIN) { E(acc, cur, wr, wc, fr, fq); S.done(cur); }
        if (!has_next) break;
#pragma unroll
        for (int a = 0; a < 2; ++a)
#pragma unroll
            for (int b = 0; b < 2; ++b)
#pragma unroll
                for (int m = 0; m < 4; ++m)
#pragma unroll
                    for (int n = 0; n < 2; ++n) acc[a][b][m][n] = (f32x4){0.f, 0.f, 0.f, 0.f};
        cur = nxt; cA = nA; cB = nB; ++ui;
        if constexpr (ALIGN_EPI) { if (wr == 1) PG8_BAR; }
    }
    PG8_WAIT_V(0);
    if constexpr (!ALIGN_EPI) { if (wr == 0) PG8_BAR; }
    PG8_BAR;
    if constexpr (Epi::AFTER_DRAIN) { E.fused(acc, cur, wr, wc, fr, fq, lds, wid, lane); S.done(cur); }
#undef PG8_SA
#undef PG8_SB
#undef PG8_STAGE
#undef PG8_LDA
#undef PG8_LDB
#undef PG8_MMA
#undef PG8_WAIT_V
#undef PG8_WAIT_L
#undef PG8_BAR
#undef PG8_SCHED
}
}
#define GAS __attribute__((address_space(1)))
#define LAS __attribute__((address_space(3)))
typedef unsigned short bf16;
typedef unsigned v4u __attribute__((ext_vector_type(4)));
typedef float f32x4 __attribute__((ext_vector_type(4)));
typedef short bf16x8 __attribute__((ext_vector_type(8)));
typedef GAS unsigned gu32;
typedef GAS unsigned long long gu64;
#define RLX_AGENT __ATOMIC_RELAXED, __HIP_MEMORY_SCOPE_AGENT
#define LDS_WAIT() asm volatile("s_waitcnt lgkmcnt(0)" ::: "memory")
#define VM_WAIT() asm volatile("s_waitcnt vmcnt(0)" ::: "memory")
__device__ __forceinline__ unsigned long long rt() { return __builtin_amdgcn_s_memrealtime(); }
__device__ __forceinline__ unsigned f2bf(float f) { unsigned u = __builtin_bit_cast(unsigned, f); return (u + 0x7fffu + ((u >> 16) & 1u)) >> 16; }
__device__ __forceinline__ unsigned pk2(float lo, float hi) { return f2bf(lo) | (f2bf(hi) << 16); }

#define XB_TMO      128
#define XB_XCNT(j)  (256  + 64 * (j))
#define XB_XSUB(j)  (1280 + 64 * (j))
#define XB_XGEN(j)  (2304 + 64 * (j))
#define XB_TOP      3328
#define XB_TOPGEN   3392
#define XCD_BAR_WORDS 3456
#define XB_SPIN_CAP (1u << 18)

__device__ __forceinline__ unsigned xb_ld(unsigned* p)              { return __hip_atomic_load(p, __ATOMIC_RELAXED, __HIP_MEMORY_SCOPE_AGENT); }
__device__ __forceinline__ unsigned xb_add(unsigned* p, unsigned v) { return __hip_atomic_fetch_add(p, v, __ATOMIC_RELAXED, __HIP_MEMORY_SCOPE_AGENT); }
__device__ __forceinline__ unsigned xb_xcc_id() { return (unsigned)__builtin_amdgcn_s_getreg((3 << 11) | 20) & 0xFu; }
#define XB_SPIN(cond, bar) do { unsigned _sp = 0; while (cond) { __builtin_amdgcn_s_sleep(1); \
    if ((++_sp & 255u) == 0u) { if (xb_ld(&(bar)[XB_TMO])) break; if (_sp > XB_SPIN_CAP) { atomicAdd(&(bar)[XB_TMO], 1u); break; } } } } while (0)

struct XcdBarrier {
    unsigned* bar; unsigned x;
    volatile LAS unsigned* st;
};

__device__ __forceinline__ XcdBarrier xcd_barrier_post(unsigned* bar, volatile LAS unsigned* st) {
    XcdBarrier b; b.bar = bar; b.x = xb_xcc_id(); b.st = st;
    if (threadIdx.x == 0) (void)xb_add(&bar[XB_XCNT(b.x)], 1u);
    return b;
}
__device__ __forceinline__ void xcd_barrier_complete(unsigned* bar, unsigned x, unsigned& nloc, unsigned& nx) {
    const unsigned G = gridDim.x * gridDim.y * gridDim.z;
    unsigned sum, cnt, mine, sp = 0u;
    for (;;) {
        sum = 0u; cnt = 0u; mine = 0u;
#pragma unroll
        for (unsigned j = 0; j < 16; ++j) { const unsigned c = xb_ld(&bar[XB_XCNT(j)]); sum += c; cnt += (c > 0u) ? 1u : 0u; mine = (j == x) ? c : mine; }
        if (sum == G) break;
        __builtin_amdgcn_s_sleep(1);
        if ((++sp & 255u) == 0u) { if (xb_ld(&bar[XB_TMO])) break; if (sp > XB_SPIN_CAP) { atomicAdd(&bar[XB_TMO], 1u); break; } }
    }
    nloc = mine > 0u ? mine : 1u; nx = cnt > 0u ? cnt : 1u;
}

__device__ __forceinline__ void xcd_barrier(const XcdBarrier& b) {
    asm volatile("s_waitcnt vmcnt(0)" ::: "memory");
    __syncthreads();
    if (threadIdx.x == 0) {
        unsigned* bar = b.bar;
        __builtin_amdgcn_s_waitcnt(0);
        unsigned nloc = b.st[0], nx = b.st[1];
        if (nloc == 0u) { xcd_barrier_complete(bar, b.x, nloc, nx); b.st[0] = nloc; b.st[1] = nx; }
        const unsigned old = xb_add(&bar[XB_XSUB(b.x)], 1u);
        const unsigned gen = old / nloc;
        if (old + 1u == (gen + 1u) * nloc) {
            __builtin_amdgcn_fence(__ATOMIC_RELEASE, "agent");
            asm volatile("s_waitcnt vmcnt(0)" ::: "memory");
            const unsigned og = xb_add(&bar[XB_TOP], 1u);
            const unsigned tg = og / nx;
            if (og + 1u == (tg + 1u) * nx) xb_add(&bar[XB_TOPGEN], 1u);
            else XB_SPIN(xb_ld(&bar[XB_TOPGEN]) == tg, bar);
            __builtin_amdgcn_fence(__ATOMIC_ACQUIRE, "agent");
            xb_add(&bar[XB_XGEN(b.x)], 1u);
            asm volatile("s_waitcnt vmcnt(0)" ::: "memory");
        } else {
            XB_SPIN(xb_ld(&bar[XB_XGEN(b.x)]) == gen, bar);
            __builtin_amdgcn_fence(__ATOMIC_ACQUIRE, "agent");
            asm volatile("s_waitcnt vmcnt(0)" ::: "memory");
        }
    }
    __syncthreads();
}

constexpr int NB = 8, SEQ = 4096, DM = 1024, MTOK = NB * SEQ, DFF = 4096, DRNN = 1280, NLB = 5, LBLK = 256;
constexpr int NHEAD = 16, HD = 64, IH = 8, TOPK = 256, BIN = 1736, BINP = 1792, NMOD = 6 * DM;
constexpr float RMS_EPS = 1e-6f;
constexpr int NWAVES = 8, NTHREADS = 512;
constexpr int N_PHASES = 15;
constexpr int N_LAUNCHES = MK_N_LAUNCHES;

constexpr size_t MiB = 1u << 20;
constexpr size_t WS_CTL = 0, CTL_ZERO_BYTES = 64 * 1024;
constexpr int CW_BAR = 4096;
constexpr size_t WS_MOD = 1 * MiB;
constexpr size_t WS_ROPE = 2 * MiB;
constexpr size_t WS_WAIN = 4 * MiB;
constexpr size_t WS_WAOUT = 9 * MiB;
constexpr size_t WS_WGATE = 12 * MiB;
constexpr size_t WS_WBIN = 14 * MiB;
constexpr size_t WS_WBOUT = 18 * MiB;
constexpr size_t WS_W1 = 20 * MiB;
constexpr size_t WS_W2 = 36 * MiB;
constexpr size_t WS_H = 64 * MiB;
constexpr size_t WS_BIG = 128 * MiB;
constexpr size_t WS_XB = WS_BIG, WS_GATE = WS_BIG + 80 * MiB, WS_Y = WS_BIG + 160 * MiB;
constexpr size_t WS_Q = WS_BIG, WS_QI = WS_BIG + 64 * MiB, WS_KV = WS_BIG + 96 * MiB  , WS_KI = WS_BIG + 104 * MiB, WS_WI = WS_BIG + 108 * MiB, WS_AO = WS_BIG + 112 * MiB;
constexpr size_t WS_XR = 384 * MiB;
constexpr size_t WS_END = 448 * MiB;

constexpr int LDS_BYTES = 163840;
constexpr int MISC_OFF = LDS_BYTES - 256;

typedef float f32x2v __attribute__((ext_vector_type(2)));
typedef __bf16 bf16x2_t __attribute__((ext_vector_type(2)));
__device__ __forceinline__ unsigned cvtpk(float lo, float hi) { const f32x2v v = {lo, hi}; return __builtin_bit_cast(unsigned, __builtin_convertvector(v, bf16x2_t)); }
#define pk2 cvtpk
typedef unsigned u32x2v __attribute__((ext_vector_type(2)));
typedef short s16x4v __attribute__((ext_vector_type(4)));

__device__ __forceinline__ float wave_sum(float v) {
#pragma unroll
    for (int o = 1; o < 64; o <<= 1) v += __shfl_xor(v, o);
    return v;
}
__device__ __forceinline__ float bf2f(unsigned short h) { return __builtin_bit_cast(float, (unsigned)h << 16); }
__device__ __forceinline__ float bflo(unsigned w) { return __builtin_bit_cast(float, w << 16); }
__device__ __forceinline__ float bfhi(unsigned w) { return __builtin_bit_cast(float, w & 0xffff0000u); }
__device__ __forceinline__ float sigmoidf_(float x) { return __builtin_amdgcn_rcpf(1.f + __builtin_amdgcn_exp2f(-1.4426950408889634f * x)); }

namespace pg8 {
__device__ __forceinline__ f32x2 gelu_tanh2(f32x2 x) {
    f32x2 u = (x * ((x * x) * 0.044715f + 1.0f)) * -2.302208198f;
    u.x = __builtin_amdgcn_exp2f(u.x); u.y = __builtin_amdgcn_exp2f(u.y); u = u + 1.0f;
    f32x2 r; r.x = __builtin_amdgcn_rcpf(u.x); r.y = __builtin_amdgcn_rcpf(u.y); return x * r;
}
struct EpiXbGate {
    static constexpr bool PERM = true, AFTER_DRAIN = false;
    bf16_t* XB; bf16_t* GT;
    __device__ __forceinline__ void operator()(const f32x4 (&acc)[2][2][4][2], const Unit& u, int wr, int wc, int fr, int fq) const {
        const bool isg = u.pn >= 5; bf16_t* base = isg ? GT : XB;
        const int row0 = u.pm * BM + wr * 64 + fr, col0 = (isg ? u.pn - 5 : u.pn) * BM + wc * 32 + 8 * fq;
#pragma unroll
        for (int ai = 0; ai < 2; ++ai)
#pragma unroll
            for (int m = 0; m < 4; ++m) { bf16_t* rowp = base + (size_t)(row0 + ai * HALF + m * 16) * DRNN + col0;
#pragma unroll
                for (int bj = 0; bj < 2; ++bj) { const f32x4 v0 = acc[ai][bj][m][0], v1 = acc[ai][bj][m][1];
                    f32x2 p0 = (f32x2){v0[0], v0[1]}, p1 = (f32x2){v0[2], v0[3]}, p2 = (f32x2){v1[0], v1[1]}, p3 = (f32x2){v1[2], v1[3]};
                    if (isg) { p0 = gelu_tanh2(p0); p1 = gelu_tanh2(p1); p2 = gelu_tanh2(p2); p3 = gelu_tanh2(p3); }
                    u32x4 w; w.x = cvtpk(p0.x, p0.y); w.y = cvtpk(p1.x, p1.y); w.z = cvtpk(p2.x, p2.y); w.w = cvtpk(p3.x, p3.y);
                    *(u32x4*)(rowp + bj * HALF) = w; } }
    }
};
template <bool RB, bool OB> struct EpiRes {
    static constexpr bool PERM = OB, AFTER_DRAIN = false;
    const void* res; void* out; const float* gate;
    __device__ __forceinline__ void operator()(const f32x4 (&acc)[2][2][4][2], const Unit& u, int wr, int wc, int fr, int fq) const {
        const int row0 = u.pm * BM + wr * 64 + fr, b = u.pm >> 4;
        const int colb = u.pn * BM + wc * 32 + (PERM ? 8 * fq : 4 * fq), nst = PERM ? 4 : 16;
        f32x2 gv[2][2][2];
#pragma unroll
        for (int bj = 0; bj < 2; ++bj)
#pragma unroll
            for (int n = 0; n < 2; ++n) { const f32x4 t = *(const f32x4*)(gate + b * NMOD + colb + bj * HALF + n * nst); gv[bj][n][0] = (f32x2){t[0], t[1]}; gv[bj][n][1] = (f32x2){t[2], t[3]}; }
#pragma unroll
        for (int ai = 0; ai < 2; ++ai)
#pragma unroll
            for (int m = 0; m < 4; ++m) { const size_t off = (size_t)(row0 + ai * HALF + m * 16) * DM + colb;
                f32x2 rv[2][2][2];
#pragma unroll
                for (int bj = 0; bj < 2; ++bj) {
                    if (RB && PERM) { const u32x4 w = *(const u32x4*)((const bf16_t*)res + off + bj * HALF);
                        rv[bj][0][0] = (f32x2){__builtin_bit_cast(float, w.x << 16), __builtin_bit_cast(float, w.x & 0xffff0000u)}; rv[bj][0][1] = (f32x2){__builtin_bit_cast(float, w.y << 16), __builtin_bit_cast(float, w.y & 0xffff0000u)};
                        rv[bj][1][0] = (f32x2){__builtin_bit_cast(float, w.z << 16), __builtin_bit_cast(float, w.z & 0xffff0000u)}; rv[bj][1][1] = (f32x2){__builtin_bit_cast(float, w.w << 16), __builtin_bit_cast(float, w.w & 0xffff0000u)}; }
                    else {
#pragma unroll
                        for (int n = 0; n < 2; ++n) {
                            if (RB) { const unsigned long long w = *(const unsigned long long*)((const bf16_t*)res + off + bj * HALF + n * nst); const unsigned lo = (unsigned)w, hi = (unsigned)(w >> 32);
                                rv[bj][n][0] = (f32x2){__builtin_bit_cast(float, lo << 16), __builtin_bit_cast(float, lo & 0xffff0000u)}; rv[bj][n][1] = (f32x2){__builtin_bit_cast(float, hi << 16), __builtin_bit_cast(float, hi & 0xffff0000u)}; }
                            else { const f32x4 t = *(const f32x4*)((const float*)res + off + bj * HALF + n * nst); rv[bj][n][0] = (f32x2){t[0], t[1]}; rv[bj][n][1] = (f32x2){t[2], t[3]}; } } } }
#pragma unroll
                for (int bj = 0; bj < 2; ++bj) { f32x2 o[2][2];
#pragma unroll
                    for (int n = 0; n < 2; ++n) { const f32x4 a = acc[ai][bj][m][n]; o[n][0] = rv[bj][n][0] + gv[bj][n][0] * (f32x2){a[0], a[1]}; o[n][1] = rv[bj][n][1] + gv[bj][n][1] * (f32x2){a[2], a[3]}; }
                    if (OB) { u32x4 w; w.x = cvtpk(o[0][0].x, o[0][0].y); w.y = cvtpk(o[0][1].x, o[0][1].y); w.z = cvtpk(o[1][0].x, o[1][0].y); w.w = cvtpk(o[1][1].x, o[1][1].y);
                        *(u32x4*)((bf16_t*)out + off + bj * HALF) = w; }
                    else { *(f32x4*)((float*)out + off + bj * HALF) = (f32x4){o[0][0].x, o[0][0].y, o[0][1].x, o[0][1].y}; *(f32x4*)((float*)out + off + bj * HALF + nst) = (f32x4){o[1][0].x, o[1][0].y, o[1][1].x, o[1][1].y}; } }
                asm volatile("" ::: "memory"); }
    }
};
struct EpiRelu2 {
    static constexpr bool PERM = true, AFTER_DRAIN = false;
    bf16_t* O;
    __device__ __forceinline__ void operator()(const f32x4 (&acc)[2][2][4][2], const Unit& u, int wr, int wc, int fr, int fq) const {
        const int row0 = u.pm * BM + wr * 64 + fr, col0 = u.pn * BM + wc * 32 + 8 * fq;
#pragma unroll
        for (int ai = 0; ai < 2; ++ai)
#pragma unroll
            for (int m = 0; m < 4; ++m) { bf16_t* rowp = O + (size_t)(row0 + ai * HALF + m * 16) * DFF + col0;
#pragma unroll
                for (int bj = 0; bj < 2; ++bj) { const f32x4 v0 = acc[ai][bj][m][0], v1 = acc[ai][bj][m][1];
                    f32x2 p0 = (f32x2){__builtin_amdgcn_fmed3f(v0[0], 0.f, 3.0e38f), __builtin_amdgcn_fmed3f(v0[1], 0.f, 3.0e38f)}, p1 = (f32x2){__builtin_amdgcn_fmed3f(v0[2], 0.f, 3.0e38f), __builtin_amdgcn_fmed3f(v0[3], 0.f, 3.0e38f)};
                    f32x2 p2 = (f32x2){__builtin_amdgcn_fmed3f(v1[0], 0.f, 3.0e38f), __builtin_amdgcn_fmed3f(v1[1], 0.f, 3.0e38f)}, p3 = (f32x2){__builtin_amdgcn_fmed3f(v1[2], 0.f, 3.0e38f), __builtin_amdgcn_fmed3f(v1[3], 0.f, 3.0e38f)};
                    p0 = p0 * p0; p1 = p1 * p1; p2 = p2 * p2; p3 = p3 * p3;
                    u32x4 w; w.x = cvtpk(p0.x, p0.y); w.y = cvtpk(p1.x, p1.y); w.z = cvtpk(p2.x, p2.y); w.w = cvtpk(p3.x, p3.y);
                    *(u32x4*)(rowp + bj * HALF) = w; } }
    }
};
struct EpiIn1 {
    static constexpr bool PERM = true, AFTER_DRAIN = false;
    bf16_t *Q, *QI, *K, *V, *KI; float* WI; const float* rope; const float *qg, *kg;
    __device__ __forceinline__ void operator()(const f32x4 (&acc)[2][2][4][2], const Unit& u, int wr, int wc, int fr, int fq) const {
        const int pn = u.pn;
        int kind;
        bf16_t* dst; int pitch, hoff;
        if (pn < 4) { kind = 0; dst = Q; pitch = DM; hoff = (4 * pn + wc) * 64; }
        else if (pn < 6) { kind = 1; dst = QI; pitch = 512; hoff = (4 * (pn - 4) + wc) * 64; }
        else if (wc == 0) { kind = 2; dst = K; pitch = 128; hoff = 0; }
        else if (wc == 1) { kind = 3; dst = KI; pitch = 64; hoff = 0; }
        else if (wc == 2) { kind = 4; dst = V; pitch = 128; hoff = 0; }
        else { kind = 5; dst = nullptr; pitch = 0; hoff = 0; }
        const bool donorm = (kind == 0 || kind == 2), dorope = (kind <= 3);
        const float osc = (kind == 0) ? 0.125f * 1.4426950408889634f : 1.f;
        f32x4 g1[2], g2[2];
#pragma unroll
        for (int n = 0; n < 2; ++n) { g1[n] = (f32x4){1.f, 1.f, 1.f, 1.f}; g2[n] = g1[n]; }
        if (kind == 0) {
#pragma unroll
            for (int n = 0; n < 2; ++n) { g1[n] = *(const f32x4*)(qg + 8 * fq + 4 * n); g2[n] = *(const f32x4*)(qg + 32 + 8 * fq + 4 * n); } }
        if (kind == 2) {
#pragma unroll
            for (int n = 0; n < 2; ++n) { g1[n] = *(const f32x4*)(kg + 8 * fq + 4 * n); g2[n] = *(const f32x4*)(kg + 32 + 8 * fq + 4 * n); } }
#pragma unroll
        for (int ai = 0; ai < 2; ++ai)
#pragma unroll
            for (int m = 0; m < 4; ++m) {
                const int row = u.pm * BM + ai * HALF + wr * 64 + m * 16 + fr, pos = row & (SEQ - 1);
                f32x4 x1[2], x2[2];
#pragma unroll
                for (int n = 0; n < 2; ++n) { x1[n] = acc[ai][0][m][n]; x2[n] = acc[ai][1][m][n]; }
                if (kind == 5) {
                    if (fq == 0) { *(f32x4*)(WI + (size_t)row * 8) = x1[0]; *(f32x4*)(WI + (size_t)row * 8 + 4) = x1[1]; }
                    continue;
                }
                if (donorm) {
                    float ss = 0.f;
#pragma unroll
                    for (int n = 0; n < 2; ++n)
#pragma unroll
                        for (int j = 0; j < 4; ++j) ss += x1[n][j] * x1[n][j] + x2[n][j] * x2[n][j];
                    ss += __shfl_xor(ss, 16); ss += __shfl_xor(ss, 32);
                    const float rs = 1.0f / sqrtf(ss * (1.f / 64.f) + RMS_EPS);
#pragma unroll
                    for (int n = 0; n < 2; ++n) { x1[n] = x1[n] * rs * g1[n]; x2[n] = x2[n] * rs * g2[n]; }
                }
                if (dorope) {
#pragma unroll
                    for (int n = 0; n < 2; ++n) { const f32x4 c = *(const f32x4*)(rope + pos * 32 + 8 * fq + 4 * n), s = *(const f32x4*)(rope + SEQ * 32 + pos * 32 + 8 * fq + 4 * n);
                        const f32x4 o1 = x1[n] * c - x2[n] * s, o2 = x2[n] * c + x1[n] * s; x1[n] = o1; x2[n] = o2; }
                }
#pragma unroll
                for (int n = 0; n < 2; ++n) { x1[n] = x1[n] * osc; x2[n] = x2[n] * osc; }
                bf16_t* rowp = (kind == 3) ? dst + (size_t)(row >> 4) * 1024 + fq * 128 + (row & 15) * 8 : dst + (size_t)row * pitch + hoff + 8 * fq;
                const int hi_off = (kind == 3) ? 512 : 32;
                u32x4 w; w.x = cvt_pk_bf16(x1[0][0], x1[0][1]); w.y = cvt_pk_bf16(x1[0][2], x1[0][3]); w.z = cvt_pk_bf16(x1[1][0], x1[1][1]); w.w = cvt_pk_bf16(x1[1][2], x1[1][3]);
                *(u32x4*)(rowp) = w;
                w.x = cvt_pk_bf16(x2[0][0], x2[0][1]); w.y = cvt_pk_bf16(x2[0][2], x2[0][3]); w.z = cvt_pk_bf16(x2[1][0], x2[1][1]); w.w = cvt_pk_bf16(x2[1][2], x2[1][3]);
                *(u32x4*)(rowp + hi_off) = w;
            }
    }
};
}

__device__ __forceinline__ int bin_row(int c) {
    if (c < 1024) { const int h = c >> 6, d = c & 63; return 256 * (h >> 2) + 128 * (d >> 5) + 32 * (h & 3) + (d & 31); }
    if (c < 1088) { const int d = c - 1024; return 1536 + 128 * (d >> 5) + (d & 31); }
    if (c < 1152) { const int d = c - 1088; return 1536 + 128 * (d >> 5) + 64 + (d & 31); }
    if (c < 1664) { const int cc = c - 1152, h = cc >> 6, d = cc & 63; return 256 * (4 + (h >> 2)) + 128 * (d >> 5) + 32 * (h & 3) + (d & 31); }
    if (c < 1728) { const int d = c - 1664; return 1536 + 128 * (d >> 5) + 32 + (d & 31); }
    return 1536 + 96 + (c - 1728);
}
template <int MODE>
__device__ __forceinline__ void tr_item(const float* W, int K, int N, bf16* WT, int item, LAS float* scr, int lane) {
    const int nblk = (N + 31) / 32, kb = item / nblk, nb = item % nblk, k0 = 64 * kb, n0 = 32 * nb;
    const int nn = n0 + (lane & 31); const bool nok = nn < N;
#pragma unroll 8
    for (int i = 0; i < 32; ++i) { const int kk = 2 * i + (lane >> 5); scr[kk * 33 + (lane & 31)] = nok ? W[(size_t)(k0 + kk) * N + nn] : 0.f; }
    LDS_WAIT(); asm volatile("" ::: "memory");
    const int c = lane & 7;
#pragma unroll
    for (int j = 0; j < 4; ++j) { const int n = (lane >> 3) + 8 * j, ncol = n0 + n; const LAS float* s = scr + (8 * c) * 33 + n;
        v4u o; o.x = pk2(s[0 * 33], s[1 * 33]); o.y = pk2(s[2 * 33], s[3 * 33]); o.z = pk2(s[4 * 33], s[5 * 33]); o.w = pk2(s[6 * 33], s[7 * 33]);
        if (ncol < N) { const int drow = (MODE == 0) ? ncol : bin_row(ncol); *(GAS v4u*)(WT + (size_t)drow * K + k0 + 8 * c) = o; } }
    LDS_WAIT(); asm volatile("" ::: "memory");
}

struct RopeInv { float v[32]; };

template <int PART>
__device__ __forceinline__ void phase_prep(const float* const* in, unsigned char* ws, LAS unsigned char* lds, const RopeInv& rinv, int tid, int lane, int wave, int bx, int G) {
  constexpr bool LATE = PART == 2;
  if (PART == 0) {
    if (bx < 192) {
        LAS float* cond = (LAS float*)lds; LAS float* part = (LAS float*)(lds + 32768);
        const float* cin = in[1];
        for (int i = tid; i < NB * DM; i += NTHREADS) { const float v = cin[i]; cond[i] = v / (1.f + __expf(-v)); }
        __syncthreads();
        const int l = bx / 96, c0 = 64 * (bx % 96), cq = tid & 15, kg = tid >> 4;
        f32x4 a[NB];
#pragma unroll
        for (int b = 0; b < NB; ++b) a[b] = (f32x4){0.f, 0.f, 0.f, 0.f};
        const float* wp = in[4] + (size_t)l * DM * NMOD + c0 + 4 * cq;
#pragma unroll 4
        for (int kk = 0; kk < 32; ++kk) { const int k = kg * 32 + kk; const f32x4 w = *(const f32x4*)(wp + (size_t)k * NMOD);
#pragma unroll
            for (int b = 0; b < NB; ++b) { const float cv = cond[b * DM + k]; a[b] += w * cv; } }
#pragma unroll
        for (int b = 0; b < NB; ++b) *(LAS f32x4*)(part + (kg * NB + b) * 64 + 4 * cq) = a[b];
        __syncthreads();
        { const int b = tid >> 6, col = tid & 63; float s = 0.f;
#pragma unroll 8
          for (int k2 = 0; k2 < 32; ++k2) s += part[(k2 * NB + b) * 64 + col];
          ((float*)(ws + WS_MOD))[(size_t)(l * NB + b) * NMOD + c0 + col] = s + in[5][l * NMOD + c0 + col]; }
        __syncthreads();
    }
    return;
  }
  if (LATE) {
    { float* rope = (float*)(ws + WS_ROPE);
      for (int idx = bx * NTHREADS + tid; idx < SEQ * 32; idx += G * NTHREADS) { const int pos = idx >> 5, i = idx & 31;
          const float ang = (float)pos * rinv.v[i]; const double a = (double)ang; const double k = rint(a * 0.15915494309189535); const float x = (float)(a * 0.15915494309189535 - k);
          rope[idx] = __builtin_amdgcn_cosf(x); rope[SEQ * 32 + idx] = __builtin_amdgcn_sinf(x); } }
    { bf16* wb = (bf16*)(ws + WS_WBIN);
      for (int i = bx * NTHREADS + tid; i < 56 * 128; i += G * NTHREADS) { const int r = i >> 7, c8 = i & 127; const int row = r < 24 ? 1536 + 96 + 8 + r : 1536 + 128 + 96 + (r - 24);
          *(GAS v4u*)(wb + (size_t)row * DM + 8 * c8) = (v4u){0u, 0u, 0u, 0u}; } }
  }
    LAS float* scr = (LAS float*)(lds + wave * 16384);
    const int gw = bx * NWAVES + wave, NGW = G * NWAVES;
    constexpr int I_AIN = 16 * 80, I_AOUT = 20 * 32, I_G1 = 4 * 8, I_GATES = 10 * I_G1, I_BIN = 16 * 55, I_BOUT = 16 * 32, I_W1 = 16 * 128, I_W2 = 64 * 32;
    constexpr int NEARLY = I_AIN + I_GATES, NLATE = 2 * I_W1 + 2 * I_W2 + I_AOUT + I_BIN + I_BOUT;
    for (int it = gw; it < (LATE ? NLATE : NEARLY); it += NGW) {
        int r = it;
        if (!LATE) {
            if (r < I_AIN) { tr_item<0>(in[6], DM, 2 * DRNN, (bf16*)(ws + WS_WAIN), r, scr, lane); continue; } r -= I_AIN;
            { const int mi = r / I_G1, n = mi >> 1, gsel = mi & 1;
              tr_item<0>(in[gsel ? 11 : 9] + (size_t)n * LBLK * LBLK, LBLK, LBLK, (bf16*)(ws + WS_WGATE) + (size_t)(n * 2 + gsel) * LBLK * LBLK, r % I_G1, scr, lane); continue; }
        }
        if (r < I_W1 * 2) { const int l = r / I_W1; tr_item<0>(in[19] + (size_t)l * DM * DFF, DM, DFF, (bf16*)(ws + WS_W1) + (size_t)l * DFF * DM, r % I_W1, scr, lane); continue; } r -= 2 * I_W1;
        if (r < I_W2 * 2) { const int l = r / I_W2; tr_item<0>(in[20] + (size_t)l * DFF * DM, DFF, DM, (bf16*)(ws + WS_W2) + (size_t)l * DM * DFF, r % I_W2, scr, lane); continue; } r -= 2 * I_W2;
        if (r < I_AOUT) { tr_item<0>(in[14], DRNN, DM, (bf16*)(ws + WS_WAOUT), r, scr, lane); continue; } r -= I_AOUT;
        if (r < I_BIN) { tr_item<1>(in[15], DM, BIN, (bf16*)(ws + WS_WBIN), r, scr, lane); continue; } r -= I_BIN;
        tr_item<0>(in[18], DM, DM, (bf16*)(ws + WS_WBOUT), r, scr, lane);
    }
}

template <bool XB16>
__device__ __forceinline__ void phase_norm(const void* x, const float* g, const float* mod_sh, const float* mod_sc, bf16* H, int lane, int wave, int vcu, int G) {
    const int gw = vcu * NWAVES + wave, NGW = G * NWAVES;
    for (int r0 = gw * 16; r0 < MTOK; r0 += NGW * 16) {
        const int b = r0 >> 12;
        f32x4 al[4], be[4];
#pragma unroll
        for (int j = 0; j < 4; ++j) { const int c = XB16 ? 8 * lane + 512 * (j >> 1) + 4 * (j & 1) : 4 * lane + 256 * j;
            const f32x4 gg = *(const f32x4*)(g + c), sc = *(const f32x4*)(mod_sc + b * NMOD + c); al[j] = gg * (sc + 1.f); be[j] = *(const f32x4*)(mod_sh + b * NMOD + c); }
#pragma unroll 2
        for (int rr = 0; rr < 16; ++rr) {
            f32x4 v[4]; float s = 0.f;
            if (XB16) {
                const GAS v4u* xr = (const GAS v4u*)((const bf16*)x + (size_t)(r0 + rr) * DM) + lane;
#pragma unroll
                for (int j = 0; j < 2; ++j) { const v4u w = xr[64 * j];
                    v[2 * j] = (f32x4){bflo(w.x), bfhi(w.x), bflo(w.y), bfhi(w.y)}; v[2 * j + 1] = (f32x4){bflo(w.z), bfhi(w.z), bflo(w.w), bfhi(w.w)}; }
            } else {
                const GAS f32x4* xr = (const GAS f32x4*)((const float*)x + (size_t)(r0 + rr) * DM) + lane;
#pragma unroll
                for (int j = 0; j < 4; ++j) v[j] = xr[64 * j];
            }
#pragma unroll
            for (int j = 0; j < 4; ++j) s += (v[j].x * v[j].x + v[j].y * v[j].y) + (v[j].z * v[j].z + v[j].w * v[j].w);
            const float rstd = 1.0f / sqrtf(wave_sum(s) * (1.f / DM) + RMS_EPS);
            f32x4 y[4];
#pragma unroll
            for (int j = 0; j < 4; ++j) y[j] = v[j] * rstd * al[j] + be[j];
            if (XB16) {
                GAS v4u* o16 = (GAS v4u*)(H + (size_t)(r0 + rr) * DM) + lane;
#pragma unroll
                for (int j = 0; j < 2; ++j) { v4u o; o.x = pk2(y[2 * j].x, y[2 * j].y); o.y = pk2(y[2 * j].z, y[2 * j].w); o.z = pk2(y[2 * j + 1].x, y[2 * j + 1].y); o.w = pk2(y[2 * j + 1].z, y[2 * j + 1].w); o16[64 * j] = o; }
            } else {
                GAS unsigned long long* o8 = (GAS unsigned long long*)(H + (size_t)(r0 + rr) * DM) + lane;
#pragma unroll
                for (int j = 0; j < 4; ++j) o8[64 * j] = (unsigned long long)pk2(y[j].x, y[j].y) | ((unsigned long long)pk2(y[j].z, y[j].w) << 32);
            }
        }
    }
}

constexpr int RQ_CT = 128, RQ_AP = 528  , RQ_SP = 68  ;
constexpr int RQ_AT = 0, RQ_A = RQ_CT * RQ_AP, RQ_B = RQ_A + RQ_CT * RQ_SP * 4, RQ_SEG = RQ_B + RQ_CT * RQ_SP * 4, RQ_END = RQ_SEG + 16 * 32 * 16;
static_assert(RQ_END <= MISC_OFF, "rglru LDS map");
__device__ __forceinline__ f32x2v bf2x(unsigned w) { return (f32x2v){__builtin_bit_cast(float, w << 16), __builtin_bit_cast(float, w & 0xffff0000u)}; }
__device__ __forceinline__ void phase_rglru(const float* const* in, unsigned char* ws, LAS unsigned char* lds, int tid, int lane, int wave, int bx) {
    if (bx >= 160) return;
    const int b = bx & 7, n = (bx >> 3) >> 2, g = (bx >> 3) & 3;
    const bf16* XB = (const bf16*)(ws + WS_XB); const bf16* GT = (const bf16*)(ws + WS_GATE); bf16* Y = (bf16*)(ws + WS_Y);
    const int fr = lane & 15, fq = lane >> 4, wr = wave >> 2, wc = wave & 3;
    pg8::bf16x8 Br[8], Bi[8];
    { const bf16* wr_ = (const bf16*)(ws + WS_WGATE) + (size_t)(n * 2 + 0) * LBLK * LBLK + (size_t)(64 * g + 16 * wc + fr) * LBLK + 8 * fq;
      const bf16* wi_ = wr_ + (size_t)LBLK * LBLK;
#pragma unroll
      for (int kk = 0; kk < 8; ++kk) { Br[kk] = *(const pg8::bf16x8*)(wr_ + 32 * kk); Bi[kk] = *(const pg8::bf16x8*)(wi_ + 32 * kk); } }
    const int chl0 = 16 * wc + 4 * fq, chg0 = LBLK * n + 64 * g + chl0;
    f32x2v brv[2], biv[2], nsp[2];
    { const f32x4 x = *(const f32x4*)(in[10] + chg0), y = *(const f32x4*)(in[12] + chg0), lam = *(const f32x4*)(in[13] + chg0);
      brv[0] = (f32x2v){x[0], x[1]}; brv[1] = (f32x2v){x[2], x[3]}; biv[0] = (f32x2v){y[0], y[1]}; biv[1] = (f32x2v){y[2], y[3]};
      float t[4];
#pragma unroll
      for (int j = 0; j < 4; ++j) t[j] = -8.f * 1.4426950408889634f * log1pf(__expf(-lam[j]));
      nsp[0] = (f32x2v){t[0], t[1]}; nsp[1] = (f32x2v){t[2], t[3]}; }
    const int cq = lane;
    const int cch = LBLK * n + 4 * cq;
    f32x2v cw[4][2], cb[2];
#pragma unroll
    for (int j = 0; j < 4; ++j) { const f32x4 w0 = *(const f32x4*)(in[7] + j * DRNN + cch); cw[j][0] = (f32x2v){w0[0], w0[1]}; cw[j][1] = (f32x2v){w0[2], w0[3]}; }
    { const f32x4 b0 = *(const f32x4*)(in[8] + cch); cb[0] = (f32x2v){b0[0], b0[1]}; cb[1] = (f32x2v){b0[2], b0[3]}; }
    const int cp = tid & 31, sg = tid >> 5;
    f32x2v hin = (f32x2v){0.f, 0.f};
    const size_t tok0 = (size_t)b * SEQ;
    u32x2v xr[19];
#define RQ_LOADX(t0_) do { _Pragma("unroll") for (int i_ = 0; i_ < 19; ++i_) { const int t_ = (t0_) + 16 * wave - 3 + i_; \
        xr[i_] = (t_ >= 0) ? *(const GAS u32x2v*)(XB + (tok0 + t_) * DRNN + cch) : (u32x2v){0u, 0u}; } } while (0)
    RQ_LOADX(0);
    for (int c = 0; c < SEQ / RQ_CT; ++c) {
        const int t0 = c * RQ_CT;
        { f32x2v xf[19][2];
#pragma unroll
          for (int i = 0; i < 19; ++i) { xf[i][0] = bf2x(xr[i].x); xf[i][1] = bf2x(xr[i].y); }
#pragma unroll
          for (int tt = 0; tt < 16; ++tt) { f32x2v o0 = cb[0], o1 = cb[1];
#pragma unroll
              for (int j = 0; j < 4; ++j) { o0 += cw[j][0] * xf[tt + j][0]; o1 += cw[j][1] * xf[tt + j][1]; }
              u32x2v pk; pk.x = pk2(o0.x, o0.y); pk.y = pk2(o1.x, o1.y);
              *(LAS u32x2v*)(lds + RQ_AT + (16 * wave + tt) * RQ_AP + 8 * cq) = pk; } }
        if (c + 1 < SEQ / RQ_CT) RQ_LOADX(t0 + RQ_CT);
        unsigned gt[8];
        { const bf16* gp = GT + (tok0 + t0 + 8 * sg) * DRNN + LBLK * n + 64 * g + 2 * cp;
#pragma unroll
          for (int t = 0; t < 8; ++t) gt[t] = *(const GAS unsigned*)(gp + (size_t)t * DRNN); }
        __syncthreads();
        f32x4 ar[4], ai_[4];
#pragma unroll
        for (int m = 0; m < 4; ++m) { ar[m] = (f32x4){0.f, 0.f, 0.f, 0.f}; ai_[m] = ar[m]; }
#pragma unroll
        for (int kk = 0; kk < 8; ++kk)
#pragma unroll
            for (int m = 0; m < 4; ++m) { const pg8::bf16x8 xf = *(const LAS pg8::bf16x8*)(lds + RQ_AT + (64 * wr + 16 * m + fr) * RQ_AP + (32 * kk + 8 * fq) * 2);
                ar[m] = __builtin_amdgcn_mfma_f32_16x16x32_bf16(Br[kk], xf, ar[m], 0, 0, 0); ai_[m] = __builtin_amdgcn_mfma_f32_16x16x32_bf16(Bi[kk], xf, ai_[m], 0, 0, 0); }
#pragma unroll
        for (int m = 0; m < 4; ++m) { const int tk = 64 * wr + 16 * m + fr;
            const u32x2v xw = *(const LAS u32x2v*)(lds + RQ_AT + tk * RQ_AP + (64 * g + chl0) * 2);
            f32x4 av, bv;
#pragma unroll
            for (int h = 0; h < 2; ++h) { const f32x2v xc = bf2x(h ? xw.y : xw.x);
                f32x2v tr_ = ((f32x2v){ar[m][2 * h], ar[m][2 * h + 1]} + brv[h]) * -1.4426950408889634f, ti_ = ((f32x2v){ai_[m][2 * h], ai_[m][2 * h + 1]} + biv[h]) * -1.4426950408889634f;
                tr_.x = __builtin_amdgcn_exp2f(tr_.x); tr_.y = __builtin_amdgcn_exp2f(tr_.y); ti_.x = __builtin_amdgcn_exp2f(ti_.x); ti_.y = __builtin_amdgcn_exp2f(ti_.y);
                tr_ = tr_ + 1.0f; ti_ = ti_ + 1.0f;
                f32x2v rr, ii; rr.x = __builtin_amdgcn_rcpf(tr_.x); rr.y = __builtin_amdgcn_rcpf(tr_.y); ii.x = __builtin_amdgcn_rcpf(ti_.x); ii.y = __builtin_amdgcn_rcpf(ti_.y);
                f32x2v la = rr * nsp[h], a; a.x = __builtin_amdgcn_exp2f(la.x); a.y = __builtin_amdgcn_exp2f(la.y);
                f32x2v q = 1.0f - a * a, s; s.x = __builtin_amdgcn_sqrtf(__builtin_fabsf(q.x)); s.y = __builtin_amdgcn_sqrtf(__builtin_fabsf(q.y));
                const f32x2v bb = s * (ii * xc);
                av[2 * h] = a.x; av[2 * h + 1] = a.y; bv[2 * h] = bb.x; bv[2 * h + 1] = bb.y; }
            *(LAS f32x4*)(lds + RQ_A + (tk * RQ_SP + chl0) * 4) = av; *(LAS f32x4*)(lds + RQ_B + (tk * RQ_SP + chl0) * 4) = bv; }
        __syncthreads();
        f32x2v sa[8], sb[8];
#pragma unroll
        for (int t = 0; t < 8; ++t) { sa[t] = *(const LAS f32x2v*)(lds + RQ_A + ((8 * sg + t) * RQ_SP + 2 * cp) * 4); sb[t] = *(const LAS f32x2v*)(lds + RQ_B + ((8 * sg + t) * RQ_SP + 2 * cp) * 4); }
        { f32x2v A = sa[0], H = sb[0];
#pragma unroll
          for (int t = 1; t < 8; ++t) { A = A * sa[t]; H = sa[t] * H + sb[t]; }
          *(LAS f32x4*)(lds + RQ_SEG + (sg * 32 + cp) * 16) = (f32x4){A.x, A.y, H.x, H.y}; }
        __syncthreads();
        { f32x2v h = hin, mine = hin;
#pragma unroll
          for (int s = 0; s < 16; ++s) { const f32x4 sh = *(const LAS f32x4*)(lds + RQ_SEG + (s * 32 + cp) * 16); if (s == sg) mine = h; h = (f32x2v){sh[0], sh[1]} * h + (f32x2v){sh[2], sh[3]}; }
          hin = h;
          f32x2v hh = mine; bf16* yp = Y + (tok0 + t0 + 8 * sg) * DRNN + LBLK * n + 64 * g + 2 * cp;
#pragma unroll
          for (int t = 0; t < 8; ++t) { hh = sa[t] * hh + sb[t]; const f32x2v yv = hh * bf2x(gt[t]); *(GAS unsigned*)(yp + (size_t)t * DRNN) = pk2(yv.x, yv.y); } }
    }
#undef RQ_LOADX
}

constexpr int DS_SCP = 8224;
constexpr int DS_H1 = 8 * DS_SCP, DS_H2 = DS_H1 + 8 * 4096, DS_BNC = 0, DS_IDX = 8 * 16384, DS_DMY = DS_IDX + 8 * 1024, DS_END = DS_DMY + 8 * 256;
static_assert(DS_END <= MISC_OFF && DS_H2 + 8 * 2048 <= DS_IDX, "dsa LDS map");

__device__ __forceinline__ unsigned mbcnt64(unsigned long long m) { return __builtin_amdgcn_mbcnt_hi((unsigned)(m >> 32), __builtin_amdgcn_mbcnt_lo((unsigned)m, 0u)); }
__device__ __forceinline__ void wave_prefix4(unsigned x, unsigned& pre, unsigned& tot) {
    pre = 0u; tot = 0u;
#pragma unroll
    for (int bit = 0; bit < 4; ++bit) { const unsigned long long m = __ballot((x >> bit) & 1u); pre += mbcnt64(m) << bit; tot += (unsigned)__popcll(m) << bit; }
}
__device__ __forceinline__ unsigned row_scan_u32(unsigned v) {
    v += (unsigned)__builtin_amdgcn_update_dpp(0, (int)v, 0x111, 0xf, 0xf, true);
    v += (unsigned)__builtin_amdgcn_update_dpp(0, (int)v, 0x112, 0xf, 0xf, true);
    v += (unsigned)__builtin_amdgcn_update_dpp(0, (int)v, 0x114, 0xf, 0xf, true);
    v += (unsigned)__builtin_amdgcn_update_dpp(0, (int)v, 0x118, 0xf, 0xf, true);
    return v;
}
__device__ __forceinline__ void hist_find4(v4u c4, unsigned need, int lane, unsigned& B, unsigned& above, unsigned& atb) {
    const unsigned s = c4.x + c4.y + c4.z + c4.w;
    const unsigned inc = row_scan_u32(s);
    const unsigned t0 = (unsigned)__builtin_amdgcn_readlane((int)inc, 15), t1 = (unsigned)__builtin_amdgcn_readlane((int)inc, 31), t2 = (unsigned)__builtin_amdgcn_readlane((int)inc, 47), t3 = (unsigned)__builtin_amdgcn_readlane((int)inc, 63);
    const int row = lane >> 4;
    const unsigned before = (row > 0 ? t0 : 0u) + (row > 1 ? t1 : 0u) + (row > 2 ? t2 : 0u) + (inc - s);
    const unsigned total = (t0 + t1) + (t2 + t3);
    const unsigned S = total - before;
    const unsigned long long mk = __ballot(S >= need);
    const int L = 63 - __builtin_clzll(mk | 1ull);
    unsigned cum = S - s, bin, ab, at;
    if (cum + c4.w >= need) { bin = 4 * lane + 3; ab = cum; at = c4.w; }
    else { cum += c4.w; if (cum + c4.z >= need) { bin = 4 * lane + 2; ab = cum; at = c4.z; }
        else { cum += c4.z; if (cum + c4.y >= need) { bin = 4 * lane + 1; ab = cum; at = c4.y; } else { cum += c4.y; bin = 4 * lane; ab = cum; at = c4.x; } } }
    B = __builtin_amdgcn_readlane(bin, L); above = __builtin_amdgcn_readlane(ab, L); atb = __builtin_amdgcn_readlane(at, L);
}
__device__ __forceinline__ void pk_count4(unsigned& a0, unsigned& a1, unsigned& a2, unsigned& a3, unsigned k0, unsigned k1, unsigned k2, unsigned k3, unsigned cm) {
    unsigned t0, t1, t2, t3;
    asm("v_pk_sub_u16 %4, %8, %12 clamp\n\tv_pk_sub_u16 %5, %9, %12 clamp\n\tv_pk_sub_u16 %6, %10, %12 clamp\n\tv_pk_sub_u16 %7, %11, %12 clamp\n\t"
        "v_pk_min_u16 %4, %4, 1 op_sel_hi:[1,0]\n\tv_pk_min_u16 %5, %5, 1 op_sel_hi:[1,0]\n\tv_pk_min_u16 %6, %6, 1 op_sel_hi:[1,0]\n\tv_pk_min_u16 %7, %7, 1 op_sel_hi:[1,0]\n\t"
        "v_pk_add_u16 %0, %0, %4\n\tv_pk_add_u16 %1, %1, %5\n\tv_pk_add_u16 %2, %2, %6\n\tv_pk_add_u16 %3, %3, %7"
        : "+v"(a0), "+v"(a1), "+v"(a2), "+v"(a3), "=&v"(t0), "=&v"(t1), "=&v"(t2), "=&v"(t3) : "v"(k0), "v"(k1), "v"(k2), "v"(k3), "v"(cm));
}
__device__ __forceinline__ unsigned pk_bin2(unsigned w, unsigned b1p) {
    unsigned t, g;
    asm("v_pk_sub_u16 %0, %2, %3\n\tv_and_or_b32 %1, %0, %4, %5\n\tv_pk_min_u16 %0, %0, %1" : "=&v"(t), "=&v"(g) : "v"(w), "v"(b1p), "v"(0x00ff00ffu), "v"(0x01000100u));
    return t;
}
typedef _Float16 h16x2 __attribute__((ext_vector_type(2)));
__device__ __forceinline__ h16x2 pkrtz(float a, float b) { return __builtin_bit_cast(h16x2, __builtin_amdgcn_cvt_pkrtz(a, b)); }
__device__ __forceinline__ unsigned score_key(float s) {
    const int h = (int)(short)__builtin_bit_cast(unsigned short, (_Float16)s);
    return ((unsigned)h ^ ((unsigned)(h >> 15) | 0x8000u)) & 0xffffu;
}

__device__ __forceinline__ void phase_dsa(unsigned char* ws, LAS unsigned char* lds, int tid, int lane, int wave, int bx, int G, int mask) {
    const bf16* Qb = (const bf16*)(ws + WS_Q); const bf16* QIb = (const bf16*)(ws + WS_QI); const bf16* KVb = (const bf16*)(ws + WS_KV);
    const bf16* KIb = (const bf16*)(ws + WS_KI); const float* WIb = (const float*)(ws + WS_WI); bf16* AO = (bf16*)(ws + WS_AO);
    const int lane0 = lane;
    const int b = bx & 7, jj = bx >> 3, nj = G >> 3;
    const size_t tokb = (size_t)b * SEQ;
    for (int i = 0; ; ++i) {
        const int qb = ((i & 1) ? (nj - 1 - jj) : jj) + nj * i;
        if (qb >= SEQ / 8) break;
        const int p0 = 8 * qb, nk16 = (p0 + 8 + 15) & ~15, NT = nk16 >> 4;
        if (mask & 1) {
            int lane = lane0; asm volatile("" : "+v"(lane));
            const int fr = lane & 15, fq = lane >> 4;
            pg8::bf16x8 QA[2][2][2];
#pragma unroll
            for (int grp = 0; grp < 2; ++grp)
#pragma unroll
                for (int hf = 0; hf < 2; ++hf)
#pragma unroll
                    for (int ks = 0; ks < 2; ++ks)
                        QA[grp][hf][ks] = *(const pg8::bf16x8*)(QIb + (tokb + p0 + 4 * grp + (fr >> 2)) * 512 + (4 * hf + (fr & 3)) * 64 + 32 * ks + 8 * fq);
            h16x2 wq[2][4];
#pragma unroll
            for (int grp = 0; grp < 2; ++grp) { const f32x4 w0 = *(const f32x4*)(WIb + (tokb + p0 + 4 * grp + fq) * 8), w1 = *(const f32x4*)(WIb + (tokb + p0 + 4 * grp + fq) * 8 + 4);
                wq[grp][0] = pkrtz(w0[0], w0[1]); wq[grp][1] = pkrtz(w0[2], w0[3]); wq[grp][2] = pkrtz(w1[0], w1[1]); wq[grp][3] = pkrtz(w1[2], w1[3]); }
            const int ntw = NT > wave ? (NT - wave + 7) >> 3 : 0, ng = (ntw + 3) >> 2;
            const char* kibase = (const char*)(KIb + tokb * 64);
            const unsigned koff = (unsigned)lane * 16u;
            const h16x2 hz = {(_Float16)0.f, (_Float16)0.f};
            pg8::bf16x8 ka[4][2], kb[4][2];
#define DS_A_LOAD(buf, g) do { _Pragma("unroll") for (int u_ = 0; u_ < 4; ++u_) { int kt_ = wave + 8 * (4 * (g) + u_); kt_ = kt_ < NT ? kt_ : NT - 1; const unsigned o_ = koff + (unsigned)kt_ * 2048u; \
                buf[u_][0] = *(const pg8::bf16x8*)(kibase + o_); buf[u_][1] = *(const pg8::bf16x8*)(kibase + o_ + 1024u); } } while (0)
#define DS_A_COMP(buf, g) do { f32x4 d_[4][2][2]; \
                _Pragma("unroll") for (int u_ = 0; u_ < 4; ++u_) _Pragma("unroll") for (int grp = 0; grp < 2; ++grp) _Pragma("unroll") for (int hf = 0; hf < 2; ++hf) { \
                    f32x4 z_ = (f32x4){0.f, 0.f, 0.f, 0.f}; z_ = __builtin_amdgcn_mfma_f32_16x16x32_bf16(QA[grp][hf][0], buf[u_][0], z_, 0, 0, 0); d_[u_][grp][hf] = __builtin_amdgcn_mfma_f32_16x16x32_bf16(QA[grp][hf][1], buf[u_][1], z_, 0, 0, 0); } \
                _Pragma("unroll") for (int u_ = 0; u_ < 4; ++u_) { const int kt_ = wave + 8 * (4 * (g) + u_); const int key_ = 16 * kt_ + fr; \
                    _Pragma("unroll") for (int grp = 0; grp < 2; ++grp) { float s_ = 0.f; \
                        _Pragma("unroll") for (int hf = 0; hf < 2; ++hf) { \
                            s_ = __builtin_amdgcn_fdot2(__builtin_elementwise_max(pkrtz(d_[u_][grp][hf][0], d_[u_][grp][hf][1]), hz), wq[grp][2 * hf], s_, false); \
                            s_ = __builtin_amdgcn_fdot2(__builtin_elementwise_max(pkrtz(d_[u_][grp][hf][2], d_[u_][grp][hf][3]), hz), wq[grp][2 * hf + 1], s_, false); } \
                        const int q_ = 4 * grp + fq; const unsigned kk_ = (key_ <= p0 + q_) ? score_key(s_) : 0u; \
                        if (kt_ < NT) *(LAS unsigned short*)(lds + q_ * DS_SCP + key_ * 2) = (unsigned short)kk_; } } } while (0)
            DS_A_LOAD(ka, 0);
            DS_A_LOAD(kb, 1);
            for (int g = 0; g < ng; g += 2) {
                DS_A_COMP(ka, g);
                DS_A_LOAD(ka, g + 2);
                if (g + 1 < ng) DS_A_COMP(kb, g + 1);
                DS_A_LOAD(kb, g + 3);
            }
#undef DS_A_LOAD
#undef DS_A_COMP
        }
        LDS_WAIT();
        __syncthreads();
        const int p = p0 + wave, nvalid = p + 1;
        LAS unsigned* idx = (LAS unsigned*)(lds + DS_IDX + wave * 1024);
        int nsel = 1;
        if (!(mask & 2)) { }
        else if (nvalid <= TOPK) {
#pragma unroll
            for (int r = 0; r < 4; ++r) { const int s = lane0 + 64 * r; idx[s] = (unsigned)(s < nvalid ? s : 0) << 8; }
            nsel = nvalid;
        } else {
            int lane = lane0; asm volatile("" : "+v"(lane));
            const LAS unsigned char* row = lds + wave * DS_SCP;
            const int nit = (nk16 + 511) >> 9;
            unsigned kp[8][4];
#pragma unroll
            for (int it = 0; it < 8; ++it) { v4u v = (v4u){0u, 0u, 0u, 0u};
                if (it < nit) { const int e0 = it * 512 + lane * 8; if (e0 < nk16) v = *(const LAS v4u*)(row + e0 * 2); }
#pragma unroll
                for (int x = 0; x < 4; ++x) kp[it][x] = v[x]; }
            const unsigned h1w = DS_H1 + wave * 4096, h2w = DS_H2 + wave * 2048;
#pragma unroll
            for (int r = 0; r < 4; ++r) *(LAS v4u*)(lds + h1w + r * 1024 + lane * 16) = (v4u){0u, 0u, 0u, 0u};
#pragma unroll
            for (int r = 0; r < 2; ++r) *(LAS v4u*)(lds + h2w + r * 1024 + lane * 16) = (v4u){0u, 0u, 0u, 0u};
            LDS_WAIT();
            const unsigned h1l = h1w + (unsigned)(lane & 3) * 1024u;
#pragma unroll
            for (int it = 0; it < 8; ++it) if (it < nit) {
#pragma unroll
                for (int x = 0; x < 4; ++x) { const unsigned w = kp[it][x];
                    __hip_atomic_fetch_add((LAS unsigned*)(lds + h1l + ((w >> 6) & 0x3fcu)), 1u, __ATOMIC_RELAXED, __HIP_MEMORY_SCOPE_WORKGROUP);
                    __hip_atomic_fetch_add((LAS unsigned*)(lds + h1l + ((w >> 22) & 0x3fcu)), 1u, __ATOMIC_RELAXED, __HIP_MEMORY_SCOPE_WORKGROUP); } }
            LDS_WAIT();
            unsigned B1, above1, at1;
            { const v4u c0 = *(const LAS v4u*)(lds + h1w + lane * 16), c1 = *(const LAS v4u*)(lds + h1w + 1024 + lane * 16), c2 = *(const LAS v4u*)(lds + h1w + 2048 + lane * 16), c3 = *(const LAS v4u*)(lds + h1w + 3072 + lane * 16);
              hist_find4((c0 + c1) + (c2 + c3), (unsigned)TOPK, lane, B1, above1, at1); }
            const unsigned need1 = (unsigned)TOPK - above1;
            const unsigned b1p = B1 * 0x01000100u;
#pragma unroll
            for (int it = 0; it < 8; ++it) if (it < nit) {
#pragma unroll
                for (int x = 0; x < 4; ++x) { const unsigned m = pk_bin2(kp[it][x], b1p);
                    __hip_atomic_fetch_add((LAS unsigned*)(lds + h2w + ((m & 0xffffu) << 2)), 1u, __ATOMIC_RELAXED, __HIP_MEMORY_SCOPE_WORKGROUP);
                    __hip_atomic_fetch_add((LAS unsigned*)(lds + h2w + ((m >> 16) << 2)), 1u, __ATOMIC_RELAXED, __HIP_MEMORY_SCOPE_WORKGROUP); } }
            LDS_WAIT();
            unsigned B2, above2, at2;
            hist_find4(*(const LAS v4u*)(lds + h2w + lane * 16), need1, lane, B2, above2, at2);
            const unsigned T = (B1 << 8) | B2, need_eq = need1 - above2;
            if (need_eq == at2) {
                unsigned a0 = 0u, a1 = 0u, a2 = 0u, a3 = 0u; const unsigned cm = (T - 1u) * 0x10001u;
#pragma unroll
                for (int it = 0; it < 8; ++it) if (it < nit) pk_count4(a0, a1, a2, a3, kp[it][0], kp[it][1], kp[it][2], kp[it][3], cm);
                const unsigned a_ = (a0 + a1) + (a2 + a3), cl = (a_ & 0xffffu) + (a_ >> 16);
                const unsigned inc = row_scan_u32(cl);
                const unsigned t0 = (unsigned)__builtin_amdgcn_readlane((int)inc, 15), t1 = (unsigned)__builtin_amdgcn_readlane((int)inc, 31), t2 = (unsigned)__builtin_amdgcn_readlane((int)inc, 47);
                const int rw = lane >> 4;
                unsigned pa = DS_IDX + wave * 1024 + 4u * ((rw > 0 ? t0 : 0u) + (rw > 1 ? t1 : 0u) + (rw > 2 ? t2 : 0u) + (inc - cl));
                const unsigned eb = (unsigned)lane * 2048u;
#pragma unroll
                for (int it = 0; it < 8; ++it) if (it < nit) {
#pragma unroll
                    for (int k = 0; k < 8; ++k) { const unsigned kk_ = (k & 1) ? (kp[it][k >> 1] >> 16) : (kp[it][k >> 1] & 0xffffu);
                        if (kk_ >= T) { *(LAS unsigned*)(lds + pa) = eb + (unsigned)((it * 512 + k) << 8); pa += 4u; } } }
            } else {
                unsigned cnt = 0u, eqc = 0u;
#pragma unroll
                for (int it = 0; it < 8; ++it) if (it < nit) {
                    unsigned gtm = 0u, eqm = 0u;
#pragma unroll
                    for (int k = 0; k < 8; ++k) { const unsigned kk_ = (k & 1) ? (kp[it][k >> 1] >> 16) : (kp[it][k >> 1] & 0xffffu); gtm |= (kk_ > T) ? (1u << k) : 0u; eqm |= (kk_ == T) ? (1u << k) : 0u; }
                    unsigned selm = gtm;
                    if (__ballot(eqm != 0u)) { unsigned pre, tot; wave_prefix4((unsigned)__popc(eqm), pre, tot); unsigned run = eqc + pre;
#pragma unroll
                        for (int k = 0; k < 8; ++k) if ((eqm >> k) & 1u) { if (run < need_eq) selm |= (1u << k); ++run; }
                        eqc += tot; }
                    if (__ballot(selm != 0u)) { unsigned pre, tot; wave_prefix4((unsigned)__popc(selm), pre, tot); unsigned pos = cnt + pre; const int e0 = it * 512 + lane * 8;
#pragma unroll
                        for (int k = 0; k < 8; ++k) if ((selm >> k) & 1u) { idx[pos & 255u] = (unsigned)(e0 + k) << 8; ++pos; }
                        cnt += tot; }
                }
            }
            nsel = TOPK;
        }
        LDS_WAIT();
        __syncthreads();
        if (mask & 4) {
            int lane = lane0; asm volatile("" : "+v"(lane));
            const int fr = lane & 15, fq = lane >> 4;
            const unsigned kbn = DS_BNC + wave * 16384, vbn = kbn + 8192;
            const pg8::bf16x8 q0 = *(const pg8::bf16x8*)(Qb + (tokb + p) * DM + fr * 64 + 8 * fq), q1 = *(const pg8::bf16x8*)(Qb + (tokb + p) * DM + fr * 64 + 32 + 8 * fq);
            const char* kvbase = (const char*)(KVb + tokb * 128);
            const int gr = lane >> 3, gc = lane & 7;
#define DS_ROFF(g_, ro_) do { const v4u i0_ = *(const LAS v4u*)((const LAS unsigned char*)idx + (64 * (g_) + 8 * gr) * 4), i1_ = *(const LAS v4u*)((const LAS unsigned char*)idx + (64 * (g_) + 8 * gr) * 4 + 16); \
                _Pragma("unroll") for (int j = 0; j < 4; ++j) { ro_[j] = i0_[j] + (unsigned)gc * 16u; ro_[4 + j] = i1_[j] + (unsigned)gc * 16u; } } while (0)
            v4u kreg[3][8], vreg[4][8];
#pragma unroll
            for (int g = 0; g < 3; ++g) { unsigned ro[8]; DS_ROFF(g, ro);
#pragma unroll
                for (int j = 0; j < 8; ++j) kreg[g][j] = *(const v4u*)(kvbase + ro[j]); }
            pg8::bf16x8 pf[8];
            const unsigned kfr = kbn + fr * 128;
            const int ksw = (fr >> 1) & 7;
#pragma unroll
            for (int g = 0; g < 4; ++g) {
                asm volatile("s_waitcnt lgkmcnt(0)" ::: "memory");
#pragma unroll
                for (int j = 0; j < 8; ++j) { const int rl = 8 * j + gr; *(LAS v4u*)(lds + kbn + rl * 128 + ((gc ^ ((rl >> 1) & 7)) << 4)) = kreg[g == 3 ? 0 : g][j]; }
                asm volatile("s_waitcnt lgkmcnt(0)" ::: "memory");
                f32x4 pt[4];
#pragma unroll
                for (int tt = 0; tt < 4; ++tt) {
                    const pg8::bf16x8 k0 = *(const LAS pg8::bf16x8*)(lds + kfr + tt * 2048 + ((fq ^ ksw) << 4)), k1 = *(const LAS pg8::bf16x8*)(lds + kfr + tt * 2048 + (((4 + fq) ^ ksw) << 4));
                    f32x4 d = (f32x4){0.f, 0.f, 0.f, 0.f};
                    d = __builtin_amdgcn_mfma_f32_16x16x32_bf16(k0, q0, d, 0, 0, 0); pt[tt] = __builtin_amdgcn_mfma_f32_16x16x32_bf16(k1, q1, d, 0, 0, 0); }
#pragma unroll
                for (int tt = 0; tt < 4; ++tt) {
#pragma unroll
                    for (int r = 0; r < 4; ++r) pt[tt][r] = __builtin_amdgcn_exp2f(pt[tt][r]);
                    if (nsel < TOPK) {
#pragma unroll
                        for (int r = 0; r < 4; ++r) { const int rl = 16 * tt + 4 * fq + r; if (64 * g + 8 * (rl & 7) + (rl >> 3) >= nsel) pt[tt][r] = 0.f; } } }
#pragma unroll
                for (int h2 = 0; h2 < 2; ++h2) { v4u w; w.x = pg8::cvt_pk_bf16(pt[2 * h2][0], pt[2 * h2][1]); w.y = pg8::cvt_pk_bf16(pt[2 * h2][2], pt[2 * h2][3]);
                    w.z = pg8::cvt_pk_bf16(pt[2 * h2 + 1][0], pt[2 * h2 + 1][1]); w.w = pg8::cvt_pk_bf16(pt[2 * h2 + 1][2], pt[2 * h2 + 1][3]); pf[2 * g + h2] = __builtin_bit_cast(pg8::bf16x8, w); }
                if (g == 0) { unsigned ro[8]; DS_ROFF(3, ro);
#pragma unroll
                    for (int j = 0; j < 8; ++j) kreg[0][j] = *(const v4u*)(kvbase + ro[j]); }
                else { unsigned ro[8]; DS_ROFF(g - 1, ro);
#pragma unroll
                  for (int j = 0; j < 8; ++j) vreg[g - 1][j] = *(const v4u*)(kvbase + ro[j] + 128u); }
            }
            f32x4 o[4], osum = (f32x4){0.f, 0.f, 0.f, 0.f};
#pragma unroll
            for (int dt = 0; dt < 4; ++dt) o[dt] = (f32x4){0.f, 0.f, 0.f, 0.f};
            pg8::bf16x8 ones;
#pragma unroll
            for (int e = 0; e < 8; ++e) ones[e] = (short)0x3f80;
            const int trow = 4 * fq + (fr >> 2), tsw = (trow >> 1) & 3;
            const unsigned tbase = vbn + trow * 128 + (fr & 3) * 8;
#pragma unroll
            for (int g = 0; g < 4; ++g) {
                asm volatile("s_waitcnt lgkmcnt(0)" ::: "memory");
#pragma unroll
                for (int j = 0; j < 8; ++j) { const int rl = 8 * j + gr; *(LAS v4u*)(lds + vbn + rl * 128 + (((((gc >> 1) ^ ((rl >> 1) & 3)) << 1) | (gc & 1)) << 4)) = vreg[g][j]; }
                if (g == 0) { unsigned ro[8]; DS_ROFF(3, ro);
#pragma unroll
                    for (int j = 0; j < 8; ++j) vreg[3][j] = *(const v4u*)(kvbase + ro[j] + 128u); }
                asm volatile("s_waitcnt lgkmcnt(0)" ::: "memory");
#pragma unroll
                for (int s2l = 0; s2l < 2; ++s2l) {
#pragma unroll
                    for (int dt = 0; dt < 4; ++dt) { const unsigned a0 = tbase + s2l * 4096 + ((dt ^ tsw) << 5);
                        const s16x4v lo = __builtin_bit_cast(s16x4v, __builtin_amdgcn_ds_read_tr16_b64_v4i16((LAS s16x4v*)(lds + a0)));
                        const s16x4v hi = __builtin_bit_cast(s16x4v, __builtin_amdgcn_ds_read_tr16_b64_v4i16((LAS s16x4v*)(lds + a0 + 2048)));
                        const pg8::bf16x8 vf = __builtin_shufflevector(lo, hi, 0, 1, 2, 3, 4, 5, 6, 7);
                        o[dt] = __builtin_amdgcn_mfma_f32_16x16x32_bf16(vf, pf[2 * g + s2l], o[dt], 0, 0, 0); }
                    osum = __builtin_amdgcn_mfma_f32_16x16x32_bf16(ones, pf[2 * g + s2l], osum, 0, 0, 0);
                }
            }
#undef DS_ROFF
            const float rinv = 1.f / osum[0];
            bf16* op = AO + (tokb + p) * DM + fr * 64 + 4 * fq;
#pragma unroll
            for (int dt = 0; dt < 4; ++dt) { u32x2v w; w.x = pg8::cvt_pk_bf16(o[dt][0] * rinv, o[dt][1] * rinv); w.y = pg8::cvt_pk_bf16(o[dt][2] * rinv, o[dt][3] * rinv); *(u32x2v*)(op + 16 * dt) = w; }
        }
        asm volatile("s_waitcnt vmcnt(0) lgkmcnt(0)" ::: "memory");
        __syncthreads();
    }
}

struct Args { const float* in[21]; float* out; unsigned char* ws; RopeInv rinv; int ph_lo, ph_hi, dsa_mask, pad; };
static_assert(sizeof(Args) == 21 * 8 + 8 + 8 + 128 + 16, "Args has no padding");

__global__ void __launch_bounds__(NTHREADS, 2) mk_fwd(Args args) {
    extern __shared__ __attribute__((aligned(16))) unsigned char lds_raw[];
    LAS unsigned char* lds = (LAS unsigned char*)lds_raw;
    const int tid = threadIdx.x, lane = tid & 63, wave = __builtin_amdgcn_readfirstlane(tid >> 6);
    const int G = gridDim.x, bx = blockIdx.x;
    const int vcu = (G % 8 == 0) ? (bx % 8) * (G / 8) + bx / 8 : bx;
    unsigned char* ws = args.ws;
    volatile LAS unsigned* MISC = (volatile LAS unsigned*)(lds + MISC_OFF);
    if (tid < 64) MISC[tid] = 0u;
    __syncthreads();
    const int lo = args.ph_lo, hi = args.ph_hi;
    XcdBarrier bar; bar.bar = (unsigned*)(ws + WS_CTL) + CW_BAR; bar.x = 0; bar.st = nullptr;
    if (hi - lo > 1) bar = xcd_barrier_post((unsigned*)(ws + WS_CTL) + CW_BAR, MISC + 8);
#define IN(k) (lo <= (k) && (k) < hi)
#define SEAM(k) do { if (IN(k) && IN((k) + 1)) xcd_barrier(bar); } while (0)
    const float* mod = (const float*)(ws + WS_MOD);
    bf16* H = (bf16*)(ws + WS_H);
    const float* x_in = args.in[0]; float* xo = args.out;
    bf16* XR = (bf16*)(ws + WS_XR);

    if (IN(0)) { phase_prep<0>(args.in, ws, lds, args.rinv, tid, lane, wave, bx, G); } SEAM(0);
    if (IN(1)) { phase_norm<false>(x_in, args.in[2], mod + 0 * DM, mod + 1 * DM, H, lane, wave, vcu, G); phase_prep<1>(args.in, ws, lds, args.rinv, tid, lane, wave, bx, G); } SEAM(1);
    if (IN(2)) { pg8::Gemm g{H, (const bf16*)(ws + WS_WAIN), MTOK, 2 * DRNN, DM}; pg8::StaticOrder S; S.init(MTOK, 2 * DRNN, G, bx);
        pg8::EpiXbGate E{(bf16*)(ws + WS_XB), (bf16*)(ws + WS_GATE)};
        pg8::gemm_phase<pg8::EpiXbGate, pg8::StaticOrder, true, true>(lds, g, S, E); } SEAM(2);
    if (IN(3)) { if (bx < 160) phase_rglru(args.in, ws, lds, tid, lane, wave, bx); else phase_prep<2>(args.in, ws, lds, args.rinv, tid, lane, wave, bx - 160, G - 160); } SEAM(3);
    if (IN(4)) { pg8::Gemm g{(const bf16*)(ws + WS_Y), (const bf16*)(ws + WS_WAOUT), MTOK, DM, DRNN}; pg8::StaticOrder S; S.init(MTOK, DM, G, bx);
        pg8::EpiRes<false, true> E{x_in, XR, mod + 2 * DM};
        pg8::gemm_phase<pg8::EpiRes<false, true>, pg8::StaticOrder, true, true>(lds, g, S, E); } SEAM(4);
    if (IN(5)) { phase_norm<true>(XR, args.in[3], mod + 3 * DM, mod + 4 * DM, H, lane, wave, vcu, G); } SEAM(5);
    if (IN(6)) { pg8::Gemm g{H, (const bf16*)(ws + WS_W1), MTOK, DFF, DM}; pg8::StaticOrder S; S.init(MTOK, DFF, G, bx);
        pg8::EpiRelu2 E{(bf16*)(ws + WS_BIG)};
        pg8::gemm_phase<pg8::EpiRelu2, pg8::StaticOrder, true, true>(lds, g, S, E); } SEAM(6);
    if (IN(7)) { pg8::Gemm g{(const bf16*)(ws + WS_BIG), (const bf16*)(ws + WS_W2), MTOK, DM, DFF}; pg8::StaticOrder S; S.init(MTOK, DM, G, bx);
        pg8::EpiRes<true, true> E{XR, XR, mod + 5 * DM};
        pg8::gemm_phase<pg8::EpiRes<true, true>, pg8::StaticOrder, true, true>(lds, g, S, E); } SEAM(7);
    const float* mod1 = mod + NB * NMOD;
    if (IN(8)) { phase_norm<true>(XR, args.in[2] + DM, mod1 + 0 * DM, mod1 + 1 * DM, H, lane, wave, vcu, G); } SEAM(8);
    if (IN(9)) { pg8::Gemm g{H, (const bf16*)(ws + WS_WBIN), MTOK, BINP, DM}; pg8::StaticOrder S; S.init(MTOK, BINP, G, bx);
        pg8::EpiIn1 E{(bf16*)(ws + WS_Q), (bf16*)(ws + WS_QI), (bf16*)(ws + WS_KV), (bf16*)(ws + WS_KV) + 64, (bf16*)(ws + WS_KI), (float*)(ws + WS_WI), (const float*)(ws + WS_ROPE), args.in[16], args.in[17]};
        pg8::gemm_phase<pg8::EpiIn1, pg8::StaticOrder, true, true>(lds, g, S, E); } SEAM(9);
    if (IN(10)) { phase_dsa(ws, lds, tid, lane, wave, bx, G, args.dsa_mask); } SEAM(10);
    if (IN(11)) { pg8::Gemm g{(const bf16*)(ws + WS_AO), (const bf16*)(ws + WS_WBOUT), MTOK, DM, DM}; pg8::StaticOrder S; S.init(MTOK, DM, G, bx);
        pg8::EpiRes<true, true> E{XR, XR, mod1 + 2 * DM};
        pg8::gemm_phase<pg8::EpiRes<true, true>, pg8::StaticOrder, true, true>(lds, g, S, E); } SEAM(11);
    if (IN(12)) { phase_norm<true>(XR, args.in[3] + DM, mod1 + 3 * DM, mod1 + 4 * DM, H, lane, wave, vcu, G); } SEAM(12);
    if (IN(13)) { pg8::Gemm g{H, (const bf16*)(ws + WS_W1) + (size_t)DFF * DM, MTOK, DFF, DM}; pg8::StaticOrder S; S.init(MTOK, DFF, G, bx);
        pg8::EpiRelu2 E{(bf16*)(ws + WS_BIG)};
        pg8::gemm_phase<pg8::EpiRelu2, pg8::StaticOrder, true, true>(lds, g, S, E); } SEAM(13);
    if (IN(14)) { pg8::Gemm g{(const bf16*)(ws + WS_BIG), (const bf16*)(ws + WS_W2) + (size_t)DM * DFF, MTOK, DM, DFF}; pg8::StaticOrder S; S.init(MTOK, DM, G, bx);
        pg8::EpiRes<true, false> E{XR, xo, mod1 + 5 * DM};
        pg8::gemm_phase<pg8::EpiRes<true, false>, pg8::StaticOrder, true, true>(lds, g, S, E); }
#undef IN
#undef SEAM
}

extern "C" void kernel_launch(void* const* d_in, const int* in_sizes, int n_in, void* d_out, int out_size, void* d_ws, size_t ws_size, hipStream_t stream) {
    static int grid = 0;
    if (grid == 0) {
        if (n_in != 21 || in_sizes[0] != MTOK * DM || out_size != MTOK * DM || ws_size < WS_END) {
            fprintf(stderr, "kernel_launch: unexpected shapes: n_in %d in0 %d out %d ws %zu (need >= %zu); nothing launched\n", n_in, n_in > 0 ? in_sizes[0] : -1, out_size, ws_size, (size_t)WS_END); grid = -1; return; }
        int dev = 0, cus = 0, per_cu = 0;
        if (hipGetDevice(&dev) != hipSuccess || hipDeviceGetAttribute(&cus, hipDeviceAttributeMultiprocessorCount, dev) != hipSuccess) { fprintf(stderr, "kernel_launch: device query failed\n"); grid = -1; return; }
        if (hipFuncSetAttribute((const void*)mk_fwd, hipFuncAttributeMaxDynamicSharedMemorySize, LDS_BYTES) != hipSuccess) { fprintf(stderr, "kernel_launch: hipFuncSetAttribute(%d B LDS) failed\n", LDS_BYTES); grid = -1; return; }
        if (hipOccupancyMaxActiveBlocksPerMultiprocessor(&per_cu, (const void*)mk_fwd, NTHREADS, LDS_BYTES) != hipSuccess || per_cu < 1)
            fprintf(stderr, "kernel_launch: note: occupancy query reports %d workgroups per CU\n", per_cu);
        (void)hipGetLastError();
        grid = cus;
    }
    if (grid < 0) return;
    if (hipMemsetAsync((char*)d_ws + WS_CTL, 0, CTL_ZERO_BYTES, stream) != hipSuccess) { fprintf(stderr, "kernel_launch: memset failed\n"); return; }
    Args a{};
    for (int i = 0; i < 21; ++i) a.in[i] = (const float*)d_in[i];
    a.out = (float*)d_out; a.ws = (unsigned char*)d_ws; a.dsa_mask = 7;
    for (int i = 0; i < 32; ++i) a.rinv.v[i] = powf(10000.0f, -(float)(2 * i) / 64.0f);
    for (int li = 0; li < N_LAUNCHES; ++li) {
        if (N_LAUNCHES == 1) { a.ph_lo = 0; a.ph_hi = N_PHASES; } else { a.ph_lo = li; a.ph_hi = li + 1; }
        const int reps = (N_LAUNCHES != 1 && li == PROBE_PH) ? PROBE_N : 1;
        for (int r = 0; r < reps; ++r) {
            a.dsa_mask = (r + 1 < reps) ? PROBE_MASK : 7;
            hipLaunchKernelGGL(mk_fwd, dim3(grid), dim3(NTHREADS), LDS_BYTES, stream, a);
            const hipError_t le = hipPeekAtLastError();
            if (le != hipSuccess) { fprintf(stderr, "kernel_launch: launch %d failed: %s\n", li, hipGetErrorName(le)); break; }
        }
    }
}
```

```cpp
#include <hip/hip_runtime.h>
#include <cstdio>
#include <cstdint>
#include <cmath>
#define MK_N_LAUNCHES 1
#define PROBE_PH -1
#define PROBE_N 1
#define PROBE_MASK 7
namespace pg8 {
#define PG8_LAS __attribute__((address_space(3)))
typedef unsigned short bf16_t;
typedef short bf16x8 __attribute__((ext_vector_type(8)));
typedef float f32x4 __attribute__((ext_vector_type(4)));
typedef unsigned u32x4 __attribute__((ext_vector_type(4)));
constexpr int BM = 256, BK = 64, HALF = 128, HTB = HALF * BK * 2  , STAGE_BYTES = 8 * HTB, NXCD = 8, WGM = 8;

__host__ __device__ __forceinline__ int lds_byte(int r, int c) { const int st = (r >> 4) * 2 + (c >> 5), rr = r & 15, cc = c & 31, ob = rr * 64 + cc * 2; return st * 1024 + (ob ^ (((ob >> 9) & 1) << 5)); }
__host__ __device__ __forceinline__ void stage_rc(int b, int& R, int& C) { const int st = b / 1024, sb = b % 1024, swz = sb ^ (((sb >> 9) & 1) << 5); R = (st >> 1) * 16 + swz / 64; C = (st & 1) * 32 + (swz % 64) / 2; }
__host__ __device__ __forceinline__ int perm32(int rho) { const int n = rho >> 4, i = rho & 15; return 8 * (i >> 2) + 4 * n + (i & 3); }

struct Unit { int pm, pn; };
struct Gemm { const bf16_t* A; const bf16_t* Bt; int M, N, K; int tiledA, tiledB; };

struct StaticOrder {
    int nM, nN, nwg, G, c;
    __host__ __device__ void init(int M, int N, int G_, int c_) { nM = M / BM; nN = N / BM; nwg = nM * nN; G = G_; c = c_; }
    __host__ __device__ bool next(int i, Unit& u) const {
        const long L = (long)i * G + c; if (L >= nwg) return false;
        int wgid = (int)L; { const int q = nwg / NXCD, r = nwg % NXCD, xcd = wgid % NXCD, off = wgid / NXCD; wgid = (xcd < r ? xcd * (q + 1) : r * (q + 1) + (xcd - r) * q) + off; }
        const int nig = WGM * nN, gid = wgid / nig, fm = gid * WGM, gsz = (nM - fm) < WGM ? (nM - fm) : WGM;
        u.pm = fm + ((wgid % nig) % gsz); u.pn = (wgid % nig) / gsz; return true;
    }
    __device__ __forceinline__ void a_ready(const Unit&) const {}
    __device__ __forceinline__ void done(const Unit&) const {}
};

__device__ __forceinline__ unsigned cvt_pk_bf16(float lo, float hi) { unsigned r; asm volatile("v_cvt_pk_bf16_f32 %0, %1, %2" : "=v"(r) : "v"(lo), "v"(hi)); return r; }
typedef float f32x2 __attribute__((ext_vector_type(2)));
template <class Epi, class Sched, bool ALIGN_EPI = false, bool SP2 = false>
__device__ __forceinline__ void gemm_phase(PG8_LAS unsigned char* lds, const Gemm g, const Sched& S, const Epi& E) {
    const int tid = threadIdx.x, wid = __builtin_amdgcn_readfirstlane(tid >> 6), lane = tid & 63, wr = wid >> 2, wc = wid & 3, fr = lane & 15, fq = lane >> 4;
    const int K = g.K, nt = K / BK;
    unsigned voffA[2], voffB[2];
#pragma unroll
    for (int i = 0; i < 2; ++i) { int R, C; stage_rc(tid * 16 + i * 8192, R, C); const int Rb = Epi::PERM ? ((R & ~31) + perm32(R & 31)) : R;
        voffA[i] = (unsigned)(R * (g.tiledA ? BK : K) + C) * 2u; voffB[i] = (unsigned)(Rb * (g.tiledB ? BK : K) + C) * 2u; }
    const size_t kstepA = g.tiledA ? (size_t)BM * BK * 2 : (size_t)(BK * 2), hstepA = g.tiledA ? (size_t)HALF * BK * 2 : (size_t)HALF * K * 2, tstepA = (size_t)BM * K * 2;
    const size_t kstepB = g.tiledB ? (size_t)BM * BK * 2 : (size_t)(BK * 2), hstepB = g.tiledB ? (size_t)HALF * BK * 2 : (size_t)HALF * K * 2, tstepB = (size_t)BM * K * 2;
    const unsigned ldsw = (unsigned)wid * 1024u;
    const int aoff = lds_byte(wr * 64 + fr, fq * 8), boff = lds_byte(wc * 32 + fr, fq * 8);
#define PG8_SA(b, h) (((b) * 2 + (h)) * HTB)
#define PG8_SB(b, h) ((4 + (b) * 2 + (h)) * HTB)
#define PG8_STAGE(bufoff, gbase, voff) do { _Pragma("unroll") for (int _i = 0; _i < 2; ++_i) \
        __builtin_amdgcn_global_load_lds((const unsigned*)((const char*)(gbase) + (voff)[_i]), (PG8_LAS unsigned*)(lds + (bufoff) + ldsw + _i * 8192), 16, 0, 0); } while (0)
#define PG8_LDA(dst, b, h) do { _Pragma("unroll") for (int m = 0; m < 4; ++m) _Pragma("unroll") for (int k = 0; k < 2; ++k) dst[m][k] = *(const PG8_LAS bf16x8*)(lds + PG8_SA(b, h) + aoff + m * 2048 + k * 1024); } while (0)
#define PG8_LDB(dst, b, h) do { _Pragma("unroll") for (int n = 0; n < 2; ++n) _Pragma("unroll") for (int k = 0; k < 2; ++k) dst[n][k] = *(const PG8_LAS bf16x8*)(lds + PG8_SB(b, h) + boff + n * 2048 + k * 1024); } while (0)
#define PG8_MMA(ai, bj, At, Bt) do { __builtin_amdgcn_s_setprio(1); _Pragma("unroll") for (int m = 0; m < 4; ++m) _Pragma("unroll") for (int n = 0; n < 2; ++n) _Pragma("unroll") for (int k = 0; k < 2; ++k) \
        acc[ai][bj][m][n] = __builtin_amdgcn_mfma_f32_16x16x32_bf16(Bt[n][k], At[m][k], acc[ai][bj][m][n], 0, 0, 0); __builtin_amdgcn_s_setprio(0); } while (0)
#define PG8_WAIT_V(n) asm volatile("s_waitcnt vmcnt(" #n ")" ::: "memory")
#define PG8_WAIT_L(n) asm volatile("s_waitcnt lgkmcnt(" #n ")" ::: "memory")
#define PG8_BAR __builtin_amdgcn_s_barrier()
#define PG8_SCHED __builtin_amdgcn_sched_barrier(0)
    Unit cur, nxt; int ui = 0;
    if (!S.next(0, cur)) return;
    f32x4 acc[2][2][4][2];
#pragma unroll
    for (int a = 0; a < 2; ++a)
#pragma unroll
        for (int b = 0; b < 2; ++b)
#pragma unroll
            for (int m = 0; m < 4; ++m)
#pragma unroll
                for (int n = 0; n < 2; ++n) acc[a][b][m][n] = (f32x4){0.f, 0.f, 0.f, 0.f};
    bf16x8 At[4][2], B0[2][2], B1[2][2];
    const char* cA = (const char*)g.A + (size_t)cur.pm * tstepA; const char* cB = (const char*)g.Bt + (size_t)cur.pn * tstepB;
    S.a_ready(cur);
    if constexpr (SP2) {
        PG8_STAGE(PG8_SB(0, 0), cB, voffB); PG8_STAGE(PG8_SB(0, 1), cB + hstepB, voffB); PG8_STAGE(PG8_SA(0, 0), cA, voffA); PG8_STAGE(PG8_SA(0, 1), cA + hstepA, voffA);
        if (wr == 1) PG8_BAR;
        PG8_WAIT_V(2); PG8_BAR;
        PG8_STAGE(PG8_SB(1, 0), cB + kstepB, voffB); PG8_STAGE(PG8_SA(1, 0), cA + kstepA, voffA); PG8_STAGE(PG8_SB(1, 1), cB + hstepB + kstepB, voffB);
        PG8_WAIT_V(6); PG8_BAR;
    } else {
        PG8_STAGE(PG8_SB(0, 0), cB, voffB); PG8_STAGE(PG8_SA(0, 0), cA, voffA); PG8_STAGE(PG8_SB(0, 1), cB + hstepB, voffB); PG8_STAGE(PG8_SA(0, 1), cA + hstepA, voffA);
        if (wr == 1) PG8_BAR;
        PG8_WAIT_V(4); PG8_BAR;
        PG8_STAGE(PG8_SB(1, 0), cB + kstepB, voffB); PG8_STAGE(PG8_SA(1, 0), cA + kstepA, voffA); PG8_STAGE(PG8_SB(1, 1), cB + hstepB + kstepB, voffB);
        PG8_WAIT_V(6); PG8_BAR;
    }
    for (;;) {
        const bool has_next = S.next(ui + 1, nxt);
        const char* nA = has_next ? (const char*)g.A + (size_t)nxt.pm * tstepA : cA; const char* nB = has_next ? (const char*)g.Bt + (size_t)nxt.pn * tstepB : cB;
        for (int t = 0; t < nt; t += 2) {
            const bool last = (t == nt - 2);
            const char* a1 = cA + (size_t)(t + 1) * kstepA;
            const char* a2 = last ? nA : cA + (size_t)(t + 2) * kstepA; const char* b2 = last ? nB : cB + (size_t)(t + 2) * kstepB;
            const char* a3 = a2 + kstepA; const char* b3 = b2 + kstepB;
            if (last && has_next) S.a_ready(nxt);
            if constexpr (SP2) {
            PG8_LDB(B0, 0, 0); PG8_LDB(B1, 0, 1); PG8_SCHED; PG8_LDA(At, 0, 0); PG8_STAGE(PG8_SA(1, 1), a1 + hstepA, voffA);
            PG8_WAIT_V(8); PG8_WAIT_L(0); PG8_BAR; PG8_MMA(0, 0, At, B0); PG8_MMA(0, 1, At, B1); PG8_BAR; PG8_SCHED;
            PG8_LDA(At, 0, 1); PG8_STAGE(PG8_SB(0, 0), b2, voffB); PG8_STAGE(PG8_SB(0, 1), b2 + hstepB, voffB); PG8_STAGE(PG8_SA(0, 0), a2, voffA);
            PG8_WAIT_V(8); PG8_WAIT_L(0); PG8_BAR; PG8_MMA(1, 0, At, B0); PG8_MMA(1, 1, At, B1); PG8_BAR; PG8_SCHED;
            PG8_LDB(B0, 1, 0); PG8_LDB(B1, 1, 1); PG8_SCHED; PG8_LDA(At, 1, 0); PG8_STAGE(PG8_SA(0, 1), a2 + hstepA, voffA);
            PG8_WAIT_V(8); PG8_WAIT_L(0); PG8_BAR; PG8_MMA(0, 0, At, B0); PG8_MMA(0, 1, At, B1); PG8_BAR; PG8_SCHED;
            PG8_LDA(At, 1, 1); PG8_STAGE(PG8_SB(1, 0), b3, voffB); PG8_STAGE(PG8_SB(1, 1), b3 + hstepB, voffB); PG8_STAGE(PG8_SA(1, 0), a3, voffA);
            PG8_WAIT_V(8); PG8_WAIT_L(0); PG8_BAR; PG8_MMA(1, 0, At, B0); PG8_MMA(1, 1, At, B1); PG8_BAR; PG8_SCHED;
            } else {
            PG8_LDB(B0, 0, 0); PG8_SCHED; PG8_LDA(At, 0, 0); PG8_STAGE(PG8_SA(1, 1), a1 + hstepA, voffA);
            PG8_WAIT_L(8); PG8_BAR; PG8_WAIT_L(0); PG8_MMA(0, 0, At, B0); PG8_BAR; PG8_SCHED;
            PG8_LDB(B1, 0, 1); PG8_STAGE(PG8_SB(0, 0), b2, voffB);
            PG8_BAR; PG8_WAIT_L(0); PG8_MMA(0, 1, At, B1); PG8_BAR;
            PG8_LDA(At, 0, 1); PG8_STAGE(PG8_SA(0, 0), a2, voffA);
            PG8_BAR; PG8_WAIT_L(0); PG8_MMA(1, 0, At, B0); PG8_BAR; PG8_SCHED;
            PG8_STAGE(PG8_SB(0, 1), b2 + hstepB, voffB);
            PG8_WAIT_V(6); PG8_BAR; PG8_MMA(1, 1, At, B1); PG8_BAR;
            PG8_LDB(B0, 1, 0); PG8_SCHED; PG8_LDA(At, 1, 0); PG8_STAGE(PG8_SA(0, 1), a2 + hstepA, voffA);
            PG8_WAIT_L(8); PG8_BAR; PG8_WAIT_L(0); PG8_MMA(0, 0, At, B0); PG8_BAR; PG8_SCHED;
            PG8_LDB(B1, 1, 1); PG8_STAGE(PG8_SB(1, 0), b3, voffB);
            PG8_BAR; PG8_WAIT_L(0); PG8_MMA(0, 1, At, B1); PG8_BAR;
            PG8_LDA(At, 1, 1); PG8_STAGE(PG8_SA(1, 0), a3, voffA);
            PG8_BAR; PG8_WAIT_L(0); PG8_MMA(1, 0, At, B0); PG8_BAR; PG8_SCHED;
            PG8_STAGE(PG8_SB(1, 1), b3 + hstepB, voffB);
            PG8_WAIT_V(6); PG8_BAR; PG8_MMA(1, 1, At, B1); PG8_BAR;
            }
        }
        if constexpr (ALIGN_EPI) { if (wr == 0) PG8_BAR; }
        if constexpr (!Epi::AFTER_DRAIN) { E(acc, cur, wr, wc, fr, fq); S.done(cur); }
        if (!has_next) break;
#pragma unroll
        for (int a = 0; a < 2; ++a)
#pragma unroll
            for (int b = 0; b < 2; ++b)
#pragma unroll
                for (int m = 0; m < 4; ++m)
#pragma unroll
                    for (int n = 0; n < 2; ++n) acc[a][b][m][n] = (f32x4){0.f, 0.f, 0.f, 0.f};
        cur = nxt; cA = nA; cB = nB; ++ui;
        if constexpr (ALIGN_EPI) { if (wr == 1) PG8_BAR; }
    }
    PG8_WAIT_V(0);
    if constexpr (!ALIGN_EPI) { if (wr == 0) PG8_BAR; }
    PG8_BAR;
    if constexpr (Epi::AFTER_DRAIN) { E.fused(acc, cur, wr, wc, fr, fq, lds, wid, lane); S.done(cur); }
#undef PG8_SA
#undef PG8_SB
#undef PG8_STAGE
#undef PG8_LDA
#undef PG8_LDB
#undef PG8_MMA
#undef PG8_WAIT_V
#undef PG8_WAIT_L
#undef PG8_BAR
#undef PG8_SCHED
}
}
#define GAS __attribute__((address_space(1)))
#define LAS __attribute__((address_space(3)))
typedef unsigned short bf16;
typedef unsigned v4u __attribute__((ext_vector_type(4)));
typedef float f32x4 __attribute__((ext_vector_type(4)));
typedef short bf16x8 __attribute__((ext_vector_type(8)));
typedef GAS unsigned gu32;
typedef GAS unsigned long long gu64;
#define RLX_AGENT __ATOMIC_RELAXED, __HIP_MEMORY_SCOPE_AGENT
#define LDS_WAIT() asm volatile("s_waitcnt lgkmcnt(0)" ::: "memory")
#define VM_WAIT() asm volatile("s_waitcnt vmcnt(0)" ::: "memory")
__device__ __forceinline__ unsigned long long rt() { return __builtin_amdgcn_s_memrealtime(); }
__device__ __forceinline__ unsigned f2bf(float f) { unsigned u = __builtin_bit_cast(unsigned, f); return (u + 0x7fffu + ((u >> 16) & 1u)) >> 16; }
__device__ __forceinline__ unsigned pk2(float lo, float hi) { return f2bf(lo) | (f2bf(hi) << 16); }

#define XB_TMO      128
#define XB_XCNT(j)  (256  + 64 * (j))
#define XB_XSUB(j)  (1280 + 64 * (j))
#define XB_XGEN(j)  (2304 + 64 * (j))
#define XB_TOP      3328
#define XB_TOPGEN   3392
#define XCD_BAR_WORDS 3456
#define XB_SPIN_CAP (1u << 18)

__device__ __forceinline__ unsigned xb_ld(unsigned* p)              { return __hip_atomic_load(p, __ATOMIC_RELAXED, __HIP_MEMORY_SCOPE_AGENT); }
__device__ __forceinline__ unsigned xb_add(unsigned* p, unsigned v) { return __hip_atomic_fetch_add(p, v, __ATOMIC_RELAXED, __HIP_MEMORY_SCOPE_AGENT); }
__device__ __forceinline__ unsigned xb_xcc_id() { return (unsigned)__builtin_amdgcn_s_getreg((3 << 11) | 20) & 0xFu; }
#define XB_SPIN(cond, bar) do { unsigned _sp = 0; while (cond) { __builtin_amdgcn_s_sleep(1); \
    if ((++_sp & 255u) == 0u) { if (xb_ld(&(bar)[XB_TMO])) break; if (_sp > XB_SPIN_CAP) { atomicAdd(&(bar)[XB_TMO], 1u); break; } } } } while (0)

struct XcdBarrier {
    unsigned* bar; unsigned x;
    volatile LAS unsigned* st;
};

__device__ __forceinline__ XcdBarrier xcd_barrier_post(unsigned* bar, volatile LAS unsigned* st) {
    XcdBarrier b; b.bar = bar; b.x = xb_xcc_id(); b.st = st;
    if (threadIdx.x == 0) (void)xb_add(&bar[XB_XCNT(b.x)], 1u);
    return b;
}
__device__ __forceinline__ void xcd_barrier_complete(unsigned* bar, unsigned x, unsigned& nloc, unsigned& nx) {
    const unsigned G = gridDim.x * gridDim.y * gridDim.z;
    unsigned sum, cnt, mine, sp = 0u;
    for (;;) {
        sum = 0u; cnt = 0u; mine = 0u;
#pragma unroll
        for (unsigned j = 0; j < 16; ++j) { const unsigned c = xb_ld(&bar[XB_XCNT(j)]); sum += c; cnt += (c > 0u) ? 1u : 0u; mine = (j == x) ? c : mine; }
        if (sum == G) break;
        __builtin_amdgcn_s_sleep(1);
        if ((++sp & 255u) == 0u) { if (xb_ld(&bar[XB_TMO])) break; if (sp > XB_SPIN_CAP) { atomicAdd(&bar[XB_TMO], 1u); break; } }
    }
    nloc = mine > 0u ? mine : 1u; nx = cnt > 0u ? cnt : 1u;
}

__device__ __forceinline__ void xcd_barrier(const XcdBarrier& b) {
    asm volatile("s_waitcnt vmcnt(0)" ::: "memory");
    __syncthreads();
    if (threadIdx.x == 0) {
        unsigned* bar = b.bar;
        __builtin_amdgcn_s_waitcnt(0);
        unsigned nloc = b.st[0], nx = b.st[1];
        if (nloc == 0u) { xcd_barrier_complete(bar, b.x, nloc, nx); b.st[0] = nloc; b.st[1] = nx; }
        const unsigned old = xb_add(&bar[XB_XSUB(b.x)], 1u);
        const unsigned gen = old / nloc;
        if (old + 1u == (gen + 1u) * nloc) {
            __builtin_amdgcn_fence(__ATOMIC_RELEASE, "agent");
            asm volatile("s_waitcnt vmcnt(0)" ::: "memory");
            const unsigned og = xb_add(&bar[XB_TOP], 1u);
            const unsigned tg = og / nx;
            if (og + 1u == (tg + 1u) * nx) xb_add(&bar[XB_TOPGEN], 1u);
            else XB_SPIN(xb_ld(&bar[XB_TOPGEN]) == tg, bar);
            __builtin_amdgcn_fence(__ATOMIC_ACQUIRE, "agent");
            xb_add(&bar[XB_XGEN(b.x)], 1u);
            asm volatile("s_waitcnt vmcnt(0)" ::: "memory");
        } else {
            XB_SPIN(xb_ld(&bar[XB_XGEN(b.x)]) == gen, bar);
            __builtin_amdgcn_fence(__ATOMIC_ACQUIRE, "agent");
            asm volatile("s_waitcnt vmcnt(0)" ::: "memory");
        }
    }
    __syncthreads();
}

constexpr int NB = 8, SEQ = 4096, DM = 1024, MTOK = NB * SEQ, DFF = 4096, DRNN = 1280, NLB = 5, LBLK = 256;
constexpr int NHEAD = 16, HD = 64, IH = 8, TOPK = 256, BIN = 1736, BINP = 1792, NMOD = 6 * DM;
constexpr float RMS_EPS = 1e-6f;
constexpr int NWAVES = 8, NTHREADS = 512;
constexpr int N_PHASES = 15;
constexpr int N_LAUNCHES = MK_N_LAUNCHES;

constexpr size_t MiB = 1u << 20;
constexpr size_t WS_CTL = 0, CTL_ZERO_BYTES = 64 * 1024;
constexpr int CW_BAR = 4096;
constexpr size_t WS_MOD = 1 * MiB;
constexpr size_t WS_ROPE = 2 * MiB;
constexpr size_t WS_WAIN = 4 * MiB;
constexpr size_t WS_WAOUT = 9 * MiB;
constexpr size_t WS_WGATE = 12 * MiB;
constexpr size_t WS_WBIN = 14 * MiB;
constexpr size_t WS_WBOUT = 18 * MiB;
constexpr size_t WS_W1 = 20 * MiB;
constexpr size_t WS_W2 = 36 * MiB;
constexpr size_t WS_H = 64 * MiB;
constexpr size_t WS_BIG = 128 * MiB;
constexpr size_t WS_XB = WS_BIG, WS_GATE = WS_BIG + 80 * MiB, WS_Y = WS_BIG + 160 * MiB;
constexpr size_t WS_Q = WS_BIG, WS_QI = WS_BIG + 64 * MiB, WS_KV = WS_BIG + 96 * MiB  , WS_KI = WS_BIG + 104 * MiB, WS_WI = WS_BIG + 108 * MiB, WS_AO = WS_BIG + 112 * MiB;
constexpr size_t WS_XR = 384 * MiB;
constexpr size_t WS_END = 448 * MiB;

constexpr int LDS_BYTES = 163840;
constexpr int MISC_OFF = LDS_BYTES - 256;

typedef float f32x2v __attribute__((ext_vector_type(2)));
typedef __bf16 bf16x2_t __attribute__((ext_vector_type(2)));
__device__ __forceinline__ unsigned cvtpk(float lo, float hi) { const f32x2v v = {lo, hi}; return __builtin_bit_cast(unsigned, __builtin_convertvector(v, bf16x2_t)); }
#define pk2 cvtpk
typedef unsigned u32x2v __attribute__((ext_vector_type(2)));
typedef short s16x4v __attribute__((ext_vector_type(4)));

__device__ __forceinline__ float wave_sum(float v) {
#pragma unroll
    for (int o = 1; o < 64; o <<= 1) v += __shfl_xor(v, o);
    return v;
}
__device__ __forceinline__ float bf2f(unsigned short h) { return __builtin_bit_cast(float, (unsigned)h << 16); }
__device__ __forceinline__ float bflo(unsigned w) { return __builtin_bit_cast(float, w << 16); }
__device__ __forceinline__ float bfhi(unsigned w) { return __builtin_bit_cast(float, w & 0xffff0000u); }
__device__ __forceinline__ float sigmoidf_(float x) { return __builtin_amdgcn_rcpf(1.f + __builtin_amdgcn_exp2f(-1.4426950408889634f * x)); }

namespace pg8 {
__device__ __forceinline__ f32x2 gelu_tanh2(f32x2 x) {
    f32x2 u = (x * ((x * x) * 0.044715f + 1.0f)) * -2.302208198f;
    u.x = __builtin_amdgcn_exp2f(u.x); u.y = __builtin_amdgcn_exp2f(u.y); u = u + 1.0f;
    f32x2 r; r.x = __builtin_amdgcn_rcpf(u.x); r.y = __builtin_amdgcn_rcpf(u.y); return x * r;
}
struct EpiXbGate {
    static constexpr bool PERM = true, AFTER_DRAIN = false;
    bf16_t* XB; bf16_t* GT;
    __device__ __forceinline__ void operator()(const f32x4 (&acc)[2][2][4][2], const Unit& u, int wr, int wc, int fr, int fq) const {
        const bool isg = u.pn >= 5; bf16_t* base = isg ? GT : XB;
        const int row0 = u.pm * BM + wr * 64 + fr, col0 = (isg ? u.pn - 5 : u.pn) * BM + wc * 32 + 8 * fq;
#pragma unroll
        for (int ai = 0; ai < 2; ++ai)
#pragma unroll
            for (int m = 0; m < 4; ++m) { bf16_t* rowp = base + (size_t)(row0 + ai * HALF + m * 16) * DRNN + col0;
#pragma unroll
                for (int bj = 0; bj < 2; ++bj) { const f32x4 v0 = acc[ai][bj][m][0], v1 = acc[ai][bj][m][1];
                    f32x2 p0 = (f32x2){v0[0], v0[1]}, p1 = (f32x2){v0[2], v0[3]}, p2 = (f32x2){v1[0], v1[1]}, p3 = (f32x2){v1[2], v1[3]};
                    if (isg) { p0 = gelu_tanh2(p0); p1 = gelu_tanh2(p1); p2 = gelu_tanh2(p2); p3 = gelu_tanh2(p3); }
                    u32x4 w; w.x = cvtpk(p0.x, p0.y); w.y = cvtpk(p1.x, p1.y); w.z = cvtpk(p2.x, p2.y); w.w = cvtpk(p3.x, p3.y);
                    *(u32x4*)(rowp + bj * HALF) = w; } }
    }
};
template <bool RB, bool OB> struct EpiRes {
    static constexpr bool PERM = OB, AFTER_DRAIN = false;
    const void* res; void* out; const float* gate;
    __device__ __forceinline__ void operator()(const f32x4 (&acc)[2][2][4][2], const Unit& u, int wr, int wc, int fr, int fq) const {
        const int row0 = u.pm * BM + wr * 64 + fr, b = u.pm >> 4;
        const int colb = u.pn * BM + wc * 32 + (PERM ? 8 * fq : 4 * fq), nst = PERM ? 4 : 16;
        f32x2 gv[2][2][2];
#pragma unroll
        for (int bj = 0; bj < 2; ++bj)
#pragma unroll
            for (int n = 0; n < 2; ++n) { const f32x4 t = *(const f32x4*)(gate + b * NMOD + colb + bj * HALF + n * nst); gv[bj][n][0] = (f32x2){t[0], t[1]}; gv[bj][n][1] = (f32x2){t[2], t[3]}; }
#pragma unroll
        for (int ai = 0; ai < 2; ++ai)
#pragma unroll
            for (int m = 0; m < 4; ++m) { const size_t off = (size_t)(row0 + ai * HALF + m * 16) * DM + colb;
                f32x2 rv[2][2][2];
#pragma unroll
                for (int bj = 0; bj < 2; ++bj) {
                    if (RB && PERM) { const u32x4 w = *(const u32x4*)((const bf16_t*)res + off + bj * HALF);
                        rv[bj][0][0] = (f32x2){__builtin_bit_cast(float, w.x << 16), __builtin_bit_cast(float, w.x & 0xffff0000u)}; rv[bj][0][1] = (f32x2){__builtin_bit_cast(float, w.y << 16), __builtin_bit_cast(float, w.y & 0xffff0000u)};
                        rv[bj][1][0] = (f32x2){__builtin_bit_cast(float, w.z << 16), __builtin_bit_cast(float, w.z & 0xffff0000u)}; rv[bj][1][1] = (f32x2){__builtin_bit_cast(float, w.w << 16), __builtin_bit_cast(float, w.w & 0xffff0000u)}; }
                    else {
#pragma unroll
                        for (int n = 0; n < 2; ++n) {
                            if (RB) { const unsigned long long w = *(const unsigned long long*)((const bf16_t*)res + off + bj * HALF + n * nst); const unsigned lo = (unsigned)w, hi = (unsigned)(w >> 32);
                                rv[bj][n][0] = (f32x2){__builtin_bit_cast(float, lo << 16), __builtin_bit_cast(float, lo & 0xffff0000u)}; rv[bj][n][1] = (f32x2){__builtin_bit_cast(float, hi << 16), __builtin_bit_cast(float, hi & 0xffff0000u)}; }
                            else { const f32x4 t = *(const f32x4*)((const float*)res + off + bj * HALF + n * nst); rv[bj][n][0] = (f32x2){t[0], t[1]}; rv[bj][n][1] = (f32x2){t[2], t[3]}; } } } }
#pragma unroll
                for (int bj = 0; bj < 2; ++bj) { f32x2 o[2][2];
#pragma unroll
                    for (int n = 0; n < 2; ++n) { const f32x4 a = acc[ai][bj][m][n]; o[n][0] = rv[bj][n][0] + gv[bj][n][0] * (f32x2){a[0], a[1]}; o[n][1] = rv[bj][n][1] + gv[bj][n][1] * (f32x2){a[2], a[3]}; }
                    if (OB) { u32x4 w; w.x = cvtpk(o[0][0].x, o[0][0].y); w.y = cvtpk(o[0][1].x, o[0][1].y); w.z = cvtpk(o[1][0].x, o[1][0].y); w.w = cvtpk(o[1][1].x, o[1][1].y);
                        *(u32x4*)((bf16_t*)out + off + bj * HALF) = w; }
                    else { *(f32x4*)((float*)out + off + bj * HALF) = (f32x4){o[0][0].x, o[0][0].y, o[0][1].x, o[0][1].y}; *(f32x4*)((float*)out + off + bj * HALF + nst) = (f32x4){o[1][0].x, o[1][0].y, o[1][1].x, o[1][1].y}; } }
                asm volatile("" ::: "memory"); }
    }
};
struct EpiRelu2 {
    static constexpr bool PERM = true, AFTER_DRAIN = false;
    bf16_t* O;
    __device__ __forceinline__ void operator()(const f32x4 (&acc)[2][2][4][2], const Unit& u, int wr, int wc, int fr, int fq) const {
        const int row0 = u.pm * BM + wr * 64 + fr, col0 = u.pn * BM + wc * 32 + 8 * fq;
#pragma unroll
        for (int ai = 0; ai < 2; ++ai)
#pragma unroll
            for (int m = 0; m < 4; ++m) {
                bf16_t* rowp = O + ((size_t)(u.pm * (DFF / 64) + u.pn * 4 + (wc >> 1)) * 256 + (wr * 64 + fr + ai * HALF + m * 16)) * 64 + (wc & 1) * 32 + 8 * fq;
#pragma unroll
                for (int bj = 0; bj < 2; ++bj) { const f32x4 v0 = acc[ai][bj][m][0], v1 = acc[ai][bj][m][1];
                    f32x2 p0 = (f32x2){__builtin_amdgcn_fmed3f(v0[0], 0.f, 3.0e38f), __builtin_amdgcn_fmed3f(v0[1], 0.f, 3.0e38f)}, p1 = (f32x2){__builtin_amdgcn_fmed3f(v0[2], 0.f, 3.0e38f), __builtin_amdgcn_fmed3f(v0[3], 0.f, 3.0e38f)};
                    f32x2 p2 = (f32x2){__builtin_amdgcn_fmed3f(v1[0], 0.f, 3.0e38f), __builtin_amdgcn_fmed3f(v1[1], 0.f, 3.0e38f)}, p3 = (f32x2){__builtin_amdgcn_fmed3f(v1[2], 0.f, 3.0e38f), __builtin_amdgcn_fmed3f(v1[3], 0.f, 3.0e38f)};
                    p0 = p0 * p0; p1 = p1 * p1; p2 = p2 * p2; p3 = p3 * p3;
                    u32x4 w; w.x = cvtpk(p0.x, p0.y); w.y = cvtpk(p1.x, p1.y); w.z = cvtpk(p2.x, p2.y); w.w = cvtpk(p3.x, p3.y);
                    *(u32x4*)(rowp + bj * 2 * 256 * 64) = w; } }
    }
};
struct EpiIn1 {
    static constexpr bool PERM = true, AFTER_DRAIN = false;
    bf16_t *Q, *QI, *K, *V, *KI; float* WI; const float* rope; const float *qg, *kg;
    __device__ __forceinline__ void operator()(const f32x4 (&acc)[2][2][4][2], const Unit& u, int wr, int wc, int fr, int fq) const {
        const int pn = u.pn;
        int kind;
        bf16_t* dst; int pitch, hoff;
        if (pn < 4) { kind = 0; dst = Q; pitch = DM; hoff = (4 * pn + wc) * 64; }
        else if (pn < 6) { kind = 1; dst = QI; pitch = 512; hoff = (4 * (pn - 4) + wc) * 64; }
        else if (wc == 0) { kind = 2; dst = K; pitch = 128; hoff = 0; }
        else if (wc == 1) { kind = 3; dst = KI; pitch = 64; hoff = 0; }
        else if (wc == 2) { kind = 4; dst = V; pitch = 128; hoff = 0; }
        else { kind = 5; dst = nullptr; pitch = 0; hoff = 0; }
        const bool donorm = (kind == 0 || kind == 2), dorope = (kind <= 3);
        const float osc = (kind == 0) ? 0.125f * 1.4426950408889634f : 1.f;
        f32x4 g1[2], g2[2];
#pragma unroll
        for (int n = 0; n < 2; ++n) { g1[n] = (f32x4){1.f, 1.f, 1.f, 1.f}; g2[n] = g1[n]; }
        if (kind == 0) {
#pragma unroll
            for (int n = 0; n < 2; ++n) { g1[n] = *(const f32x4*)(qg + 8 * fq + 4 * n); g2[n] = *(const f32x4*)(qg + 32 + 8 * fq + 4 * n); } }
        if (kind == 2) {
#pragma unroll
            for (int n = 0; n < 2; ++n) { g1[n] = *(const f32x4*)(kg + 8 * fq + 4 * n); g2[n] = *(const f32x4*)(kg + 32 + 8 * fq + 4 * n); } }
#pragma unroll
        for (int ai = 0; ai < 2; ++ai)
#pragma unroll
            for (int m = 0; m < 4; ++m) {
                const int row = u.pm * BM + ai * HALF + wr * 64 + m * 16 + fr, pos = row & (SEQ - 1);
                f32x4 x1[2], x2[2];
#pragma unroll
                for (int n = 0; n < 2; ++n) { x1[n] = acc[ai][0][m][n]; x2[n] = acc[ai][1][m][n]; }
                if (kind == 5) {
                    if (fq == 0) { *(f32x4*)(WI + (size_t)row * 8) = x1[0]; *(f32x4*)(WI + (size_t)row * 8 + 4) = x1[1]; }
                    continue;
                }
                if (donorm) {
                    float ss = 0.f;
#pragma unroll
                    for (int n = 0; n < 2; ++n)
#pragma unroll
                        for (int j = 0; j < 4; ++j) ss += x1[n][j] * x1[n][j] + x2[n][j] * x2[n][j];
                    ss += __shfl_xor(ss, 16); ss += __shfl_xor(ss, 32);
                    const float rs = 1.0f / sqrtf(ss * (1.f / 64.f) + RMS_EPS);
#pragma unroll
                    for (int n = 0; n < 2; ++n) { x1[n] = x1[n] * rs * g1[n]; x2[n] = x2[n] * rs * g2[n]; }
                }
                if (dorope) {
#pragma unroll
                    for (int n = 0; n < 2; ++n) { const f32x4 c = *(const f32x4*)(rope + pos * 32 + 8 * fq + 4 * n), s = *(const f32x4*)(rope + SEQ * 32 + pos * 32 + 8 * fq + 4 * n);
                        const f32x4 o1 = x1[n] * c - x2[n] * s, o2 = x2[n] * c + x1[n] * s; x1[n] = o1; x2[n] = o2; }
                }
#pragma unroll
                for (int n = 0; n < 2; ++n) { x1[n] = x1[n] * osc; x2[n] = x2[n] * osc; }
                bf16_t* rowp = (kind == 3) ? dst + (size_t)(row >> 4) * 1024 + fq * 128 + (row & 15) * 8 : dst + (size_t)row * pitch + hoff + 8 * fq;
                const int hi_off = (kind == 3) ? 512 : 32;
                u32x4 w; w.x = cvt_pk_bf16(x1[0][0], x1[0][1]); w.y = cvt_pk_bf16(x1[0][2], x1[0][3]); w.z = cvt_pk_bf16(x1[1][0], x1[1][1]); w.w = cvt_pk_bf16(x1[1][2], x1[1][3]);
                *(u32x4*)(rowp) = w;
                w.x = cvt_pk_bf16(x2[0][0], x2[0][1]); w.y = cvt_pk_bf16(x2[0][2], x2[0][3]); w.z = cvt_pk_bf16(x2[1][0], x2[1][1]); w.w = cvt_pk_bf16(x2[1][2], x2[1][3]);
                *(u32x4*)(rowp + hi_off) = w;
            }
    }
};
}

__device__ __forceinline__ int bin_row(int c) {
    if (c < 1024) { const int h = c >> 6, d = c & 63; return 256 * (h >> 2) + 128 * (d >> 5) + 32 * (h & 3) + (d & 31); }
    if (c < 1088) { const int d = c - 1024; return 1536 + 128 * (d >> 5) + (d & 31); }
    if (c < 1152) { const int d = c - 1088; return 1536 + 128 * (d >> 5) + 64 + (d & 31); }
    if (c < 1664) { const int cc = c - 1152, h = cc >> 6, d = cc & 63; return 256 * (4 + (h >> 2)) + 128 * (d >> 5) + 32 * (h & 3) + (d & 31); }
    if (c < 1728) { const int d = c - 1664; return 1536 + 128 * (d >> 5) + 32 + (d & 31); }
    return 1536 + 96 + (c - 1728);
}
template <int MODE>
__device__ __forceinline__ void tr_item(const float* W, int K, int N, bf16* WT, int item, LAS float* scr, int lane) {
    const int nblk = (N + 31) / 32, kb = item / nblk, nb = item % nblk, k0 = 64 * kb, n0 = 32 * nb;
    const int nn = n0 + (lane & 31); const bool nok = nn < N;
#pragma unroll 8
    for (int i = 0; i < 32; ++i) { const int kk = 2 * i + (lane >> 5); scr[kk * 33 + (lane & 31)] = nok ? W[(size_t)(k0 + kk) * N + nn] : 0.f; }
    LDS_WAIT(); asm volatile("" ::: "memory");
    const int c = lane & 7;
#pragma unroll
    for (int j = 0; j < 4; ++j) { const int n = (lane >> 3) + 8 * j, ncol = n0 + n; const LAS float* s = scr + (8 * c) * 33 + n;
        v4u o; o.x = pk2(s[0 * 33], s[1 * 33]); o.y = pk2(s[2 * 33], s[3 * 33]); o.z = pk2(s[4 * 33], s[5 * 33]); o.w = pk2(s[6 * 33], s[7 * 33]);
        if (ncol < N) {
            if (MODE == 3) *(GAS v4u*)(WT + ((size_t)((ncol >> 8) * (K / 64) + (k0 >> 6)) * 256 + (ncol & 255)) * 64 + 8 * c) = o;
            else { const int drow = (MODE == 0) ? ncol : bin_row(ncol); *(GAS v4u*)(WT + (size_t)drow * K + k0 + 8 * c) = o; } } }
    LDS_WAIT(); asm volatile("" ::: "memory");
}

struct RopeInv { float v[32]; };

template <int PART>
__device__ __forceinline__ void phase_prep(const float* const* in, unsigned char* ws, LAS unsigned char* lds, const RopeInv& rinv, int tid, int lane, int wave, int bx, int G) {
  constexpr bool LATE = PART == 2;
  if (PART == 0) {
    if (bx < 192) {
        LAS float* cond = (LAS float*)lds; LAS float* part = (LAS float*)(lds + 32768);
        const float* cin = in[1];
        for (int i = tid; i < NB * DM; i += NTHREADS) { const float v = cin[i]; cond[i] = v / (1.f + __expf(-v)); }
        __syncthreads();
        const int l = bx / 96, c0 = 64 * (bx % 96), cq = tid & 15, kg = tid >> 4;
        f32x4 a[NB];
#pragma unroll
        for (int b = 0; b < NB; ++b) a[b] = (f32x4){0.f, 0.f, 0.f, 0.f};
        const float* wp = in[4] + (size_t)l * DM * NMOD + c0 + 4 * cq;
#pragma unroll 4
        for (int kk = 0; kk < 32; ++kk) { const int k = kg * 32 + kk; const f32x4 w = *(const f32x4*)(wp + (size_t)k * NMOD);
#pragma unroll
            for (int b = 0; b < NB; ++b) { const float cv = cond[b * DM + k]; a[b] += w * cv; } }
#pragma unroll
        for (int b = 0; b < NB; ++b) *(LAS f32x4*)(part + (kg * NB + b) * 64 + 4 * cq) = a[b];
        __syncthreads();
        { const int b = tid >> 6, col = tid & 63; float s = 0.f;
#pragma unroll 8
          for (int k2 = 0; k2 < 32; ++k2) s += part[(k2 * NB + b) * 64 + col];
          ((float*)(ws + WS_MOD))[(size_t)(l * NB + b) * NMOD + c0 + col] = s + in[5][l * NMOD + c0 + col]; }
        __syncthreads();
    }
    return;
  }
  if (LATE) {
    { float* rope = (float*)(ws + WS_ROPE);
      for (int idx = bx * NTHREADS + tid; idx < SEQ * 32; idx += G * NTHREADS) { const int pos = idx >> 5, i = idx & 31;
          const float ang = (float)pos * rinv.v[i]; const double a = (double)ang; const double k = rint(a * 0.15915494309189535); const float x = (float)(a * 0.15915494309189535 - k);
          rope[idx] = __builtin_amdgcn_cosf(x); rope[SEQ * 32 + idx] = __builtin_amdgcn_sinf(x); } }
    { bf16* wb = (bf16*)(ws + WS_WBIN);
      for (int i = bx * NTHREADS + tid; i < 56 * 128; i += G * NTHREADS) { const int r = i >> 7, c8 = i & 127; const int row = r < 24 ? 1536 + 96 + 8 + r : 1536 + 128 + 96 + (r - 24);
          *(GAS v4u*)(wb + (size_t)row * DM + 8 * c8) = (v4u){0u, 0u, 0u, 0u}; } }
  }
    LAS float* scr = (LAS float*)(lds + wave * 16384);
    const int gw = bx * NWAVES + wave, NGW = G * NWAVES;
    constexpr int I_AIN = 16 * 80, I_AOUT = 20 * 32, I_G1 = 4 * 8, I_GATES = 10 * I_G1, I_BIN = 16 * 55, I_BOUT = 16 * 32, I_W1 = 16 * 128, I_W2 = 64 * 32;
    constexpr int NEARLY = I_AIN + I_GATES, NLATE = 2 * I_W1 + 2 * I_W2 + I_AOUT + I_BIN + I_BOUT;
    for (int it = gw; it < (LATE ? NLATE : NEARLY); it += NGW) {
        int r = it;
        if (!LATE) {
            if (r < I_AIN) { tr_item<0>(in[6], DM, 2 * DRNN, (bf16*)(ws + WS_WAIN), r, scr, lane); continue; } r -= I_AIN;
            { const int mi = r / I_G1, n = mi >> 1, gsel = mi & 1;
              tr_item<0>(in[gsel ? 11 : 9] + (size_t)n * LBLK * LBLK, LBLK, LBLK, (bf16*)(ws + WS_WGATE) + (size_t)(n * 2 + gsel) * LBLK * LBLK, r % I_G1, scr, lane); continue; }
        }
        if (r < I_W1 * 2) { const int l = r / I_W1; tr_item<0>(in[19] + (size_t)l * DM * DFF, DM, DFF, (bf16*)(ws + WS_W1) + (size_t)l * DFF * DM, r % I_W1, scr, lane); continue; } r -= 2 * I_W1;
        if (r < I_W2 * 2) { const int l = r / I_W2; tr_item<3>(in[20] + (size_t)l * DFF * DM, DFF, DM, (bf16*)(ws + WS_W2) + (size_t)l * DM * DFF, r % I_W2, scr, lane); continue; } r -= 2 * I_W2;
        if (r < I_AOUT) { tr_item<0>(in[14], DRNN, DM, (bf16*)(ws + WS_WAOUT), r, scr, lane); continue; } r -= I_AOUT;
        if (r < I_BIN) { tr_item<1>(in[15], DM, BIN, (bf16*)(ws + WS_WBIN), r, scr, lane); continue; } r -= I_BIN;
        tr_item<0>(in[18], DM, DM, (bf16*)(ws + WS_WBOUT), r, scr, lane);
    }
}

template <bool XB16>
__device__ __forceinline__ void phase_norm(const void* x, const float* g, const float* mod_sh, const float* mod_sc, bf16* H, int lane, int wave, int vcu, int G) {
    const int gw = vcu * NWAVES + wave, NGW = G * NWAVES;
    for (int r0 = gw * 16; r0 < MTOK; r0 += NGW * 16) {
        const int b = r0 >> 12;
        f32x4 al[4], be[4];
#pragma unroll
        for (int j = 0; j < 4; ++j) { const int c = XB16 ? 8 * lane + 512 * (j >> 1) + 4 * (j & 1) : 4 * lane + 256 * j;
            const f32x4 gg = *(const f32x4*)(g + c), sc = *(const f32x4*)(mod_sc + b * NMOD + c); al[j] = gg * (sc + 1.f); be[j] = *(const f32x4*)(mod_sh + b * NMOD + c); }
#pragma unroll 2
        for (int rr = 0; rr < 16; ++rr) {
            f32x4 v[4]; float s = 0.f;
            if (XB16) {
                const GAS v4u* xr = (const GAS v4u*)((const bf16*)x + (size_t)(r0 + rr) * DM) + lane;
#pragma unroll
                for (int j = 0; j < 2; ++j) { const v4u w = xr[64 * j];
                    v[2 * j] = (f32x4){bflo(w.x), bfhi(w.x), bflo(w.y), bfhi(w.y)}; v[2 * j + 1] = (f32x4){bflo(w.z), bfhi(w.z), bflo(w.w), bfhi(w.w)}; }
            } else {
                const GAS f32x4* xr = (const GAS f32x4*)((const float*)x + (size_t)(r0 + rr) * DM) + lane;
#pragma unroll
                for (int j = 0; j < 4; ++j) v[j] = xr[64 * j];
            }
#pragma unroll
            for (int j = 0; j < 4; ++j) s += (v[j].x * v[j].x + v[j].y * v[j].y) + (v[j].z * v[j].z + v[j].w * v[j].w);
            const float rstd = 1.0f / sqrtf(wave_sum(s) * (1.f / DM) + RMS_EPS);
            f32x4 y[4];
#pragma unroll
            for (int j = 0; j < 4; ++j) y[j] = v[j] * rstd * al[j] + be[j];
            if (XB16) {
                GAS v4u* o16 = (GAS v4u*)(H + (size_t)(r0 + rr) * DM) + lane;
#pragma unroll
                for (int j = 0; j < 2; ++j) { v4u o; o.x = pk2(y[2 * j].x, y[2 * j].y); o.y = pk2(y[2 * j].z, y[2 * j].w); o.z = pk2(y[2 * j + 1].x, y[2 * j + 1].y); o.w = pk2(y[2 * j + 1].z, y[2 * j + 1].w); o16[64 * j] = o; }
            } else {
                GAS unsigned long long* o8 = (GAS unsigned long long*)(H + (size_t)(r0 + rr) * DM) + lane;
#pragma unroll
                for (int j = 0; j < 4; ++j) o8[64 * j] = (unsigned long long)pk2(y[j].x, y[j].y) | ((unsigned long long)pk2(y[j].z, y[j].w) << 32);
            }
        }
    }
}

constexpr int RQ_CT = 128, RQ_AP = 528  , RQ_SP = 68  ;
constexpr int RQ_AT = 0, RQ_A = RQ_CT * RQ_AP, RQ_B = RQ_A + RQ_CT * RQ_SP * 4, RQ_SEG = RQ_B + RQ_CT * RQ_SP * 4, RQ_END = RQ_SEG + 16 * 32 * 16;
static_assert(RQ_END <= MISC_OFF, "rglru LDS map");
__device__ __forceinline__ f32x2v bf2x(unsigned w) { return (f32x2v){__builtin_bit_cast(float, w << 16), __builtin_bit_cast(float, w & 0xffff0000u)}; }
__device__ __forceinline__ void phase_rglru(const float* const* in, unsigned char* ws, LAS unsigned char* lds, int tid, int lane, int wave, int bx) {
    if (bx >= 160) return;
    const int b = bx & 7, n = (bx >> 3) >> 2, g = (bx >> 3) & 3;
    const bf16* XB = (const bf16*)(ws + WS_XB); const bf16* GT = (const bf16*)(ws + WS_GATE); bf16* Y = (bf16*)(ws + WS_Y);
    const int fr = lane & 15, fq = lane >> 4, wr = wave >> 2, wc = wave & 3;
    pg8::bf16x8 Br[8], Bi[8];
    { const bf16* wr_ = (const bf16*)(ws + WS_WGATE) + (size_t)(n * 2 + 0) * LBLK * LBLK + (size_t)(64 * g + 16 * wc + fr) * LBLK + 8 * fq;
      const bf16* wi_ = wr_ + (size_t)LBLK * LBLK;
#pragma unroll
      for (int kk = 0; kk < 8; ++kk) { Br[kk] = *(const pg8::bf16x8*)(wr_ + 32 * kk); Bi[kk] = *(const pg8::bf16x8*)(wi_ + 32 * kk); } }
    const int chl0 = 16 * wc + 4 * fq, chg0 = LBLK * n + 64 * g + chl0;
    f32x2v brv[2], biv[2], nsp[2];
    { const f32x4 x = *(const f32x4*)(in[10] + chg0), y = *(const f32x4*)(in[12] + chg0), lam = *(const f32x4*)(in[13] + chg0);
      brv[0] = (f32x2v){x[0], x[1]}; brv[1] = (f32x2v){x[2], x[3]}; biv[0] = (f32x2v){y[0], y[1]}; biv[1] = (f32x2v){y[2], y[3]};
      float t[4];
#pragma unroll
      for (int j = 0; j < 4; ++j) t[j] = -8.f * 1.4426950408889634f * log1pf(__expf(-lam[j]));
      nsp[0] = (f32x2v){t[0], t[1]}; nsp[1] = (f32x2v){t[2], t[3]}; }
    const int cq = lane;
    const int cch = LBLK * n + 4 * cq;
    f32x2v cw[4][2], cb[2];
#pragma unroll
    for (int j = 0; j < 4; ++j) { const f32x4 w0 = *(const f32x4*)(in[7] + j * DRNN + cch); cw[j][0] = (f32x2v){w0[0], w0[1]}; cw[j][1] = (f32x2v){w0[2], w0[3]}; }
    { const f32x4 b0 = *(const f32x4*)(in[8] + cch); cb[0] = (f32x2v){b0[0], b0[1]}; cb[1] = (f32x2v){b0[2], b0[3]}; }
    const int cp = tid & 31, sg = tid >> 5;
    f32x2v hin = (f32x2v){0.f, 0.f};
    const size_t tok0 = (size_t)b * SEQ;
    u32x2v xr[19];
#define RQ_LOADX(t0_) do { _Pragma("unroll") for (int i_ = 0; i_ < 19; ++i_) { const int t_ = (t0_) + 16 * wave - 3 + i_; \
        xr[i_] = (t_ >= 0) ? *(const GAS u32x2v*)(XB + (tok0 + t_) * DRNN + cch) : (u32x2v){0u, 0u}; } } while (0)
    RQ_LOADX(0);
    for (int c = 0; c < SEQ / RQ_CT; ++c) {
        const int t0 = c * RQ_CT;
        { f32x2v xf[19][2];
#pragma unroll
          for (int i = 0; i < 19; ++i) { xf[i][0] = bf2x(xr[i].x); xf[i][1] = bf2x(xr[i].y); }
#pragma unroll
          for (int tt = 0; tt < 16; ++tt) { f32x2v o0 = cb[0], o1 = cb[1];
#pragma unroll
              for (int j = 0; j < 4; ++j) { o0 += cw[j][0] * xf[tt + j][0]; o1 += cw[j][1] * xf[tt + j][1]; }
              u32x2v pk; pk.x = pk2(o0.x, o0.y); pk.y = pk2(o1.x, o1.y);
              *(LAS u32x2v*)(lds + RQ_AT + (16 * wave + tt) * RQ_AP + 8 * cq) = pk; } }
        if (c + 1 < SEQ / RQ_CT) RQ_LOADX(t0 + RQ_CT);
        unsigned gt[8];
        { const bf16* gp = GT + (tok0 + t0 + 8 * sg) * DRNN + LBLK * n + 64 * g + 2 * cp;
#pragma unroll
          for (int t = 0; t < 8; ++t) gt[t] = *(const GAS unsigned*)(gp + (size_t)t * DRNN); }
        __syncthreads();
        f32x4 ar[4], ai_[4];
#pragma unroll
        for (int m = 0; m < 4; ++m) { ar[m] = (f32x4){0.f, 0.f, 0.f, 0.f}; ai_[m] = ar[m]; }
#pragma unroll
        for (int kk = 0; kk < 8; ++kk)
#pragma unroll
            for (int m = 0; m < 4; ++m) { const pg8::bf16x8 xf = *(const LAS pg8::bf16x8*)(lds + RQ_AT + (64 * wr + 16 * m + fr) * RQ_AP + (32 * kk + 8 * fq) * 2);
                ar[m] = __builtin_amdgcn_mfma_f32_16x16x32_bf16(Br[kk], xf, ar[m], 0, 0, 0); ai_[m] = __builtin_amdgcn_mfma_f32_16x16x32_bf16(Bi[kk], xf, ai_[m], 0, 0, 0); }
#pragma unroll
        for (int m = 0; m < 4; ++m) { const int tk = 64 * wr + 16 * m + fr;
            const u32x2v xw = *(const LAS u32x2v*)(lds + RQ_AT + tk * RQ_AP + (64 * g + chl0) * 2);
            f32x4 av, bv;
#pragma unroll
            for (int h = 0; h < 2; ++h) { const f32x2v xc = bf2x(h ? xw.y : xw.x);
                f32x2v tr_ = ((f32x2v){ar[m][2 * h], ar[m][2 * h + 1]} + brv[h]) * -1.4426950408889634f, ti_ = ((f32x2v){ai_[m][2 * h], ai_[m][2 * h + 1]} + biv[h]) * -1.4426950408889634f;
                tr_.x = __builtin_amdgcn_exp2f(tr_.x); tr_.y = __builtin_amdgcn_exp2f(tr_.y); ti_.x = __builtin_amdgcn_exp2f(ti_.x); ti_.y = __builtin_amdgcn_exp2f(ti_.y);
                tr_ = tr_ + 1.0f; ti_ = ti_ + 1.0f;
                f32x2v rr, ii; rr.x = __builtin_amdgcn_rcpf(tr_.x); rr.y = __builtin_amdgcn_rcpf(tr_.y); ii.x = __builtin_amdgcn_rcpf(ti_.x); ii.y = __builtin_amdgcn_rcpf(ti_.y);
                f32x2v la = rr * nsp[h], a; a.x = __builtin_amdgcn_exp2f(la.x); a.y = __builtin_amdgcn_exp2f(la.y);
                f32x2v q = 1.0f - a * a, s; s.x = __builtin_amdgcn_sqrtf(__builtin_fabsf(q.x)); s.y = __builtin_amdgcn_sqrtf(__builtin_fabsf(q.y));
                const f32x2v bb = s * (ii * xc);
                av[2 * h] = a.x; av[2 * h + 1] = a.y; bv[2 * h] = bb.x; bv[2 * h + 1] = bb.y; }
            *(LAS f32x4*)(lds + RQ_A + (tk * RQ_SP + chl0) * 4) = av; *(LAS f32x4*)(lds + RQ_B + (tk * RQ_SP + chl0) * 4) = bv; }
        __syncthreads();
        f32x2v sa[8], sb[8];
#pragma unroll
        for (int t = 0; t < 8; ++t) { sa[t] = *(const LAS f32x2v*)(lds + RQ_A + ((8 * sg + t) * RQ_SP + 2 * cp) * 4); sb[t] = *(const LAS f32x2v*)(lds + RQ_B + ((8 * sg + t) * RQ_SP + 2 * cp) * 4); }
        { f32x2v A = sa[0], H = sb[0];
#pragma unroll
          for (int t = 1; t < 8; ++t) { A = A * sa[t]; H = sa[t] * H + sb[t]; }
          *(LAS f32x4*)(lds + RQ_SEG + (sg * 32 + cp) * 16) = (f32x4){A.x, A.y, H.x, H.y}; }
        __syncthreads();
        { f32x2v h = hin, mine = hin;
#pragma unroll
          for (int s = 0; s < 16; ++s) { const f32x4 sh = *(const LAS f32x4*)(lds + RQ_SEG + (s * 32 + cp) * 16); if (s == sg) mine = h; h = (f32x2v){sh[0], sh[1]} * h + (f32x2v){sh[2], sh[3]}; }
          hin = h;
          f32x2v hh = mine; bf16* yp = Y + (tok0 + t0 + 8 * sg) * DRNN + LBLK * n + 64 * g + 2 * cp;
#pragma unroll
          for (int t = 0; t < 8; ++t) { hh = sa[t] * hh + sb[t]; const f32x2v yv = hh * bf2x(gt[t]); *(GAS unsigned*)(yp + (size_t)t * DRNN) = pk2(yv.x, yv.y); } }
    }
#undef RQ_LOADX
}

constexpr int DS_SCP = 8224;
constexpr int DS_H1 = 8 * DS_SCP, DS_H2 = DS_H1 + 8 * 4096, DS_BNC = 0, DS_IDX = 8 * 16384, DS_DMY = DS_IDX + 8 * 1024, DS_END = DS_DMY + 8 * 256;
static_assert(DS_END <= MISC_OFF && DS_H2 + 8 * 2048 <= DS_IDX, "dsa LDS map");

__device__ __forceinline__ unsigned mbcnt64(unsigned long long m) { return __builtin_amdgcn_mbcnt_hi((unsigned)(m >> 32), __builtin_amdgcn_mbcnt_lo((unsigned)m, 0u)); }
__device__ __forceinline__ void wave_prefix4(unsigned x, unsigned& pre, unsigned& tot) {
    pre = 0u; tot = 0u;
#pragma unroll
    for (int bit = 0; bit < 4; ++bit) { const unsigned long long m = __ballot((x >> bit) & 1u); pre += mbcnt64(m) << bit; tot += (unsigned)__popcll(m) << bit; }
}
__device__ __forceinline__ unsigned row_scan_u32(unsigned v) {
    v += (unsigned)__builtin_amdgcn_update_dpp(0, (int)v, 0x111, 0xf, 0xf, true);
    v += (unsigned)__builtin_amdgcn_update_dpp(0, (int)v, 0x112, 0xf, 0xf, true);
    v += (unsigned)__builtin_amdgcn_update_dpp(0, (int)v, 0x114, 0xf, 0xf, true);
    v += (unsigned)__builtin_amdgcn_update_dpp(0, (int)v, 0x118, 0xf, 0xf, true);
    return v;
}
__device__ __forceinline__ void hist_find4(v4u c4, unsigned need, int lane, unsigned& B, unsigned& above, unsigned& atb) {
    const unsigned s = c4.x + c4.y + c4.z + c4.w;
    const unsigned inc = row_scan_u32(s);
    const unsigned t0 = (unsigned)__builtin_amdgcn_readlane((int)inc, 15), t1 = (unsigned)__builtin_amdgcn_readlane((int)inc, 31), t2 = (unsigned)__builtin_amdgcn_readlane((int)inc, 47), t3 = (unsigned)__builtin_amdgcn_readlane((int)inc, 63);
    const int row = lane >> 4;
    const unsigned before = (row > 0 ? t0 : 0u) + (row > 1 ? t1 : 0u) + (row > 2 ? t2 : 0u) + (inc - s);
    const unsigned total = (t0 + t1) + (t2 + t3);
    const unsigned S = total - before;
    const unsigned long long mk = __ballot(S >= need);
    const int L = 63 - __builtin_clzll(mk | 1ull);
    unsigned cum = S - s, bin, ab, at;
    if (cum + c4.w >= need) { bin = 4 * lane + 3; ab = cum; at = c4.w; }
    else { cum += c4.w; if (cum + c4.z >= need) { bin = 4 * lane + 2; ab = cum; at = c4.z; }
        else { cum += c4.z; if (cum + c4.y >= need) { bin = 4 * lane + 1; ab = cum; at = c4.y; } else { cum += c4.y; bin = 4 * lane; ab = cum; at = c4.x; } } }
    B = __builtin_amdgcn_readlane(bin, L); above = __builtin_amdgcn_readlane(ab, L); atb = __builtin_amdgcn_readlane(at, L);
}
__device__ __forceinline__ void pk_count4(unsigned& a0, unsigned& a1, unsigned& a2, unsigned& a3, unsigned k0, unsigned k1, unsigned k2, unsigned k3, unsigned cm) {
    unsigned t0, t1, t2, t3;
    asm("v_pk_sub_u16 %4, %8, %12 clamp\n\tv_pk_sub_u16 %5, %9, %12 clamp\n\tv_pk_sub_u16 %6, %10, %12 clamp\n\tv_pk_sub_u16 %7, %11, %12 clamp\n\t"
        "v_pk_min_u16 %4, %4, 1 op_sel_hi:[1,0]\n\tv_pk_min_u16 %5, %5, 1 op_sel_hi:[1,0]\n\tv_pk_min_u16 %6, %6, 1 op_sel_hi:[1,0]\n\tv_pk_min_u16 %7, %7, 1 op_sel_hi:[1,0]\n\t"
        "v_pk_add_u16 %0, %0, %4\n\tv_pk_add_u16 %1, %1, %5\n\tv_pk_add_u16 %2, %2, %6\n\tv_pk_add_u16 %3, %3, %7"
        : "+v"(a0), "+v"(a1), "+v"(a2), "+v"(a3), "=&v"(t0), "=&v"(t1), "=&v"(t2), "=&v"(t3) : "v"(k0), "v"(k1), "v"(k2), "v"(k3), "v"(cm));
}
__device__ __forceinline__ unsigned pk_bin2(unsigned w, unsigned b1p) {
    unsigned t, g;
    asm("v_pk_sub_u16 %0, %2, %3\n\tv_and_or_b32 %1, %0, %4, %5\n\tv_pk_min_u16 %0, %0, %1" : "=&v"(t), "=&v"(g) : "v"(w), "v"(b1p), "v"(0x00ff00ffu), "v"(0x01000100u));
    return t;
}
typedef _Float16 h16x2 __attribute__((ext_vector_type(2)));
__device__ __forceinline__ h16x2 pkrtz(float a, float b) { return __builtin_bit_cast(h16x2, __builtin_amdgcn_cvt_pkrtz(a, b)); }
__device__ __forceinline__ unsigned score_key(float s) {
    const int h = (int)(short)__builtin_bit_cast(unsigned short, (_Float16)s);
    return ((unsigned)h ^ ((unsigned)(h >> 15) | 0x8000u)) & 0xffffu;
}

__device__ __forceinline__ void phase_dsa(unsigned char* ws, LAS unsigned char* lds, int tid, int lane, int wave, int bx, int G, int mask) {
    const bf16* Qb = (const bf16*)(ws + WS_Q); const bf16* QIb = (const bf16*)(ws + WS_QI); const bf16* KVb = (const bf16*)(ws + WS_KV);
    const bf16* KIb = (const bf16*)(ws + WS_KI); const float* WIb = (const float*)(ws + WS_WI); bf16* AO = (bf16*)(ws + WS_AO);
    const int lane0 = lane;
    const int b = bx & 7, jj = bx >> 3, nj = G >> 3;
    const size_t tokb = (size_t)b * SEQ;
    for (int i = 0; ; ++i) {
        const int qb = ((i & 1) ? (nj - 1 - jj) : jj) + nj * i;
        if (qb >= SEQ / 8) break;
        const int p0 = 8 * qb, nk16 = (p0 + 8 + 15) & ~15, NT = nk16 >> 4;
        if (mask & 1) {
            int lane = lane0; asm volatile("" : "+v"(lane));
            const int fr = lane & 15, fq = lane >> 4;
            pg8::bf16x8 QA[2][2][2];
#pragma unroll
            for (int grp = 0; grp < 2; ++grp)
#pragma unroll
                for (int hf = 0; hf < 2; ++hf)
#pragma unroll
                    for (int ks = 0; ks < 2; ++ks)
                        QA[grp][hf][ks] = *(const pg8::bf16x8*)(QIb + (tokb + p0 + 4 * grp + (fr >> 2)) * 512 + (4 * hf + (fr & 3)) * 64 + 32 * ks + 8 * fq);
            h16x2 wq[2][4];
#pragma unroll
            for (int grp = 0; grp < 2; ++grp) { const f32x4 w0 = *(const f32x4*)(WIb + (tokb + p0 + 4 * grp + fq) * 8), w1 = *(const f32x4*)(WIb + (tokb + p0 + 4 * grp + fq) * 8 + 4);
                wq[grp][0] = pkrtz(w0[0], w0[1]); wq[grp][1] = pkrtz(w0[2], w0[3]); wq[grp][2] = pkrtz(w1[0], w1[1]); wq[grp][3] = pkrtz(w1[2], w1[3]); }
            const int ntw = NT > wave ? (NT - wave + 7) >> 3 : 0, ng = (ntw + 3) >> 2;
            const char* kibase = (const char*)(KIb + tokb * 64);
            const unsigned koff = (unsigned)lane * 16u;
            const h16x2 hz = {(_Float16)0.f, (_Float16)0.f};
            pg8::bf16x8 ka[4][2], kb[4][2];
#define DS_A_LOAD(buf, g) do { _Pragma("unroll") for (int u_ = 0; u_ < 4; ++u_) { int kt_ = wave + 8 * (4 * (g) + u_); kt_ = kt_ < NT ? kt_ : NT - 1; const unsigned o_ = koff + (unsigned)kt_ * 2048u; \
                buf[u_][0] = *(const pg8::bf16x8*)(kibase + o_); buf[u_][1] = *(const pg8::bf16x8*)(kibase + o_ + 1024u); } } while (0)
#define DS_A_COMP(buf, g) do { f32x4 d_[4][2][2]; \
                _Pragma("unroll") for (int u_ = 0; u_ < 4; ++u_) _Pragma("unroll") for (int grp = 0; grp < 2; ++grp) _Pragma("unroll") for (int hf = 0; hf < 2; ++hf) { \
                    f32x4 z_ = (f32x4){0.f, 0.f, 0.f, 0.f}; z_ = __builtin_amdgcn_mfma_f32_16x16x32_bf16(QA[grp][hf][0], buf[u_][0], z_, 0, 0, 0); d_[u_][grp][hf] = __builtin_amdgcn_mfma_f32_16x16x32_bf16(QA[grp][hf][1], buf[u_][1], z_, 0, 0, 0); } \
                _Pragma("unroll") for (int u_ = 0; u_ < 4; ++u_) { const int kt_ = wave + 8 * (4 * (g) + u_); const int key_ = 16 * kt_ + fr; \
                    _Pragma("unroll") for (int grp = 0; grp < 2; ++grp) { float s_ = 0.f; \
                        _Pragma("unroll") for (int hf = 0; hf < 2; ++hf) { \
                            s_ = __builtin_amdgcn_fdot2(__builtin_elementwise_max(pkrtz(d_[u_][grp][hf][0], d_[u_][grp][hf][1]), hz), wq[grp][2 * hf], s_, false); \
                            s_ = __builtin_amdgcn_fdot2(__builtin_elementwise_max(pkrtz(d_[u_][grp][hf][2], d_[u_][grp][hf][3]), hz), wq[grp][2 * hf + 1], s_, false); } \
                        const int q_ = 4 * grp + fq; const unsigned kk_ = (key_ <= p0 + q_) ? score_key(s_) : 0u; \
                        if (kt_ < NT) *(LAS unsigned short*)(lds + q_ * DS_SCP + key_ * 2) = (unsigned short)kk_; } } } while (0)
            DS_A_LOAD(ka, 0);
            DS_A_LOAD(kb, 1);
            for (int g = 0; g < ng; g += 2) {
                DS_A_COMP(ka, g);
                DS_A_LOAD(ka, g + 2);
                if (g + 1 < ng) DS_A_COMP(kb, g + 1);
                DS_A_LOAD(kb, g + 3);
            }
#undef DS_A_LOAD
#undef DS_A_COMP
        }
        LDS_WAIT();
        __syncthreads();
        const int p = p0 + wave, nvalid = p + 1;
        LAS unsigned* idx = (LAS unsigned*)(lds + DS_IDX + wave * 1024);
        int nsel = 1;
        if (!(mask & 2)) { }
        else if (nvalid <= TOPK) {
#pragma unroll
            for (int r = 0; r < 4; ++r) { const int s = lane0 + 64 * r; idx[s] = (unsigned)(s < nvalid ? s : 0) << 8; }
            nsel = nvalid;
        } else {
            int lane = lane0; asm volatile("" : "+v"(lane));
            const LAS unsigned char* row = lds + wave * DS_SCP;
            const int nit = (nk16 + 511) >> 9;
            unsigned kp[8][4];
#pragma unroll
            for (int it = 0; it < 8; ++it) { v4u v = (v4u){0u, 0u, 0u, 0u};
                if (it < nit) { const int e0 = it * 512 + lane * 8; if (e0 < nk16) v = *(const LAS v4u*)(row + e0 * 2); }
#pragma unroll
                for (int x = 0; x < 4; ++x) kp[it][x] = v[x]; }
            const unsigned h1w = DS_H1 + wave * 4096, h2w = DS_H2 + wave * 2048;
#pragma unroll
            for (int r = 0; r < 4; ++r) *(LAS v4u*)(lds + h1w + r * 1024 + lane * 16) = (v4u){0u, 0u, 0u, 0u};
#pragma unroll
            for (int r = 0; r < 2; ++r) *(LAS v4u*)(lds + h2w + r * 1024 + lane * 16) = (v4u){0u, 0u, 0u, 0u};
            LDS_WAIT();
            const unsigned h1l = h1w + (unsigned)(lane & 3) * 1024u;
#pragma unroll
            for (int it = 0; it < 8; ++it) if (it < nit) {
#pragma unroll
                for (int x = 0; x < 4; ++x) { const unsigned w = kp[it][x];
                    __hip_atomic_fetch_add((LAS unsigned*)(lds + h1l + ((w >> 6) & 0x3fcu)), 1u, __ATOMIC_RELAXED, __HIP_MEMORY_SCOPE_WORKGROUP);
                    __hip_atomic_fetch_add((LAS unsigned*)(lds + h1l + ((w >> 22) & 0x3fcu)), 1u, __ATOMIC_RELAXED, __HIP_MEMORY_SCOPE_WORKGROUP); } }
            LDS_WAIT();
            unsigned B1, above1, at1;
            { const v4u c0 = *(const LAS v4u*)(lds + h1w + lane * 16), c1 = *(const LAS v4u*)(lds + h1w + 1024 + lane * 16), c2 = *(const LAS v4u*)(lds + h1w + 2048 + lane * 16), c3 = *(const LAS v4u*)(lds + h1w + 3072 + lane * 16);
              hist_find4((c0 + c1) + (c2 + c3), (unsigned)TOPK, lane, B1, above1, at1); }
            const unsigned need1 = (unsigned)TOPK - above1;
            const unsigned b1p = B1 * 0x01000100u;
#pragma unroll
            for (int it = 0; it < 8; ++it) if (it < nit) {
#pragma unroll
                for (int x = 0; x < 4; ++x) { const unsigned m = pk_bin2(kp[it][x], b1p);
                    __hip_atomic_fetch_add((LAS unsigned*)(lds + h2w + ((m & 0xffffu) << 2)), 1u, __ATOMIC_RELAXED, __HIP_MEMORY_SCOPE_WORKGROUP);
                    __hip_atomic_fetch_add((LAS unsigned*)(lds + h2w + ((m >> 16) << 2)), 1u, __ATOMIC_RELAXED, __HIP_MEMORY_SCOPE_WORKGROUP); } }
            LDS_WAIT();
            unsigned B2, above2, at2;
            hist_find4(*(const LAS v4u*)(lds + h2w + lane * 16), need1, lane, B2, above2, at2);
            const unsigned T = (B1 << 8) | B2, need_eq = need1 - above2;
            if (need_eq == at2) {
                unsigned a0 = 0u, a1 = 0u, a2 = 0u, a3 = 0u; const unsigned cm = (T - 1u) * 0x10001u;
#pragma unroll
                for (int it = 0; it < 8; ++it) if (it < nit) pk_count4(a0, a1, a2, a3, kp[it][0], kp[it][1], kp[it][2], kp[it][3], cm);
                const unsigned a_ = (a0 + a1) + (a2 + a3), cl = (a_ & 0xffffu) + (a_ >> 16);
                const unsigned inc = row_scan_u32(cl);
                const unsigned t0 = (unsigned)__builtin_amdgcn_readlane((int)inc, 15), t1 = (unsigned)__builtin_amdgcn_readlane((int)inc, 31), t2 = (unsigned)__builtin_amdgcn_readlane((int)inc, 47);
                const int rw = lane >> 4;
                unsigned pa = DS_IDX + wave * 1024 + 4u * ((rw > 0 ? t0 : 0u) + (rw > 1 ? t1 : 0u) + (rw > 2 ? t2 : 0u) + (inc - cl));
                const unsigned eb = (unsigned)lane * 2048u;
#pragma unroll
                for (int it = 0; it < 8; ++it) if (it < nit) {
#pragma unroll
                    for (int k = 0; k < 8; ++k) { const unsigned kk_ = (k & 1) ? (kp[it][k >> 1] >> 16) : (kp[it][k >> 1] & 0xffffu);
                        if (kk_ >= T) { *(LAS unsigned*)(lds + pa) = eb + (unsigned)((it * 512 + k) << 8); pa += 4u; } } }
            } else {
                unsigned cnt = 0u, eqc = 0u;
#pragma unroll
                for (int it = 0; it < 8; ++it) if (it < nit) {
                    unsigned gtm = 0u, eqm = 0u;
#pragma unroll
                    for (int k = 0; k < 8; ++k) { const unsigned kk_ = (k & 1) ? (kp[it][k >> 1] >> 16) : (kp[it][k >> 1] & 0xffffu); gtm |= (kk_ > T) ? (1u << k) : 0u; eqm |= (kk_ == T) ? (1u << k) : 0u; }
                    unsigned selm = gtm;
                    if (__ballot(eqm != 0u)) { unsigned pre, tot; wave_prefix4((unsigned)__popc(eqm), pre, tot); unsigned run = eqc + pre;
#pragma unroll
                        for (int k = 0; k < 8; ++k) if ((eqm >> k) & 1u) { if (run < need_eq) selm |= (1u << k); ++run; }
                        eqc += tot; }
                    if (__ballot(selm != 0u)) { unsigned pre, tot; wave_prefix4((unsigned)__popc(selm), pre, tot); unsigned pos = cnt + pre; const int e0 = it * 512 + lane * 8;
#pragma unroll
                        for (int k = 0; k < 8; ++k) if ((selm >> k) & 1u) { idx[pos & 255u] = (unsigned)(e0 + k) << 8; ++pos; }
                        cnt += tot; }
                }
            }
            nsel = TOPK;
        }
        LDS_WAIT();
        __syncthreads();
        if (mask & 4) {
            int lane = lane0; asm volatile("" : "+v"(lane));
            const int fr = lane & 15, fq = lane >> 4;
            const unsigned kbn = DS_BNC + wave * 16384, vbn = kbn + 8192;
            const pg8::bf16x8 q0 = *(const pg8::bf16x8*)(Qb + (tokb + p) * DM + fr * 64 + 8 * fq), q1 = *(const pg8::bf16x8*)(Qb + (tokb + p) * DM + fr * 64 + 32 + 8 * fq);
            const char* kvbase = (const char*)(KVb + tokb * 128);
            const int gr = lane >> 3, gc = lane & 7;
#define DS_ROFF(g_, ro_) do { const v4u i0_ = *(const LAS v4u*)((const LAS unsigned char*)idx + (64 * (g_) + 8 * gr) * 4), i1_ = *(const LAS v4u*)((const LAS unsigned char*)idx + (64 * (g_) + 8 * gr) * 4 + 16); \
                _Pragma("unroll") for (int j = 0; j < 4; ++j) { ro_[j] = i0_[j] + (unsigned)gc * 16u; ro_[4 + j] = i1_[j] + (unsigned)gc * 16u; } } while (0)
            v4u kreg[3][8], vreg[4][8];
#pragma unroll
            for (int g = 0; g < 3; ++g) { unsigned ro[8]; DS_ROFF(g, ro);
#pragma unroll
                for (int j = 0; j < 8; ++j) kreg[g][j] = *(const v4u*)(kvbase + ro[j]); }
            pg8::bf16x8 pf[8];
            const unsigned kfr = kbn + fr * 128;
            const int ksw = (fr >> 1) & 7;
#pragma unroll
            for (int g = 0; g < 4; ++g) {
                asm volatile("s_waitcnt lgkmcnt(0)" ::: "memory");
#pragma unroll
                for (int j = 0; j < 8; ++j) { const int rl = 8 * j + gr; *(LAS v4u*)(lds + kbn + rl * 128 + ((gc ^ ((rl >> 1) & 7)) << 4)) = kreg[g == 3 ? 0 : g][j]; }
                asm volatile("s_waitcnt lgkmcnt(0)" ::: "memory");
                f32x4 pt[4];
#pragma unroll
                for (int tt = 0; tt < 4; ++tt) {
                    const pg8::bf16x8 k0 = *(const LAS pg8::bf16x8*)(lds + kfr + tt * 2048 + ((fq ^ ksw) << 4)), k1 = *(const LAS pg8::bf16x8*)(lds + kfr + tt * 2048 + (((4 + fq) ^ ksw) << 4));
                    f32x4 d = (f32x4){0.f, 0.f, 0.f, 0.f};
                    d = __builtin_amdgcn_mfma_f32_16x16x32_bf16(k0, q0, d, 0, 0, 0); pt[tt] = __builtin_amdgcn_mfma_f32_16x16x32_bf16(k1, q1, d, 0, 0, 0); }
#pragma unroll
                for (int tt = 0; tt < 4; ++tt) {
#pragma unroll
                    for (int r = 0; r < 4; ++r) pt[tt][r] = __builtin_amdgcn_exp2f(pt[tt][r]);
                    if (nsel < TOPK) {
#pragma unroll
                        for (int r = 0; r < 4; ++r) { const int rl = 16 * tt + 4 * fq + r; if (64 * g + 8 * (rl & 7) + (rl >> 3) >= nsel) pt[tt][r] = 0.f; } } }
#pragma unroll
                for (int h2 = 0; h2 < 2; ++h2) { v4u w; w.x = pg8::cvt_pk_bf16(pt[2 * h2][0], pt[2 * h2][1]); w.y = pg8::cvt_pk_bf16(pt[2 * h2][2], pt[2 * h2][3]);
                    w.z = pg8::cvt_pk_bf16(pt[2 * h2 + 1][0], pt[2 * h2 + 1][1]); w.w = pg8::cvt_pk_bf16(pt[2 * h2 + 1][2], pt[2 * h2 + 1][3]); pf[2 * g + h2] = __builtin_bit_cast(pg8::bf16x8, w); }
                if (g == 0) { unsigned ro[8]; DS_ROFF(3, ro);
#pragma unroll
                    for (int j = 0; j < 8; ++j) kreg[0][j] = *(const v4u*)(kvbase + ro[j]); }
                else { unsigned ro[8]; DS_ROFF(g - 1, ro);
#pragma unroll
                  for (int j = 0; j < 8; ++j) vreg[g - 1][j] = *(const v4u*)(kvbase + ro[j] + 128u); }
            }
            f32x4 o[4], osum = (f32x4){0.f, 0.f, 0.f, 0.f};
#pragma unroll
            for (int dt = 0; dt < 4; ++dt) o[dt] = (f32x4){0.f, 0.f, 0.f, 0.f};
            pg8::bf16x8 ones;
#pragma unroll
            for (int e = 0; e < 8; ++e) ones[e] = (short)0x3f80;
            const int trow = 4 * fq + (fr >> 2), tsw = (trow >> 1) & 3;
            const unsigned tbase = vbn + trow * 128 + (fr & 3) * 8;
#pragma unroll
            for (int g = 0; g < 4; ++g) {
                asm volatile("s_waitcnt lgkmcnt(0)" ::: "memory");
#pragma unroll
                for (int j = 0; j < 8; ++j) { const int rl = 8 * j + gr; *(LAS v4u*)(lds + vbn + rl * 128 + (((((gc >> 1) ^ ((rl >> 1) & 3)) << 1) | (gc & 1)) << 4)) = vreg[g][j]; }
                if (g == 0) { unsigned ro[8]; DS_ROFF(3, ro);
#pragma unroll
                    for (int j = 0; j < 8; ++j) vreg[3][j] = *(const v4u*)(kvbase + ro[j] + 128u); }
                asm volatile("s_waitcnt lgkmcnt(0)" ::: "memory");
#pragma unroll
                for (int s2l = 0; s2l < 2; ++s2l) {
#pragma unroll
                    for (int dt = 0; dt < 4; ++dt) { const unsigned a0 = tbase + s2l * 4096 + ((dt ^ tsw) << 5);
                        const s16x4v lo = __builtin_bit_cast(s16x4v, __builtin_amdgcn_ds_read_tr16_b64_v4i16((LAS s16x4v*)(lds + a0)));
                        const s16x4v hi = __builtin_bit_cast(s16x4v, __builtin_amdgcn_ds_read_tr16_b64_v4i16((LAS s16x4v*)(lds + a0 + 2048)));
                        const pg8::bf16x8 vf = __builtin_shufflevector(lo, hi, 0, 1, 2, 3, 4, 5, 6, 7);
                        o[dt] = __builtin_amdgcn_mfma_f32_16x16x32_bf16(vf, pf[2 * g + s2l], o[dt], 0, 0, 0); }
                    osum = __builtin_amdgcn_mfma_f32_16x16x32_bf16(ones, pf[2 * g + s2l], osum, 0, 0, 0);
                }
            }
#undef DS_ROFF
            const float rinv = 1.f / osum[0];
            bf16* op = AO + (tokb + p) * DM + fr * 64 + 4 * fq;
#pragma unroll
            for (int dt = 0; dt < 4; ++dt) { u32x2v w; w.x = pg8::cvt_pk_bf16(o[dt][0] * rinv, o[dt][1] * rinv); w.y = pg8::cvt_pk_bf16(o[dt][2] * rinv, o[dt][3] * rinv); *(u32x2v*)(op + 16 * dt) = w; }
        }
        asm volatile("s_waitcnt vmcnt(0) lgkmcnt(0)" ::: "memory");
        __syncthreads();
    }
}

struct Args { const float* in[21]; float* out; unsigned char* ws; RopeInv rinv; int ph_lo, ph_hi, dsa_mask, pad; };
static_assert(sizeof(Args) == 21 * 8 + 8 + 8 + 128 + 16, "Args has no padding");

__global__ void __launch_bounds__(NTHREADS, 2) mk_fwd(Args args) {
    extern __shared__ __attribute__((aligned(16))) unsigned char lds_raw[];
    LAS unsigned char* lds = (LAS unsigned char*)lds_raw;
    const int tid = threadIdx.x, lane = tid & 63, wave = __builtin_amdgcn_readfirstlane(tid >> 6);
    const int G = gridDim.x, bx = blockIdx.x;
    const int vcu = (G % 8 == 0) ? (bx % 8) * (G / 8) + bx / 8 : bx;
    unsigned char* ws = args.ws;
    volatile LAS unsigned* MISC = (volatile LAS unsigned*)(lds + MISC_OFF);
    if (tid < 64) MISC[tid] = 0u;
    __syncthreads();
    const int lo = args.ph_lo, hi = args.ph_hi;
    XcdBarrier bar; bar.bar = (unsigned*)(ws + WS_CTL) + CW_BAR; bar.x = 0; bar.st = nullptr;
    if (hi - lo > 1) bar = xcd_barrier_post((unsigned*)(ws + WS_CTL) + CW_BAR, MISC + 8);
#define IN(k) (lo <= (k) && (k) < hi)
#define SEAM(k) do { if (IN(k) && IN((k) + 1)) xcd_barrier(bar); } while (0)
    const float* mod = (const float*)(ws + WS_MOD);
    bf16* H = (bf16*)(ws + WS_H);
    const float* x_in = args.in[0]; float* xo = args.out;
    bf16* XR = (bf16*)(ws + WS_XR);

    if (IN(0)) { phase_prep<0>(args.in, ws, lds, args.rinv, tid, lane, wave, bx, G); } SEAM(0);
    if (IN(1)) { phase_norm<false>(x_in, args.in[2], mod + 0 * DM, mod + 1 * DM, H, lane, wave, vcu, G); phase_prep<1>(args.in, ws, lds, args.rinv, tid, lane, wave, bx, G); } SEAM(1);
    if (IN(2)) { pg8::Gemm g{H, (const bf16*)(ws + WS_WAIN), MTOK, 2 * DRNN, DM}; pg8::StaticOrder S; S.init(MTOK, 2 * DRNN, G, bx);
        pg8::EpiXbGate E{(bf16*)(ws + WS_XB), (bf16*)(ws + WS_GATE)};
        pg8::gemm_phase<pg8::EpiXbGate, pg8::StaticOrder, true, true>(lds, g, S, E); } SEAM(2);
    if (IN(3)) { if (bx < 160) phase_rglru(args.in, ws, lds, tid, lane, wave, bx); else phase_prep<2>(args.in, ws, lds, args.rinv, tid, lane, wave, bx - 160, G - 160); } SEAM(3);
    if (IN(4)) { pg8::Gemm g{(const bf16*)(ws + WS_Y), (const bf16*)(ws + WS_WAOUT), MTOK, DM, DRNN}; pg8::StaticOrder S; S.init(MTOK, DM, G, bx);
        pg8::EpiRes<false, true> E{x_in, XR, mod + 2 * DM};
        pg8::gemm_phase<pg8::EpiRes<false, true>, pg8::StaticOrder, true, true>(lds, g, S, E); } SEAM(4);
    if (IN(5)) { phase_norm<true>(XR, args.in[3], mod + 3 * DM, mod + 4 * DM, H, lane, wave, vcu, G); } SEAM(5);
    if (IN(6)) { pg8::Gemm g{H, (const bf16*)(ws + WS_W1), MTOK, DFF, DM}; pg8::StaticOrder S; S.init(MTOK, DFF, G, bx);
        pg8::EpiRelu2 E{(bf16*)(ws + WS_BIG)};
        pg8::gemm_phase<pg8::EpiRelu2, pg8::StaticOrder, true, true>(lds, g, S, E); } SEAM(6);
    if (IN(7)) { pg8::Gemm g{(const bf16*)(ws + WS_BIG), (const bf16*)(ws + WS_W2), MTOK, DM, DFF, 1, 1}; pg8::StaticOrder S; S.init(MTOK, DM, G, bx);
        pg8::EpiRes<true, true> E{XR, XR, mod + 5 * DM};
        pg8::gemm_phase<pg8::EpiRes<true, true>, pg8::StaticOrder, true, true>(lds, g, S, E); } SEAM(7);
    const float* mod1 = mod + NB * NMOD;
    if (IN(8)) { phase_norm<true>(XR, args.in[2] + DM, mod1 + 0 * DM, mod1 + 1 * DM, H, lane, wave, vcu, G); } SEAM(8);
    if (IN(9)) { pg8::Gemm g{H, (const bf16*)(ws + WS_WBIN), MTOK, BINP, DM}; pg8::StaticOrder S; S.init(MTOK, BINP, G, bx);
        pg8::EpiIn1 E{(bf16*)(ws + WS_Q), (bf16*)(ws + WS_QI), (bf16*)(ws + WS_KV), (bf16*)(ws + WS_KV) + 64, (bf16*)(ws + WS_KI), (float*)(ws + WS_WI), (const float*)(ws + WS_ROPE), args.in[16], args.in[17]};
        pg8::gemm_phase<pg8::EpiIn1, pg8::StaticOrder, true, true>(lds, g, S, E); } SEAM(9);
    if (IN(10)) { phase_dsa(ws, lds, tid, lane, wave, bx, G, args.dsa_mask); } SEAM(10);
    if (IN(11)) { pg8::Gemm g{(const bf16*)(ws + WS_AO), (const bf16*)(ws + WS_WBOUT), MTOK, DM, DM}; pg8::StaticOrder S; S.init(MTOK, DM, G, bx);
        pg8::EpiRes<true, true> E{XR, XR, mod1 + 2 * DM};
        pg8::gemm_phase<pg8::EpiRes<true, true>, pg8::StaticOrder, true, true>(lds, g, S, E); } SEAM(11);
    if (IN(12)) { phase_norm<true>(XR, args.in[3] + DM, mod1 + 3 * DM, mod1 + 4 * DM, H, lane, wave, vcu, G); } SEAM(12);
    if (IN(13)) { pg8::Gemm g{H, (const bf16*)(ws + WS_W1) + (size_t)DFF * DM, MTOK, DFF, DM}; pg8::StaticOrder S; S.init(MTOK, DFF, G, bx);
        pg8::EpiRelu2 E{(bf16*)(ws + WS_BIG)};
        pg8::gemm_phase<pg8::EpiRelu2, pg8::StaticOrder, true, true>(lds, g, S, E); } SEAM(13);
    if (IN(14)) { pg8::Gemm g{(const bf16*)(ws + WS_BIG), (const bf16*)(ws + WS_W2) + (size_t)DM * DFF, MTOK, DM, DFF, 1, 1}; pg8::StaticOrder S; S.init(MTOK, DM, G, bx);
        pg8::EpiRes<true, false> E{XR, xo, mod1 + 5 * DM};
        pg8::gemm_phase<pg8::EpiRes<true, false>, pg8::StaticOrder, true, true>(lds, g, S, E); }
#undef IN
#undef SEAM
}

extern "C" void kernel_launch(void* const* d_in, const int* in_sizes, int n_in, void* d_out, int out_size, void* d_ws, size_t ws_size, hipStream_t stream) {
    static int grid = 0;
    if (grid == 0) {
        if (n_in != 21 || in_sizes[0] != MTOK * DM || out_size != MTOK * DM || ws_size < WS_END) {
            fprintf(stderr, "kernel_launch: unexpected shapes: n_in %d in0 %d out %d ws %zu (need >= %zu); nothing launched\n", n_in, n_in > 0 ? in_sizes[0] : -1, out_size, ws_size, (size_t)WS_END); grid = -1; return; }
        int dev = 0, cus = 0, per_cu = 0;
        if (hipGetDevice(&dev) != hipSuccess || hipDeviceGetAttribute(&cus, hipDeviceAttributeMultiprocessorCount, dev) != hipSuccess) { fprintf(stderr, "kernel_launch: device query failed\n"); grid = -1; return; }
        if (hipFuncSetAttribute((const void*)mk_fwd, hipFuncAttributeMaxDynamicSharedMemorySize, LDS_BYTES) != hipSuccess) { fprintf(stderr, "kernel_launch: hipFuncSetAttribute(%d B LDS) failed\n", LDS_BYTES); grid = -1; return; }
        if (hipOccupancyMaxActiveBlocksPerMultiprocessor(&per_cu, (const void*)mk_fwd, NTHREADS, LDS_BYTES) != hipSuccess || per_cu < 1)
            fprintf(stderr, "kernel_launch: note: occupancy query reports %d workgroups per CU\n", per_cu);
        (void)hipGetLastError();
        grid = cus;
    }
    if (grid < 0) return;
    if (hipMemsetAsync((char*)d_ws + WS_CTL, 0, CTL_ZERO_BYTES, stream) != hipSuccess) { fprintf(stderr, "kernel_launch: memset failed\n"); return; }
    Args a{};
    for (int i = 0; i < 21; ++i) a.in[i] = (const float*)d_in[i];
    a.out = (float*)d_out; a.ws = (unsigned char*)d_ws; a.dsa_mask = 7;
    for (int i = 0; i < 32; ++i) a.rinv.v[i] = powf(10000.0f, -(float)(2 * i) / 64.0f);
    for (int li = 0; li < N_LAUNCHES; ++li) {
        if (N_LAUNCHES == 1) { a.ph_lo = 0; a.ph_hi = N_PHASES; } else { a.ph_lo = li; a.ph_hi = li + 1; }
        const int reps = (N_LAUNCHES != 1 && li == PROBE_PH) ? PROBE_N : 1;
        for (int r = 0; r < reps; ++r) {
            a.dsa_mask = (r + 1 < reps) ? PROBE_MASK : 7;
            hipLaunchKernelGGL(mk_fwd, dim3(grid), dim3(NTHREADS), LDS_BYTES, stream, a);
            const hipError_t le = hipPeekAtLastError();
            if (le != hipSuccess) { fprintf(stderr, "kernel_launch: launch %d failed: %s\n", li, hipGetErrorName(le)); break; }
        }
    }
}
```

```cpp
#include <hip/hip_runtime.h>
#include <cstdio>
#include <cstdint>
#include <cmath>
#define MK_N_LAUNCHES 1
#define PROBE_PH -1
#define PROBE_N 1
#define PROBE_MASK 7
namespace pg8 {
#define PG8_LAS __attribute__((address_space(3)))
typedef unsigned short bf16_t;
typedef short bf16x8 __attribute__((ext_vector_type(8)));
typedef float f32x4 __attribute__((ext_vector_type(4)));
typedef unsigned u32x4 __attribute__((ext_vector_type(4)));
constexpr int BM = 256, BK = 64, HALF = 128, HTB = HALF * BK * 2  , STAGE_BYTES = 8 * HTB, NXCD = 8, WGM = 8;

__host__ __device__ __forceinline__ int lds_byte(int r, int c) { const int st = (r >> 4) * 2 + (c >> 5), rr = r & 15, cc = c & 31, ob = rr * 64 + cc * 2; return st * 1024 + (ob ^ (((ob >> 9) & 1) << 5)); }
__host__ __device__ __forceinline__ void stage_rc(int b, int& R, int& C) { const int st = b / 1024, sb = b % 1024, swz = sb ^ (((sb >> 9) & 1) << 5); R = (st >> 1) * 16 + swz / 64; C = (st & 1) * 32 + (swz % 64) / 2; }
__host__ __device__ __forceinline__ int perm32(int rho) { const int n = rho >> 4, i = rho & 15; return 8 * (i >> 2) + 4 * n + (i & 3); }

struct Unit { int pm, pn; };
struct Gemm { const bf16_t* A; const bf16_t* Bt; int M, N, K; int tiledA, tiledB; };

struct StaticOrder {
    int nM, nN, nwg, G, c;
    __host__ __device__ void init(int M, int N, int G_, int c_) { nM = M / BM; nN = N / BM; nwg = nM * nN; G = G_; c = c_; }
    __host__ __device__ bool next(int i, Unit& u) const {
        const long L = (long)i * G + c; if (L >= nwg) return false;
        int wgid = (int)L; { const int q = nwg / NXCD, r = nwg % NXCD, xcd = wgid % NXCD, off = wgid / NXCD; wgid = (xcd < r ? xcd * (q + 1) : r * (q + 1) + (xcd - r) * q) + off; }
        const int nig = WGM * nN, gid = wgid / nig, fm = gid * WGM, gsz = (nM - fm) < WGM ? (nM - fm) : WGM;
        u.pm = fm + ((wgid % nig) % gsz); u.pn = (wgid % nig) / gsz; return true;
    }
    __device__ __forceinline__ void a_ready(const Unit&) const {}
    __device__ __forceinline__ void done(const Unit&) const {}
};

__device__ __forceinline__ unsigned cvt_pk_bf16(float lo, float hi) { unsigned r; asm volatile("v_cvt_pk_bf16_f32 %0, %1, %2" : "=v"(r) : "v"(lo), "v"(hi)); return r; }
typedef float f32x2 __attribute__((ext_vector_type(2)));
template <class Epi, class Sched, bool ALIGN_EPI = false, bool SP2 = false>
__device__ __forceinline__ void gemm_phase(PG8_LAS unsigned char* lds, const Gemm g, const Sched& S, const Epi& E) {
    const int tid = threadIdx.x, wid = __builtin_amdgcn_readfirstlane(tid >> 6), lane = tid & 63, wr = wid >> 2, wc = wid & 3, fr = lane & 15, fq = lane >> 4;
    const int K = g.K, nt = K / BK;
    constexpr int NVM = ALIGN_EPI ? Epi::NVM : 0;
    unsigned voffA[2], voffB[2];
#pragma unroll
    for (int i = 0; i < 2; ++i) { int R, C; stage_rc(tid * 16 + i * 8192, R, C); const int Rb = Epi::PERM ? ((R & ~31) + perm32(R & 31)) : R;
        voffA[i] = (unsigned)(R * (g.tiledA ? BK : K) + C) * 2u; voffB[i] = (unsigned)(Rb * (g.tiledB ? BK : K) + C) * 2u; }
    const size_t kstepA = g.tiledA ? (size_t)BM * BK * 2 : (size_t)(BK * 2), hstepA = g.tiledA ? (size_t)HALF * BK * 2 : (size_t)HALF * K * 2, tstepA = (size_t)BM * K * 2;
    const size_t kstepB = g.tiledB ? (size_t)BM * BK * 2 : (size_t)(BK * 2), hstepB = g.tiledB ? (size_t)HALF * BK * 2 : (size_t)HALF * K * 2, tstepB = (size_t)BM * K * 2;
    const unsigned ldsw = (unsigned)wid * 1024u;
    const int aoff = lds_byte(wr * 64 + fr, fq * 8), boff = lds_byte(wc * 32 + fr, fq * 8);
#define PG8_SA(b, h) (((b) * 2 + (h)) * HTB)
#define PG8_SB(b, h) ((4 + (b) * 2 + (h)) * HTB)
#define PG8_STAGE(bufoff, gbase, voff) do { const char* gb_ = (const char*)(gbase); asm volatile("" : "+s"(gb_));     \
        _Pragma("unroll") for (int _i = 0; _i < 2; ++_i) \
        __builtin_amdgcn_global_load_lds((const unsigned*)(gb_ + (voff)[_i]), (PG8_LAS unsigned*)(lds + (bufoff) + ldsw + _i * 8192), 16, 0, 0); } while (0)
#define PG8_LDA(dst, b, h) do { _Pragma("unroll") for (int m = 0; m < 4; ++m) _Pragma("unroll") for (int k = 0; k < 2; ++k) dst[m][k] = *(const PG8_LAS bf16x8*)(lds + PG8_SA(b, h) + aoff + m * 2048 + k * 1024); } while (0)
#define PG8_LDB(dst, b, h) do { _Pragma("unroll") for (int n = 0; n < 2; ++n) _Pragma("unroll") for (int k = 0; k < 2; ++k) dst[n][k] = *(const PG8_LAS bf16x8*)(lds + PG8_SB(b, h) + boff + n * 2048 + k * 1024); } while (0)
#define PG8_MMA(ai, bj, At, Bt) do { __builtin_amdgcn_s_setprio(1); _Pragma("unroll") for (int m = 0; m < 4; ++m) _Pragma("unroll") for (int n = 0; n < 2; ++n) _Pragma("unroll") for (int k = 0; k < 2; ++k) \
        acc[ai][bj][m][n] = __builtin_amdgcn_mfma_f32_16x16x32_bf16(Bt[n][k], At[m][k], acc[ai][bj][m][n], 0, 0, 0); __builtin_amdgcn_s_setprio(0); } while (0)
#define PG8_WAIT_V(n) asm volatile("s_waitcnt vmcnt(" #n ")" ::: "memory")
#define PG8_WAIT_VN(n) asm volatile("s_waitcnt vmcnt(%0)" :: "n"(n) : "memory")
#define PG8_WAIT_L(n) asm volatile("s_waitcnt lgkmcnt(" #n ")" ::: "memory")
#define PG8_BAR __builtin_amdgcn_s_barrier()
#define PG8_SCHED __builtin_amdgcn_sched_barrier(0)
    Unit cur, nxt; int ui = 0;
    if (!S.next(0, cur)) return;
    f32x4 acc[2][2][4][2];
#pragma unroll
    for (int a = 0; a < 2; ++a)
#pragma unroll
        for (int b = 0; b < 2; ++b)
#pragma unroll
            for (int m = 0; m < 4; ++m)
#pragma unroll
                for (int n = 0; n < 2; ++n) acc[a][b][m][n] = (f32x4){0.f, 0.f, 0.f, 0.f};
    bf16x8 At[4][2], B0[2][2], B1[2][2];
    const char* cA = (const char*)g.A + (size_t)cur.pm * tstepA; const char* cB = (const char*)g.Bt + (size_t)cur.pn * tstepB;
    S.a_ready(cur);
    static_assert(SP2 && ALIGN_EPI, "only the two-super-phase loop with aligned epilogues is kept");
    PG8_STAGE(PG8_SB(0, 0), cB, voffB); PG8_STAGE(PG8_SB(0, 1), cB + hstepB, voffB); PG8_STAGE(PG8_SA(0, 0), cA, voffA); PG8_STAGE(PG8_SA(0, 1), cA + hstepA, voffA);
    PG8_STAGE(PG8_SB(1, 0), cB + kstepB, voffB); PG8_STAGE(PG8_SA(1, 0), cA + kstepA, voffA); PG8_STAGE(PG8_SB(1, 1), cB + hstepB + kstepB, voffB); PG8_STAGE(PG8_SA(1, 1), cA + hstepA + kstepA, voffA);
    if (wr == 1) PG8_BAR;
    PG8_WAIT_V(0); PG8_BAR;
    PG8_BAR;
    for (;;) {
        const bool has_next = S.next(ui + 1, nxt);
        const char* nA = has_next ? (const char*)g.A + (size_t)nxt.pm * tstepA : cA; const char* nB = has_next ? (const char*)g.Bt + (size_t)nxt.pn * tstepB : cB;
        {   const char* a2 = cA + (size_t)2 * kstepA; const char* b2 = cB + (size_t)2 * kstepB; const char* a3 = a2 + kstepA; const char* b3 = b2 + kstepB;
            PG8_LDB(B0, 0, 0); PG8_LDB(B1, 0, 1); PG8_SCHED; PG8_LDA(At, 0, 0);
            PG8_WAIT_VN(8 + NVM); PG8_WAIT_L(0); PG8_BAR; PG8_MMA(0, 0, At, B0); PG8_MMA(0, 1, At, B1); PG8_BAR; PG8_SCHED;
            PG8_LDA(At, 0, 1); PG8_STAGE(PG8_SB(0, 0), b2, voffB); PG8_STAGE(PG8_SB(0, 1), b2 + hstepB, voffB); PG8_STAGE(PG8_SA(0, 0), a2, voffA);
            PG8_WAIT_VN(8 + NVM); PG8_WAIT_L(0); PG8_BAR; PG8_MMA(1, 0, At, B0); PG8_MMA(1, 1, At, B1); PG8_BAR; PG8_SCHED;
            PG8_LDB(B0, 1, 0); PG8_LDB(B1, 1, 1); PG8_SCHED; PG8_LDA(At, 1, 0); PG8_STAGE(PG8_SA(0, 1), a2 + hstepA, voffA);
            PG8_WAIT_VN(8 + NVM); PG8_WAIT_L(0); PG8_BAR; PG8_MMA(0, 0, At, B0); PG8_MMA(0, 1, At, B1); PG8_BAR; PG8_SCHED;
            PG8_LDA(At, 1, 1); PG8_STAGE(PG8_SB(1, 0), b3, voffB); PG8_STAGE(PG8_SB(1, 1), b3 + hstepB, voffB); PG8_STAGE(PG8_SA(1, 0), a3, voffA);
            PG8_WAIT_V(8); PG8_WAIT_L(0); PG8_BAR; PG8_MMA(1, 0, At, B0); PG8_MMA(1, 1, At, B1); PG8_BAR; PG8_SCHED;
        }
        for (int t = 2; t < nt; t += 2) {
            const bool last = (t == nt - 2);
            const char* a1 = cA + (size_t)(t + 1) * kstepA;
            const char* a2 = last ? nA : cA + (size_t)(t + 2) * kstepA; const char* b2 = last ? nB : cB + (size_t)(t + 2) * kstepB;
            const char* a3 = a2 + kstepA; const char* b3 = b2 + kstepB;
            if (last && has_next) S.a_ready(nxt);
            if constexpr (SP2) {
            PG8_LDB(B0, 0, 0); PG8_LDB(B1, 0, 1); PG8_SCHED; PG8_LDA(At, 0, 0); PG8_STAGE(PG8_SA(1, 1), a1 + hstepA, voffA);
            PG8_WAIT_V(8); PG8_WAIT_L(0); PG8_BAR; PG8_MMA(0, 0, At, B0); PG8_MMA(0, 1, At, B1); PG8_BAR; PG8_SCHED;
            PG8_LDA(At, 0, 1); PG8_STAGE(PG8_SB(0, 0), b2, voffB); PG8_STAGE(PG8_SB(0, 1), b2 + hstepB, voffB); PG8_STAGE(PG8_SA(0, 0), a2, voffA);
            PG8_WAIT_V(8); PG8_WAIT_L(0); PG8_BAR; PG8_MMA(1, 0, At, B0); PG8_MMA(1, 1, At, B1); PG8_BAR; PG8_SCHED;
            PG8_LDB(B0, 1, 0); PG8_LDB(B1, 1, 1); PG8_SCHED; PG8_LDA(At, 1, 0); PG8_STAGE(PG8_SA(0, 1), a2 + hstepA, voffA);
            PG8_WAIT_V(8); PG8_WAIT_L(0); PG8_BAR; PG8_MMA(0, 0, At, B0); PG8_MMA(0, 1, At, B1); PG8_BAR; PG8_SCHED;
            PG8_LDA(At, 1, 1); PG8_STAGE(PG8_SB(1, 0), b3, voffB); PG8_STAGE(PG8_SB(1, 1), b3 + hstepB, voffB); PG8_STAGE(PG8_SA(1, 0), a3, voffA);
            PG8_WAIT_V(8); PG8_WAIT_L(0); PG8_BAR; PG8_MMA(1, 0, At, B0); PG8_MMA(1, 1, At, B1); PG8_BAR; PG8_SCHED;
            } else {
            PG8_LDB(B0, 0, 0); PG8_SCHED; PG8_LDA(At, 0, 0); PG8_STAGE(PG8_SA(1, 1), a1 + hstepA, voffA);
            PG8_WAIT_L(8); PG8_BAR; PG8_WAIT_L(0); PG8_MMA(0, 0, At, B0); PG8_BAR; PG8_SCHED;
            PG8_LDB(B1, 0, 1); PG8_STAGE(PG8_SB(0, 0), b2, voffB);
            PG8_BAR; PG8_WAIT_L(0); PG8_MMA(0, 1, At, B1); PG8_BAR;
            PG8_LDA(At, 0, 1); PG8_STAGE(PG8_SA(0, 0), a2, voffA);
            PG8_BAR; PG8_WAIT_L(0); PG8_MMA(1, 0, At, B0); PG8_BAR; PG8_SCHED;
            PG8_STAGE(PG8_SB(0, 1), b2 + hstepB, voffB);
            PG8_WAIT_V(6); PG8_BAR; PG8_MMA(1, 1, At, B1); PG8_BAR;
            PG8_LDB(B0, 1, 0); PG8_SCHED; PG8_LDA(At, 1, 0); PG8_STAGE(PG8_SA(0, 1), a2 + hstepA, voffA);
            PG8_WAIT_L(8); PG8_BAR; PG8_WAIT_L(0); PG8_MMA(0, 0, At, B0); PG8_BAR; PG8_SCHED;
            PG8_LDB(B1, 1, 1); PG8_STAGE(PG8_SB(1, 0), b3, voffB);
            PG8_BAR; PG8_WAIT_L(0); PG8_MMA(0, 1, At, B1); PG8_BAR;
            PG8_LDA(At, 1, 1); PG8_STAGE(PG8_SA(1, 0), a3, voffA);
            PG8_BAR; PG8_WAIT_L(0); PG8_MMA(1, 0, At, B0); PG8_BAR; PG8_SCHED;
            PG8_STAGE(PG8_SB(1, 1), b3 + hstepB, voffB);
            PG8_WAIT_V(6); PG8_BAR; PG8_MMA(1, 1, At, B1); PG8_BAR;
            }
        }
        if constexpr (ALIGN_EPI) { if (wr == 0) PG8_BAR; }
        PG8_STAGE(PG8_SA(1, 1), nA + kstepA + hstepA, voffA); PG8_SCHED;
        if constexpr (!Epi::AFTER_DRAIN) { int fr_ = fr, fq_ = fq; asm volatile("" : "+v"(fr_), "+v"(fq_));
            E(acc, cur, wr, wc, fr_, fq_); S.done(cur); }
        if (!has_next) break;
#pragma unroll
        for (int a = 0; a < 2; ++a)
#pragma unroll
            for (int b = 0; b < 2; ++b)
#pragma unroll
                for (int m = 0; m < 4; ++m)
#pragma unroll
                    for (int n = 0; n < 2; ++n) acc[a][b][m][n] = (f32x4){0.f, 0.f, 0.f, 0.f};
        cur = nxt; cA = nA; cB = nB; ++ui;
        if constexpr (ALIGN_EPI) { if (wr == 1) PG8_BAR; }
    }
    PG8_WAIT_V(0);
    if constexpr (!ALIGN_EPI) { if (wr == 0) PG8_BAR; }
    PG8_BAR;
    if constexpr (Epi::AFTER_DRAIN) { E.fused(acc, cur, wr, wc, fr, fq, lds, wid, lane); S.done(cur); }
#undef PG8_SA
#undef PG8_SB
#undef PG8_STAGE
#undef PG8_LDA
#undef PG8_LDB
#undef PG8_MMA
#undef PG8_WAIT_V
#undef PG8_WAIT_VN
#undef PG8_WAIT_L
#undef PG8_BAR
#undef PG8_SCHED
}
}
#define GAS __attribute__((address_space(1)))
#define LAS __attribute__((address_space(3)))
typedef unsigned short bf16;
typedef unsigned v4u __attribute__((ext_vector_type(4)));
typedef float f32x4 __attribute__((ext_vector_type(4)));
typedef short bf16x8 __attribute__((ext_vector_type(8)));
typedef GAS unsigned gu32;
typedef GAS unsigned long long gu64;
#define RLX_AGENT __ATOMIC_RELAXED, __HIP_MEMORY_SCOPE_AGENT
#define LDS_WAIT() asm volatile("s_waitcnt lgkmcnt(0)" ::: "memory")
#define VM_WAIT() asm volatile("s_waitcnt vmcnt(0)" ::: "memory")
__device__ __forceinline__ unsigned long long rt() { return __builtin_amdgcn_s_memrealtime(); }
__device__ __forceinline__ unsigned f2bf(float f) { unsigned u = __builtin_bit_cast(unsigned, f); return (u + 0x7fffu + ((u >> 16) & 1u)) >> 16; }
__device__ __forceinline__ unsigned pk2(float lo, float hi) { return f2bf(lo) | (f2bf(hi) << 16); }

#define XB_TMO      128
#define XB_XCNT(j)  (256  + 64 * (j))
#define XB_XSUB(j)  (1280 + 64 * (j))
#define XB_XGEN(j)  (2304 + 64 * (j))
#define XB_TOP      3328
#define XB_TOPGEN   3392
#define XCD_BAR_WORDS 3456
#define XB_SPIN_CAP (1u << 18)

__device__ __forceinline__ unsigned xb_ld(unsigned* p)              { return __hip_atomic_load(p, __ATOMIC_RELAXED, __HIP_MEMORY_SCOPE_AGENT); }
__device__ __forceinline__ unsigned xb_add(unsigned* p, unsigned v) { return __hip_atomic_fetch_add(p, v, __ATOMIC_RELAXED, __HIP_MEMORY_SCOPE_AGENT); }
__device__ __forceinline__ unsigned xb_xcc_id() { return (unsigned)__builtin_amdgcn_s_getreg((3 << 11) | 20) & 0xFu; }
#define XB_SPIN(cond, bar) do { unsigned _sp = 0; while (cond) { __builtin_amdgcn_s_sleep(1); \
    if ((++_sp & 255u) == 0u) { if (xb_ld(&(bar)[XB_TMO])) break; if (_sp > XB_SPIN_CAP) { atomicAdd(&(bar)[XB_TMO], 1u); break; } } } } while (0)

struct XcdBarrier {
    unsigned* bar; unsigned x;
    volatile LAS unsigned* st;
};

__device__ __forceinline__ XcdBarrier xcd_barrier_post(unsigned* bar, volatile LAS unsigned* st) {
    XcdBarrier b; b.bar = bar; b.x = xb_xcc_id(); b.st = st;
    if (threadIdx.x == 0) (void)xb_add(&bar[XB_XCNT(b.x)], 1u);
    return b;
}
__device__ __forceinline__ void xcd_barrier_complete(unsigned* bar, unsigned x, unsigned& nloc, unsigned& nx) {
    const unsigned G = gridDim.x * gridDim.y * gridDim.z;
    unsigned sum, cnt, mine, sp = 0u;
    for (;;) {
        sum = 0u; cnt = 0u; mine = 0u;
#pragma unroll
        for (unsigned j = 0; j < 16; ++j) { const unsigned c = xb_ld(&bar[XB_XCNT(j)]); sum += c; cnt += (c > 0u) ? 1u : 0u; mine = (j == x) ? c : mine; }
        if (sum == G) break;
        __builtin_amdgcn_s_sleep(1);
        if ((++sp & 255u) == 0u) { if (xb_ld(&bar[XB_TMO])) break; if (sp > XB_SPIN_CAP) { atomicAdd(&bar[XB_TMO], 1u); break; } }
    }
    nloc = mine > 0u ? mine : 1u; nx = cnt > 0u ? cnt : 1u;
}

__device__ __forceinline__ void xcd_barrier(const XcdBarrier& b) {
    asm volatile("s_waitcnt vmcnt(0)" ::: "memory");
    __syncthreads();
    if (threadIdx.x == 0) {
        unsigned* bar = b.bar;
        __builtin_amdgcn_s_waitcnt(0);
        unsigned nloc = b.st[0], nx = b.st[1];
        if (nloc == 0u) { xcd_barrier_complete(bar, b.x, nloc, nx); b.st[0] = nloc; b.st[1] = nx; }
        const unsigned old = xb_add(&bar[XB_XSUB(b.x)], 1u);
        const unsigned gen = old / nloc;
        if (old + 1u == (gen + 1u) * nloc) {
            __builtin_amdgcn_fence(__ATOMIC_RELEASE, "agent");
            asm volatile("s_waitcnt vmcnt(0)" ::: "memory");
            const unsigned og = xb_add(&bar[XB_TOP], 1u);
            const unsigned tg = og / nx;
            if (og + 1u == (tg + 1u) * nx) xb_add(&bar[XB_TOPGEN], 1u);
            else XB_SPIN(xb_ld(&bar[XB_TOPGEN]) == tg, bar);
            __builtin_amdgcn_fence(__ATOMIC_ACQUIRE, "agent");
            xb_add(&bar[XB_XGEN(b.x)], 1u);
            asm volatile("s_waitcnt vmcnt(0)" ::: "memory");
        } else {
            XB_SPIN(xb_ld(&bar[XB_XGEN(b.x)]) == gen, bar);
            __builtin_amdgcn_fence(__ATOMIC_ACQUIRE, "agent");
            asm volatile("s_waitcnt vmcnt(0)" ::: "memory");
        }
    }
    __syncthreads();
}

constexpr int NB = 8, SEQ = 4096, DM = 1024, MTOK = NB * SEQ, DFF = 4096, DRNN = 1280, NLB = 5, LBLK = 256;
constexpr int NHEAD = 16, HD = 64, IH = 8, TOPK = 256, BIN = 1736, BINP = 1792, NMOD = 6 * DM;
constexpr float RMS_EPS = 1e-6f;
constexpr int NWAVES = 8, NTHREADS = 512;
constexpr int N_PHASES = 15;
constexpr int N_LAUNCHES = MK_N_LAUNCHES;

constexpr size_t MiB = 1u << 20;
constexpr size_t WS_CTL = 0, CTL_ZERO_BYTES = 64 * 1024;
constexpr int CW_BAR = 4096;
constexpr size_t WS_MOD = 1 * MiB;
constexpr size_t WS_ROPE = 2 * MiB;
constexpr size_t WS_WAIN = 4 * MiB;
constexpr size_t WS_WAOUT = 9 * MiB;
constexpr size_t WS_WGATE = 12 * MiB;
constexpr size_t WS_WBIN = 14 * MiB;
constexpr size_t WS_WBOUT = 18 * MiB;
constexpr size_t WS_W1 = 20 * MiB;
constexpr size_t WS_W2 = 36 * MiB;
constexpr size_t WS_H = 64 * MiB;
constexpr size_t WS_BIG = 128 * MiB;
constexpr size_t WS_XB = WS_BIG, WS_GATE = WS_BIG + 80 * MiB, WS_Y = WS_BIG + 160 * MiB;
constexpr size_t WS_Q = WS_BIG, WS_QI = WS_BIG + 64 * MiB, WS_KV = WS_BIG + 96 * MiB  , WS_KI = WS_BIG + 104 * MiB, WS_WI = WS_BIG + 108 * MiB, WS_AO = WS_BIG + 112 * MiB;
constexpr size_t WS_XR = 384 * MiB;
constexpr size_t WS_END = 448 * MiB;

constexpr int LDS_BYTES = 163840;
constexpr int MISC_OFF = LDS_BYTES - 256;

typedef float f32x2v __attribute__((ext_vector_type(2)));
typedef __bf16 bf16x2_t __attribute__((ext_vector_type(2)));
__device__ __forceinline__ unsigned cvtpk(float lo, float hi) { const f32x2v v = {lo, hi}; return __builtin_bit_cast(unsigned, __builtin_convertvector(v, bf16x2_t)); }
#define pk2 cvtpk
typedef unsigned u32x2v __attribute__((ext_vector_type(2)));
typedef short s16x4v __attribute__((ext_vector_type(4)));

__device__ __forceinline__ float wave_sum(float v) {
#pragma unroll
    for (int o = 1; o < 64; o <<= 1) v += __shfl_xor(v, o);
    return v;
}
__device__ __forceinline__ float bf2f(unsigned short h) { return __builtin_bit_cast(float, (unsigned)h << 16); }
__device__ __forceinline__ float bflo(unsigned w) { return __builtin_bit_cast(float, w << 16); }
__device__ __forceinline__ float bfhi(unsigned w) { return __builtin_bit_cast(float, w & 0xffff0000u); }
__device__ __forceinline__ float sigmoidf_(float x) { return __builtin_amdgcn_rcpf(1.f + __builtin_amdgcn_exp2f(-1.4426950408889634f * x)); }

namespace pg8 {
__device__ __forceinline__ f32x2 gelu_tanh2(f32x2 x) {
    f32x2 u = (x * ((x * x) * 0.044715f + 1.0f)) * -2.302208198f;
    u.x = __builtin_amdgcn_exp2f(u.x); u.y = __builtin_amdgcn_exp2f(u.y); u = u + 1.0f;
    f32x2 r; r.x = __builtin_amdgcn_rcpf(u.x); r.y = __builtin_amdgcn_rcpf(u.y); return x * r;
}
struct EpiXbGate {
    static constexpr bool PERM = true, AFTER_DRAIN = false; static constexpr int NVM = 16;
    bf16_t* XB; bf16_t* GT;
    __device__ __forceinline__ void operator()(const f32x4 (&acc)[2][2][4][2], const Unit& u, int wr, int wc, int fr, int fq) const {
        const bool isg = u.pn >= 5;
        char* ub = (char*)(isg ? GT : XB) + ((size_t)u.pm * BM * DRNN + (size_t)(isg ? u.pn - 5 : u.pn) * BM) * 2;
        unsigned lo = (unsigned)(((wr * 64 + fr) * DRNN + wc * 32 + 8 * fq) * 2); asm volatile("" : "+v"(lo));
#pragma unroll
        for (int ai = 0; ai < 2; ++ai)
#pragma unroll
            for (int m = 0; m < 4; ++m) {
#pragma unroll
                for (int bj = 0; bj < 2; ++bj) { const f32x4 v0 = acc[ai][bj][m][0], v1 = acc[ai][bj][m][1];
                    f32x2 p0 = (f32x2){v0[0], v0[1]}, p1 = (f32x2){v0[2], v0[3]}, p2 = (f32x2){v1[0], v1[1]}, p3 = (f32x2){v1[2], v1[3]};
                    if (isg) { p0 = gelu_tanh2(p0); p1 = gelu_tanh2(p1); p2 = gelu_tanh2(p2); p3 = gelu_tanh2(p3); }
                    u32x4 w; w.x = cvtpk(p0.x, p0.y); w.y = cvtpk(p1.x, p1.y); w.z = cvtpk(p2.x, p2.y); w.w = cvtpk(p3.x, p3.y);
                    *(u32x4*)(ub + (lo + (unsigned)(((ai * HALF + m * 16) * DRNN + bj * HALF) * 2))) = w; } }
    }
};
template <bool RB, bool OB> struct EpiRes {
    static constexpr bool PERM = OB, AFTER_DRAIN = false; static constexpr int NVM = OB ? 16 : 32;
    const void* res; void* out; const float* gate;
    __device__ __forceinline__ static f32x2 bfpair(unsigned w) { return (f32x2){__builtin_bit_cast(float, w << 16), __builtin_bit_cast(float, w & 0xffff0000u)}; }
    __device__ __forceinline__ void operator()(const f32x4 (&acc)[2][2][4][2], const Unit& u, int wr, int wc, int fr, int fq) const {
        constexpr int nst = PERM ? 4 : 16, RS = RB ? 2 : 4, OS = OB ? 2 : 4;
        const size_t ue = (size_t)u.pm * BM * DM + (size_t)u.pn * BM;
        const char* rb = (const char*)res + ue * RS; char* ob = (char*)out + ue * OS;
        const unsigned le = (unsigned)((wr * 64 + fr) * DM + wc * 32 + (PERM ? 8 * fq : 4 * fq));
        f32x2 gv[2][2][2];
        { const float* gb = gate + (u.pm >> 4) * NMOD + u.pn * BM + wc * 32 + (PERM ? 8 * fq : 4 * fq);
#pragma unroll
          for (int bj = 0; bj < 2; ++bj)
#pragma unroll
            for (int n = 0; n < 2; ++n) { const f32x4 t = *(const f32x4*)(gb + bj * HALF + n * nst); gv[bj][n][0] = (f32x2){t[0], t[1]}; gv[bj][n][1] = (f32x2){t[2], t[3]}; } }
        constexpr int NP = RB ? 1 : 2, AP = 2 / NP;
#pragma unroll
        for (int part = 0; part < NP; ++part) {
            u32x4 rw[AP][4][2][(RB && PERM) ? 1 : 2]; f32x4 rf[AP][4][2][2];
#pragma unroll
            for (int a = 0; a < AP; ++a)
#pragma unroll
                for (int m = 0; m < 4; ++m)
#pragma unroll
                    for (int bj = 0; bj < 2; ++bj) { const unsigned eo = le + (unsigned)(((part * AP + a) * HALF + m * 16) * DM + bj * HALF);
                        if (RB && PERM) rw[a][m][bj][0] = *(const u32x4*)(rb + eo * RS);
                        else {
#pragma unroll
                            for (int n = 0; n < 2; ++n) {
                                if (RB) { const u32x2v w = *(const u32x2v*)(rb + (eo + n * nst) * RS); rw[a][m][bj][n].x = w.x; rw[a][m][bj][n].y = w.y; }
                                else rf[a][m][bj][n] = *(const f32x4*)(rb + (eo + n * nst) * RS); } } }
#pragma unroll
            for (int a = 0; a < AP; ++a)
#pragma unroll
                for (int m = 0; m < 4; ++m)
#pragma unroll
                    for (int bj = 0; bj < 2; ++bj) { const int ai = part * AP + a; const unsigned eo = le + (unsigned)((ai * HALF + m * 16) * DM + bj * HALF);
                        f32x2 o[2][2];
#pragma unroll
                        for (int n = 0; n < 2; ++n) { const f32x4 c = acc[ai][bj][m][n]; f32x2 r0, r1;
                            if (RB && PERM) { const u32x4 w = rw[a][m][bj][0]; r0 = bfpair(n ? w.z : w.x); r1 = bfpair(n ? w.w : w.y); }
                            else if (RB) { r0 = bfpair(rw[a][m][bj][n].x); r1 = bfpair(rw[a][m][bj][n].y); }
                            else { const f32x4 w = rf[a][m][bj][n]; r0 = (f32x2){w[0], w[1]}; r1 = (f32x2){w[2], w[3]}; }
                            o[n][0] = r0 + gv[bj][n][0] * (f32x2){c[0], c[1]}; o[n][1] = r1 + gv[bj][n][1] * (f32x2){c[2], c[3]}; }
                        if (OB) { u32x4 w; w.x = cvtpk(o[0][0].x, o[0][0].y); w.y = cvtpk(o[0][1].x, o[0][1].y); w.z = cvtpk(o[1][0].x, o[1][0].y); w.w = cvtpk(o[1][1].x, o[1][1].y);
                            *(u32x4*)(ob + eo * OS) = w; }
                        else { *(f32x4*)(ob + eo * OS) = (f32x4){o[0][0].x, o[0][0].y, o[0][1].x, o[0][1].y}; *(f32x4*)(ob + (eo + nst) * OS) = (f32x4){o[1][0].x, o[1][0].y, o[1][1].x, o[1][1].y}; } }
            if (part + 1 < NP) asm volatile("" ::: "memory");
        }
    }
};
struct EpiRelu2 {
    static constexpr bool PERM = true, AFTER_DRAIN = false; static constexpr int NVM = 16;
    bf16_t* O;
    __device__ __forceinline__ void operator()(const f32x4 (&acc)[2][2][4][2], const Unit& u, int wr, int wc, int fr, int fq) const {
        char* ub = (char*)O + (size_t)(u.pm * (DFF / 64) + u.pn * 4) * (256 * 64 * 2);
        unsigned lo = (unsigned)((((wc >> 1) * 256 + wr * 64 + fr) * 64 + (wc & 1) * 32 + 8 * fq) * 2); asm volatile("" : "+v"(lo));
#pragma unroll
        for (int ai = 0; ai < 2; ++ai)
#pragma unroll
            for (int m = 0; m < 4; ++m) {
#pragma unroll
                for (int bj = 0; bj < 2; ++bj) { const f32x4 v0 = acc[ai][bj][m][0], v1 = acc[ai][bj][m][1];
                    f32x2 p0 = (f32x2){__builtin_amdgcn_fmed3f(v0[0], 0.f, 3.0e38f), __builtin_amdgcn_fmed3f(v0[1], 0.f, 3.0e38f)}, p1 = (f32x2){__builtin_amdgcn_fmed3f(v0[2], 0.f, 3.0e38f), __builtin_amdgcn_fmed3f(v0[3], 0.f, 3.0e38f)};
                    f32x2 p2 = (f32x2){__builtin_amdgcn_fmed3f(v1[0], 0.f, 3.0e38f), __builtin_amdgcn_fmed3f(v1[1], 0.f, 3.0e38f)}, p3 = (f32x2){__builtin_amdgcn_fmed3f(v1[2], 0.f, 3.0e38f), __builtin_amdgcn_fmed3f(v1[3], 0.f, 3.0e38f)};
                    p0 = p0 * p0; p1 = p1 * p1; p2 = p2 * p2; p3 = p3 * p3;
                    u32x4 w; w.x = cvtpk(p0.x, p0.y); w.y = cvtpk(p1.x, p1.y); w.z = cvtpk(p2.x, p2.y); w.w = cvtpk(p3.x, p3.y);
                    *(u32x4*)(ub + (lo + (unsigned)(((ai * HALF + m * 16) * 64 + bj * 2 * 256 * 64) * 2))) = w; } }
    }
};
struct EpiIn1 {
    static constexpr bool PERM = true, AFTER_DRAIN = false; static constexpr int NVM = 0;
    bf16_t *Q, *QI, *K, *V, *KI; float* WI; const float* rope; const float *qg, *kg;
    __device__ __forceinline__ void operator()(const f32x4 (&acc)[2][2][4][2], const Unit& u, int wr, int wc, int fr, int fq) const {
        const int pn = u.pn;
        int kind;
        bf16_t* dst; int pitch, hoff;
        if (pn < 4) { kind = 0; dst = Q; pitch = DM; hoff = (4 * pn + wc) * 64; }
        else if (pn < 6) { kind = 1; dst = QI; pitch = 512; hoff = (4 * (pn - 4) + wc) * 64; }
        else if (wc == 0) { kind = 2; dst = K; pitch = 128; hoff = 0; }
        else if (wc == 1) { kind = 3; dst = KI; pitch = 64; hoff = 0; }
        else if (wc == 2) { kind = 4; dst = V; pitch = 128; hoff = 0; }
        else { kind = 5; dst = nullptr; pitch = 0; hoff = 0; }
        const bool donorm = (kind == 0 || kind == 2), dorope = (kind <= 3);
        const float osc = (kind == 0) ? 0.125f * 1.4426950408889634f : 1.f;
        f32x4 g1[2], g2[2];
#pragma unroll
        for (int n = 0; n < 2; ++n) { g1[n] = (f32x4){1.f, 1.f, 1.f, 1.f}; g2[n] = g1[n]; }
        if (kind == 0) {
#pragma unroll
            for (int n = 0; n < 2; ++n) { g1[n] = *(const f32x4*)(qg + 8 * fq + 4 * n); g2[n] = *(const f32x4*)(qg + 32 + 8 * fq + 4 * n); } }
        if (kind == 2) {
#pragma unroll
            for (int n = 0; n < 2; ++n) { g1[n] = *(const f32x4*)(kg + 8 * fq + 4 * n); g2[n] = *(const f32x4*)(kg + 32 + 8 * fq + 4 * n); } }
#pragma unroll
        for (int ai = 0; ai < 2; ++ai)
#pragma unroll
            for (int m = 0; m < 4; ++m) {
                const int row = u.pm * BM + ai * HALF + wr * 64 + m * 16 + fr, pos = row & (SEQ - 1);
                f32x4 x1[2], x2[2];
#pragma unroll
                for (int n = 0; n < 2; ++n) { x1[n] = acc[ai][0][m][n]; x2[n] = acc[ai][1][m][n]; }
                if (kind == 5) {
                    if (fq == 0) { *(f32x4*)(WI + (size_t)row * 8) = x1[0]; *(f32x4*)(WI + (size_t)row * 8 + 4) = x1[1]; }
                    continue;
                }
                if (donorm) {
                    float ss = 0.f;
#pragma unroll
                    for (int n = 0; n < 2; ++n)
#pragma unroll
                        for (int j = 0; j < 4; ++j) ss += x1[n][j] * x1[n][j] + x2[n][j] * x2[n][j];
                    ss += __shfl_xor(ss, 16); ss += __shfl_xor(ss, 32);
                    const float rs = 1.0f / sqrtf(ss * (1.f / 64.f) + RMS_EPS);
#pragma unroll
                    for (int n = 0; n < 2; ++n) { x1[n] = x1[n] * rs * g1[n]; x2[n] = x2[n] * rs * g2[n]; }
                }
                if (dorope) {
#pragma unroll
                    for (int n = 0; n < 2; ++n) { const f32x4 c = *(const f32x4*)(rope + pos * 32 + 8 * fq + 4 * n), s = *(const f32x4*)(rope + SEQ * 32 + pos * 32 + 8 * fq + 4 * n);
                        const f32x4 o1 = x1[n] * c - x2[n] * s, o2 = x2[n] * c + x1[n] * s; x1[n] = o1; x2[n] = o2; }
                }
#pragma unroll
                for (int n = 0; n < 2; ++n) { x1[n] = x1[n] * osc; x2[n] = x2[n] * osc; }
                bf16_t* rowp = (kind == 3) ? dst + (size_t)(row >> 4) * 1024 + fq * 128 + (row & 15) * 8 : dst + (size_t)row * pitch + hoff + 8 * fq;
                const int hi_off = (kind == 3) ? 512 : 32;
                u32x4 w; w.x = cvt_pk_bf16(x1[0][0], x1[0][1]); w.y = cvt_pk_bf16(x1[0][2], x1[0][3]); w.z = cvt_pk_bf16(x1[1][0], x1[1][1]); w.w = cvt_pk_bf16(x1[1][2], x1[1][3]);
                *(u32x4*)(rowp) = w;
                w.x = cvt_pk_bf16(x2[0][0], x2[0][1]); w.y = cvt_pk_bf16(x2[0][2], x2[0][3]); w.z = cvt_pk_bf16(x2[1][0], x2[1][1]); w.w = cvt_pk_bf16(x2[1][2], x2[1][3]);
                *(u32x4*)(rowp + hi_off) = w;
            }
    }
};
}

__device__ __forceinline__ int bin_row(int c) {
    if (c < 1024) { const int h = c >> 6, d = c & 63; return 256 * (h >> 2) + 128 * (d >> 5) + 32 * (h & 3) + (d & 31); }
    if (c < 1088) { const int d = c - 1024; return 1536 + 128 * (d >> 5) + (d & 31); }
    if (c < 1152) { const int d = c - 1088; return 1536 + 128 * (d >> 5) + 64 + (d & 31); }
    if (c < 1664) { const int cc = c - 1152, h = cc >> 6, d = cc & 63; return 256 * (4 + (h >> 2)) + 128 * (d >> 5) + 32 * (h & 3) + (d & 31); }
    if (c < 1728) { const int d = c - 1664; return 1536 + 128 * (d >> 5) + 32 + (d & 31); }
    return 1536 + 96 + (c - 1728);
}
template <int MODE>
__device__ __forceinline__ void tr_item(const float* W, int K, int N, bf16* WT, int item, LAS float* scr, int lane) {
    const int nblk = (N + 31) / 32, kb = item / nblk, nb = item % nblk, k0 = 64 * kb, n0 = 32 * nb;
    const int nn = n0 + (lane & 31); const bool nok = nn < N;
#pragma unroll 8
    for (int i = 0; i < 32; ++i) { const int kk = 2 * i + (lane >> 5); scr[kk * 33 + (lane & 31)] = nok ? W[(size_t)(k0 + kk) * N + nn] : 0.f; }
    LDS_WAIT(); asm volatile("" ::: "memory");
    const int c = lane & 7;
#pragma unroll
    for (int j = 0; j < 4; ++j) { const int n = (lane >> 3) + 8 * j, ncol = n0 + n; const LAS float* s = scr + (8 * c) * 33 + n;
        v4u o; o.x = pk2(s[0 * 33], s[1 * 33]); o.y = pk2(s[2 * 33], s[3 * 33]); o.z = pk2(s[4 * 33], s[5 * 33]); o.w = pk2(s[6 * 33], s[7 * 33]);
        if (ncol < N) {
            if (MODE == 3) *(GAS v4u*)(WT + ((size_t)((ncol >> 8) * (K / 64) + (k0 >> 6)) * 256 + (ncol & 255)) * 64 + 8 * c) = o;
            else { const int drow = (MODE == 0) ? ncol : bin_row(ncol); *(GAS v4u*)(WT + (size_t)drow * K + k0 + 8 * c) = o; } } }
    LDS_WAIT(); asm volatile("" ::: "memory");
}

struct RopeInv { float v[32]; };

template <int PART>
__device__ __forceinline__ void phase_prep(const float* const* in, unsigned char* ws, LAS unsigned char* lds, const RopeInv& rinv, int tid, int lane, int wave, int bx, int G) {
  constexpr bool LATE = PART == 2;
  if (PART == 0) {
    if (bx < 192) {
        LAS float* cond = (LAS float*)lds; LAS float* part = (LAS float*)(lds + 32768);
        const float* cin = in[1];
        for (int i = tid; i < NB * DM; i += NTHREADS) { const float v = cin[i]; cond[i] = v / (1.f + __expf(-v)); }
        __syncthreads();
        const int l = bx / 96, c0 = 64 * (bx % 96), cq = tid & 15, kg = tid >> 4;
        f32x4 a[NB];
#pragma unroll
        for (int b = 0; b < NB; ++b) a[b] = (f32x4){0.f, 0.f, 0.f, 0.f};
        const float* wp = in[4] + (size_t)l * DM * NMOD + c0 + 4 * cq;
#pragma unroll 4
        for (int kk = 0; kk < 32; ++kk) { const int k = kg * 32 + kk; const f32x4 w = *(const f32x4*)(wp + (size_t)k * NMOD);
#pragma unroll
            for (int b = 0; b < NB; ++b) { const float cv = cond[b * DM + k]; a[b] += w * cv; } }
#pragma unroll
        for (int b = 0; b < NB; ++b) *(LAS f32x4*)(part + (kg * NB + b) * 64 + 4 * cq) = a[b];
        __syncthreads();
        { const int b = tid >> 6, col = tid & 63; float s = 0.f;
#pragma unroll 8
          for (int k2 = 0; k2 < 32; ++k2) s += part[(k2 * NB + b) * 64 + col];
          ((float*)(ws + WS_MOD))[(size_t)(l * NB + b) * NMOD + c0 + col] = s + in[5][l * NMOD + c0 + col]; }
        __syncthreads();
    }
    return;
  }
  if (LATE) {
    { float* rope = (float*)(ws + WS_ROPE);
      for (int idx = bx * NTHREADS + tid; idx < SEQ * 32; idx += G * NTHREADS) { const int pos = idx >> 5, i = idx & 31;
          const float ang = (float)pos * rinv.v[i]; const double a = (double)ang; const double k = rint(a * 0.15915494309189535); const float x = (float)(a * 0.15915494309189535 - k);
          rope[idx] = __builtin_amdgcn_cosf(x); rope[SEQ * 32 + idx] = __builtin_amdgcn_sinf(x); } }
    { bf16* wb = (bf16*)(ws + WS_WBIN);
      for (int i = bx * NTHREADS + tid; i < 56 * 128; i += G * NTHREADS) { const int r = i >> 7, c8 = i & 127; const int row = r < 24 ? 1536 + 96 + 8 + r : 1536 + 128 + 96 + (r - 24);
          *(GAS v4u*)(wb + (size_t)row * DM + 8 * c8) = (v4u){0u, 0u, 0u, 0u}; } }
  }
    LAS float* scr = (LAS float*)(lds + wave * 16384);
    const int gw = bx * NWAVES + wave, NGW = G * NWAVES;
    constexpr int I_AIN = 16 * 80, I_AOUT = 20 * 32, I_G1 = 4 * 8, I_GATES = 10 * I_G1, I_BIN = 16 * 55, I_BOUT = 16 * 32, I_W1 = 16 * 128, I_W2 = 64 * 32;
    constexpr int NEARLY = I_AIN + I_GATES, NLATE = 2 * I_W1 + 2 * I_W2 + I_AOUT + I_BIN + I_BOUT;
    for (int it = gw; it < (LATE ? NLATE : NEARLY); it += NGW) {
        int r = it;
        if (!LATE) {
            if (r < I_AIN) { tr_item<0>(in[6], DM, 2 * DRNN, (bf16*)(ws + WS_WAIN), r, scr, lane); continue; } r -= I_AIN;
            { const int mi = r / I_G1, n = mi >> 1, gsel = mi & 1;
              tr_item<0>(in[gsel ? 11 : 9] + (size_t)n * LBLK * LBLK, LBLK, LBLK, (bf16*)(ws + WS_WGATE) + (size_t)(n * 2 + gsel) * LBLK * LBLK, r % I_G1, scr, lane); continue; }
        }
        if (r < I_W1 * 2) { const int l = r / I_W1; tr_item<0>(in[19] + (size_t)l * DM * DFF, DM, DFF, (bf16*)(ws + WS_W1) + (size_t)l * DFF * DM, r % I_W1, scr, lane); continue; } r -= 2 * I_W1;
        if (r < I_W2 * 2) { const int l = r / I_W2; tr_item<3>(in[20] + (size_t)l * DFF * DM, DFF, DM, (bf16*)(ws + WS_W2) + (size_t)l * DM * DFF, r % I_W2, scr, lane); continue; } r -= 2 * I_W2;
        if (r < I_AOUT) { tr_item<0>(in[14], DRNN, DM, (bf16*)(ws + WS_WAOUT), r, scr, lane); continue; } r -= I_AOUT;
        if (r < I_BIN) { tr_item<1>(in[15], DM, BIN, (bf16*)(ws + WS_WBIN), r, scr, lane); continue; } r -= I_BIN;
        tr_item<0>(in[18], DM, DM, (bf16*)(ws + WS_WBOUT), r, scr, lane);
    }
}

template <bool XB16>
__device__ __forceinline__ void phase_norm(const void* x, const float* g, const float* mod_sh, const float* mod_sc, bf16* H, int lane, int wave, int vcu, int G) {
    const int gw = vcu * NWAVES + wave, NGW = G * NWAVES;
    for (int r0 = gw * 16; r0 < MTOK; r0 += NGW * 16) {
        const int b = r0 >> 12;
        f32x4 al[4], be[4];
#pragma unroll
        for (int j = 0; j < 4; ++j) { const int c = XB16 ? 8 * lane + 512 * (j >> 1) + 4 * (j & 1) : 4 * lane + 256 * j;
            const f32x4 gg = *(const f32x4*)(g + c), sc = *(const f32x4*)(mod_sc + b * NMOD + c); al[j] = gg * (sc + 1.f); be[j] = *(const f32x4*)(mod_sh + b * NMOD + c); }
#pragma unroll 2
        for (int rr = 0; rr < 16; ++rr) {
            f32x4 v[4]; float s = 0.f;
            if (XB16) {
                const GAS v4u* xr = (const GAS v4u*)((const bf16*)x + (size_t)(r0 + rr) * DM) + lane;
#pragma unroll
                for (int j = 0; j < 2; ++j) { const v4u w = xr[64 * j];
                    v[2 * j] = (f32x4){bflo(w.x), bfhi(w.x), bflo(w.y), bfhi(w.y)}; v[2 * j + 1] = (f32x4){bflo(w.z), bfhi(w.z), bflo(w.w), bfhi(w.w)}; }
            } else {
                const GAS f32x4* xr = (const GAS f32x4*)((const float*)x + (size_t)(r0 + rr) * DM) + lane;
#pragma unroll
                for (int j = 0; j < 4; ++j) v[j] = xr[64 * j];
            }
#pragma unroll
            for (int j = 0; j < 4; ++j) s += (v[j].x * v[j].x + v[j].y * v[j].y) + (v[j].z * v[j].z + v[j].w * v[j].w);
            const float rstd = 1.0f / sqrtf(wave_sum(s) * (1.f / DM) + RMS_EPS);
            f32x4 y[4];
#pragma unroll
            for (int j = 0; j < 4; ++j) y[j] = v[j] * rstd * al[j] + be[j];
            if (XB16) {
                GAS v4u* o16 = (GAS v4u*)(H + (size_t)(r0 + rr) * DM) + lane;
#pragma unroll
                for (int j = 0; j < 2; ++j) { v4u o; o.x = pk2(y[2 * j].x, y[2 * j].y); o.y = pk2(y[2 * j].z, y[2 * j].w); o.z = pk2(y[2 * j + 1].x, y[2 * j + 1].y); o.w = pk2(y[2 * j + 1].z, y[2 * j + 1].w); o16[64 * j] = o; }
            } else {
                GAS unsigned long long* o8 = (GAS unsigned long long*)(H + (size_t)(r0 + rr) * DM) + lane;
#pragma unroll
                for (int j = 0; j < 4; ++j) o8[64 * j] = (unsigned long long)pk2(y[j].x, y[j].y) | ((unsigned long long)pk2(y[j].z, y[j].w) << 32);
            }
        }
    }
}

constexpr int RQ_CT = 128, RQ_AP = 528  , RQ_SP = 68  ;
constexpr int RQ_AT = 0, RQ_A = RQ_CT * RQ_AP, RQ_B = RQ_A + RQ_CT * RQ_SP * 4, RQ_SEG = RQ_B + RQ_CT * RQ_SP * 4, RQ_END = RQ_SEG + 16 * 32 * 16;
static_assert(RQ_END <= MISC_OFF, "rglru LDS map");
__device__ __forceinline__ f32x2v bf2x(unsigned w) { return (f32x2v){__builtin_bit_cast(float, w << 16), __builtin_bit_cast(float, w & 0xffff0000u)}; }
__device__ __forceinline__ void phase_rglru(const float* const* in, unsigned char* ws, LAS unsigned char* lds, int tid, int lane, int wave, int bx) {
    if (bx >= 160) return;
    const int b = bx & 7, n = (bx >> 3) >> 2, g = (bx >> 3) & 3;
    const bf16* XB = (const bf16*)(ws + WS_XB); const bf16* GT = (const bf16*)(ws + WS_GATE); bf16* Y = (bf16*)(ws + WS_Y);
    const int fr = lane & 15, fq = lane >> 4, wr = wave >> 2, wc = wave & 3;
    pg8::bf16x8 Br[8], Bi[8];
    { const bf16* wr_ = (const bf16*)(ws + WS_WGATE) + (size_t)(n * 2 + 0) * LBLK * LBLK + (size_t)(64 * g + 16 * wc + fr) * LBLK + 8 * fq;
      const bf16* wi_ = wr_ + (size_t)LBLK * LBLK;
#pragma unroll
      for (int kk = 0; kk < 8; ++kk) { Br[kk] = *(const pg8::bf16x8*)(wr_ + 32 * kk); Bi[kk] = *(const pg8::bf16x8*)(wi_ + 32 * kk); } }
    const int chl0 = 16 * wc + 4 * fq, chg0 = LBLK * n + 64 * g + chl0;
    f32x2v brv[2], biv[2], nsp[2];
    { const f32x4 x = *(const f32x4*)(in[10] + chg0), y = *(const f32x4*)(in[12] + chg0), lam = *(const f32x4*)(in[13] + chg0);
      brv[0] = (f32x2v){x[0], x[1]}; brv[1] = (f32x2v){x[2], x[3]}; biv[0] = (f32x2v){y[0], y[1]}; biv[1] = (f32x2v){y[2], y[3]};
      float t[4];
#pragma unroll
      for (int j = 0; j < 4; ++j) t[j] = -8.f * 1.4426950408889634f * log1pf(__expf(-lam[j]));
      nsp[0] = (f32x2v){t[0], t[1]}; nsp[1] = (f32x2v){t[2], t[3]}; }
    const int cq = lane;
    const int cch = LBLK * n + 4 * cq;
    f32x2v cw[4][2], cb[2];
#pragma unroll
    for (int j = 0; j < 4; ++j) { const f32x4 w0 = *(const f32x4*)(in[7] + j * DRNN + cch); cw[j][0] = (f32x2v){w0[0], w0[1]}; cw[j][1] = (f32x2v){w0[2], w0[3]}; }
    { const f32x4 b0 = *(const f32x4*)(in[8] + cch); cb[0] = (f32x2v){b0[0], b0[1]}; cb[1] = (f32x2v){b0[2], b0[3]}; }
    const int cp = tid & 31, sg = tid >> 5;
    f32x2v hin = (f32x2v){0.f, 0.f};
    const size_t tok0 = (size_t)b * SEQ;
    u32x2v xr[19];
#define RQ_LOADX(t0_) do { _Pragma("unroll") for (int i_ = 0; i_ < 19; ++i_) { const int t_ = (t0_) + 16 * wave - 3 + i_; \
        xr[i_] = (t_ >= 0) ? *(const GAS u32x2v*)(XB + (tok0 + t_) * DRNN + cch) : (u32x2v){0u, 0u}; } } while (0)
    RQ_LOADX(0);
    for (int c = 0; c < SEQ / RQ_CT; ++c) {
        const int t0 = c * RQ_CT;
        { f32x2v xf[19][2];
#pragma unroll
          for (int i = 0; i < 19; ++i) { xf[i][0] = bf2x(xr[i].x); xf[i][1] = bf2x(xr[i].y); }
#pragma unroll
          for (int tt = 0; tt < 16; ++tt) { f32x2v o0 = cb[0], o1 = cb[1];
#pragma unroll
              for (int j = 0; j < 4; ++j) { o0 += cw[j][0] * xf[tt + j][0]; o1 += cw[j][1] * xf[tt + j][1]; }
              u32x2v pk; pk.x = pk2(o0.x, o0.y); pk.y = pk2(o1.x, o1.y);
              *(LAS u32x2v*)(lds + RQ_AT + (16 * wave + tt) * RQ_AP + 8 * cq) = pk; } }
        if (c + 1 < SEQ / RQ_CT) RQ_LOADX(t0 + RQ_CT);
        unsigned gt[8];
        { const bf16* gp = GT + (tok0 + t0 + 8 * sg) * DRNN + LBLK * n + 64 * g + 2 * cp;
#pragma unroll
          for (int t = 0; t < 8; ++t) gt[t] = *(const GAS unsigned*)(gp + (size_t)t * DRNN); }
        __syncthreads();
        f32x4 ar[4], ai_[4];
#pragma unroll
        for (int m = 0; m < 4; ++m) { ar[m] = (f32x4){0.f, 0.f, 0.f, 0.f}; ai_[m] = ar[m]; }
#pragma unroll
        for (int kk = 0; kk < 8; ++kk)
#pragma unroll
            for (int m = 0; m < 4; ++m) { const pg8::bf16x8 xf = *(const LAS pg8::bf16x8*)(lds + RQ_AT + (64 * wr + 16 * m + fr) * RQ_AP + (32 * kk + 8 * fq) * 2);
                ar[m] = __builtin_amdgcn_mfma_f32_16x16x32_bf16(Br[kk], xf, ar[m], 0, 0, 0); ai_[m] = __builtin_amdgcn_mfma_f32_16x16x32_bf16(Bi[kk], xf, ai_[m], 0, 0, 0); }
#pragma unroll
        for (int m = 0; m < 4; ++m) { const int tk = 64 * wr + 16 * m + fr;
            const u32x2v xw = *(const LAS u32x2v*)(lds + RQ_AT + tk * RQ_AP + (64 * g + chl0) * 2);
            f32x4 av, bv;
#pragma unroll
            for (int h = 0; h < 2; ++h) { const f32x2v xc = bf2x(h ? xw.y : xw.x);
                f32x2v tr_ = ((f32x2v){ar[m][2 * h], ar[m][2 * h + 1]} + brv[h]) * -1.4426950408889634f, ti_ = ((f32x2v){ai_[m][2 * h], ai_[m][2 * h + 1]} + biv[h]) * -1.4426950408889634f;
                tr_.x = __builtin_amdgcn_exp2f(tr_.x); tr_.y = __builtin_amdgcn_exp2f(tr_.y); ti_.x = __builtin_amdgcn_exp2f(ti_.x); ti_.y = __builtin_amdgcn_exp2f(ti_.y);
                tr_ = tr_ + 1.0f; ti_ = ti_ + 1.0f;
                f32x2v rr, ii; rr.x = __builtin_amdgcn_rcpf(tr_.x); rr.y = __builtin_amdgcn_rcpf(tr_.y); ii.x = __builtin_amdgcn_rcpf(ti_.x); ii.y = __builtin_amdgcn_rcpf(ti_.y);
                f32x2v la = rr * nsp[h], a; a.x = __builtin_amdgcn_exp2f(la.x); a.y = __builtin_amdgcn_exp2f(la.y);
                f32x2v q = 1.0f - a * a, s; s.x = __builtin_amdgcn_sqrtf(__builtin_fabsf(q.x)); s.y = __builtin_amdgcn_sqrtf(__builtin_fabsf(q.y));
                const f32x2v bb = s * (ii * xc);
                av[2 * h] = a.x; av[2 * h + 1] = a.y; bv[2 * h] = bb.x; bv[2 * h + 1] = bb.y; }
            *(LAS f32x4*)(lds + RQ_A + (tk * RQ_SP + chl0) * 4) = av; *(LAS f32x4*)(lds + RQ_B + (tk * RQ_SP + chl0) * 4) = bv; }
        __syncthreads();
        f32x2v sa[8], sb[8];
#pragma unroll
        for (int t = 0; t < 8; ++t) { sa[t] = *(const LAS f32x2v*)(lds + RQ_A + ((8 * sg + t) * RQ_SP + 2 * cp) * 4); sb[t] = *(const LAS f32x2v*)(lds + RQ_B + ((8 * sg + t) * RQ_SP + 2 * cp) * 4); }
        { f32x2v A = sa[0], H = sb[0];
#pragma unroll
          for (int t = 1; t < 8; ++t) { A = A * sa[t]; H = sa[t] * H + sb[t]; }
          *(LAS f32x4*)(lds + RQ_SEG + (sg * 32 + cp) * 16) = (f32x4){A.x, A.y, H.x, H.y}; }
        __syncthreads();
        { f32x2v h = hin, mine = hin;
#pragma unroll
          for (int s = 0; s < 16; ++s) { const f32x4 sh = *(const LAS f32x4*)(lds + RQ_SEG + (s * 32 + cp) * 16); if (s == sg) mine = h; h = (f32x2v){sh[0], sh[1]} * h + (f32x2v){sh[2], sh[3]}; }
          hin = h;
          f32x2v hh = mine; bf16* yp = Y + (tok0 + t0 + 8 * sg) * DRNN + LBLK * n + 64 * g + 2 * cp;
#pragma unroll
          for (int t = 0; t < 8; ++t) { hh = sa[t] * hh + sb[t]; const f32x2v yv = hh * bf2x(gt[t]); *(GAS unsigned*)(yp + (size_t)t * DRNN) = pk2(yv.x, yv.y); } }
    }
#undef RQ_LOADX
}

constexpr int DS_SCP = 8224;
constexpr int DS_H1 = 8 * DS_SCP, DS_H2 = DS_H1 + 8 * 4096, DS_BNC = 0, DS_IDX = 8 * 16384, DS_DMY = DS_IDX + 8 * 1024, DS_END = DS_DMY + 8 * 256;
static_assert(DS_END <= MISC_OFF && DS_H2 + 8 * 2048 <= DS_IDX, "dsa LDS map");

__device__ __forceinline__ unsigned mbcnt64(unsigned long long m) { return __builtin_amdgcn_mbcnt_hi((unsigned)(m >> 32), __builtin_amdgcn_mbcnt_lo((unsigned)m, 0u)); }
__device__ __forceinline__ void wave_prefix4(unsigned x, unsigned& pre, unsigned& tot) {
    pre = 0u; tot = 0u;
#pragma unroll
    for (int bit = 0; bit < 4; ++bit) { const unsigned long long m = __ballot((x >> bit) & 1u); pre += mbcnt64(m) << bit; tot += (unsigned)__popcll(m) << bit; }
}
__device__ __forceinline__ unsigned row_scan_u32(unsigned v) {
    v += (unsigned)__builtin_amdgcn_update_dpp(0, (int)v, 0x111, 0xf, 0xf, true);
    v += (unsigned)__builtin_amdgcn_update_dpp(0, (int)v, 0x112, 0xf, 0xf, true);
    v += (unsigned)__builtin_amdgcn_update_dpp(0, (int)v, 0x114, 0xf, 0xf, true);
    v += (unsigned)__builtin_amdgcn_update_dpp(0, (int)v, 0x118, 0xf, 0xf, true);
    return v;
}
__device__ __forceinline__ void hist_find4(v4u c4, unsigned need, int lane, unsigned& B, unsigned& above, unsigned& atb) {
    const unsigned s = c4.x + c4.y + c4.z + c4.w;
    const unsigned inc = row_scan_u32(s);
    const unsigned t0 = (unsigned)__builtin_amdgcn_readlane((int)inc, 15), t1 = (unsigned)__builtin_amdgcn_readlane((int)inc, 31), t2 = (unsigned)__builtin_amdgcn_readlane((int)inc, 47), t3 = (unsigned)__builtin_amdgcn_readlane((int)inc, 63);
    const int row = lane >> 4;
    const unsigned before = (row > 0 ? t0 : 0u) + (row > 1 ? t1 : 0u) + (row > 2 ? t2 : 0u) + (inc - s);
    const unsigned total = (t0 + t1) + (t2 + t3);
    const unsigned S = total - before;
    const unsigned long long mk = __ballot(S >= need);
    const int L = 63 - __builtin_clzll(mk | 1ull);
    unsigned cum = S - s, bin, ab, at;
    if (cum + c4.w >= need) { bin = 4 * lane + 3; ab = cum; at = c4.w; }
    else { cum += c4.w; if (cum + c4.z >= need) { bin = 4 * lane + 2; ab = cum; at = c4.z; }
        else { cum += c4.z; if (cum + c4.y >= need) { bin = 4 * lane + 1; ab = cum; at = c4.y; } else { cum += c4.y; bin = 4 * lane; ab = cum; at = c4.x; } } }
    B = __builtin_amdgcn_readlane(bin, L); above = __builtin_amdgcn_readlane(ab, L); atb = __builtin_amdgcn_readlane(at, L);
}
__device__ __forceinline__ void pk_count4(unsigned& a0, unsigned& a1, unsigned& a2, unsigned& a3, unsigned k0, unsigned k1, unsigned k2, unsigned k3, unsigned cm) {
    unsigned t0, t1, t2, t3;
    asm("v_pk_sub_u16 %4, %8, %12 clamp\n\tv_pk_sub_u16 %5, %9, %12 clamp\n\tv_pk_sub_u16 %6, %10, %12 clamp\n\tv_pk_sub_u16 %7, %11, %12 clamp\n\t"
        "v_pk_min_u16 %4, %4, 1 op_sel_hi:[1,0]\n\tv_pk_min_u16 %5, %5, 1 op_sel_hi:[1,0]\n\tv_pk_min_u16 %6, %6, 1 op_sel_hi:[1,0]\n\tv_pk_min_u16 %7, %7, 1 op_sel_hi:[1,0]\n\t"
        "v_pk_add_u16 %0, %0, %4\n\tv_pk_add_u16 %1, %1, %5\n\tv_pk_add_u16 %2, %2, %6\n\tv_pk_add_u16 %3, %3, %7"
        : "+v"(a0), "+v"(a1), "+v"(a2), "+v"(a3), "=&v"(t0), "=&v"(t1), "=&v"(t2), "=&v"(t3) : "v"(k0), "v"(k1), "v"(k2), "v"(k3), "v"(cm));
}
__device__ __forceinline__ unsigned pk_bin2(unsigned w, unsigned b1p) {
    unsigned t, g;
    asm("v_pk_sub_u16 %0, %2, %3\n\tv_and_or_b32 %1, %0, %4, %5\n\tv_pk_min_u16 %0, %0, %1" : "=&v"(t), "=&v"(g) : "v"(w), "v"(b1p), "v"(0x00ff00ffu), "v"(0x01000100u));
    return t;
}
typedef _Float16 h16x2 __attribute__((ext_vector_type(2)));
__device__ __forceinline__ h16x2 pkrtz(float a, float b) { return __builtin_bit_cast(h16x2, __builtin_amdgcn_cvt_pkrtz(a, b)); }
__device__ __forceinline__ unsigned score_key(float s) {
    const int h = (int)(short)__builtin_bit_cast(unsigned short, (_Float16)s);
    return ((unsigned)h ^ ((unsigned)(h >> 15) | 0x8000u)) & 0xffffu;
}

__device__ __forceinline__ void phase_dsa(unsigned char* ws, LAS unsigned char* lds, int tid, int lane, int wave, int bx, int G, int mask) {
    const bf16* Qb = (const bf16*)(ws + WS_Q); const bf16* QIb = (const bf16*)(ws + WS_QI); const bf16* KVb = (const bf16*)(ws + WS_KV);
    const bf16* KIb = (const bf16*)(ws + WS_KI); const float* WIb = (const float*)(ws + WS_WI); bf16* AO = (bf16*)(ws + WS_AO);
    const int lane0 = lane;
    const int b = bx & 7, jj = bx >> 3, nj = G >> 3;
    const size_t tokb = (size_t)b * SEQ;
    for (int i = 0; ; ++i) {
        const int qb = ((i & 1) ? (nj - 1 - jj) : jj) + nj * i;
        if (qb >= SEQ / 8) break;
        const int p0 = 8 * qb, nk16 = (p0 + 8 + 15) & ~15, NT = nk16 >> 4;
        if (mask & 1) {
            int lane = lane0; asm volatile("" : "+v"(lane));
            const int fr = lane & 15, fq = lane >> 4;
            pg8::bf16x8 QA[2][2][2];
#pragma unroll
            for (int grp = 0; grp < 2; ++grp)
#pragma unroll
                for (int hf = 0; hf < 2; ++hf)
#pragma unroll
                    for (int ks = 0; ks < 2; ++ks)
                        QA[grp][hf][ks] = *(const pg8::bf16x8*)(QIb + (tokb + p0 + 4 * grp + (fr >> 2)) * 512 + (4 * hf + (fr & 3)) * 64 + 32 * ks + 8 * fq);
            h16x2 wq[2][4];
#pragma unroll
            for (int grp = 0; grp < 2; ++grp) { const f32x4 w0 = *(const f32x4*)(WIb + (tokb + p0 + 4 * grp + fq) * 8), w1 = *(const f32x4*)(WIb + (tokb + p0 + 4 * grp + fq) * 8 + 4);
                wq[grp][0] = pkrtz(w0[0], w0[1]); wq[grp][1] = pkrtz(w0[2], w0[3]); wq[grp][2] = pkrtz(w1[0], w1[1]); wq[grp][3] = pkrtz(w1[2], w1[3]); }
            const int ntw = NT > wave ? (NT - wave + 7) >> 3 : 0, ng = (ntw + 3) >> 2;
            const char* kibase = (const char*)(KIb + tokb * 64);
            const unsigned koff = (unsigned)lane * 16u;
            const h16x2 hz = {(_Float16)0.f, (_Float16)0.f};
            pg8::bf16x8 ka[4][2], kb[4][2];
#define DS_A_LOAD(buf, g) do { _Pragma("unroll") for (int u_ = 0; u_ < 4; ++u_) { int kt_ = wave + 8 * (4 * (g) + u_); kt_ = kt_ < NT ? kt_ : NT - 1; const unsigned o_ = koff + (unsigned)kt_ * 2048u; \
                buf[u_][0] = *(const pg8::bf16x8*)(kibase + o_); buf[u_][1] = *(const pg8::bf16x8*)(kibase + o_ + 1024u); } } while (0)
#define DS_A_COMP(buf, g) do { f32x4 d_[4][2][2]; \
                _Pragma("unroll") for (int u_ = 0; u_ < 4; ++u_) _Pragma("unroll") for (int grp = 0; grp < 2; ++grp) _Pragma("unroll") for (int hf = 0; hf < 2; ++hf) { \
                    f32x4 z_ = (f32x4){0.f, 0.f, 0.f, 0.f}; z_ = __builtin_amdgcn_mfma_f32_16x16x32_bf16(QA[grp][hf][0], buf[u_][0], z_, 0, 0, 0); d_[u_][grp][hf] = __builtin_amdgcn_mfma_f32_16x16x32_bf16(QA[grp][hf][1], buf[u_][1], z_, 0, 0, 0); } \
                _Pragma("unroll") for (int u_ = 0; u_ < 4; ++u_) { const int kt_ = wave + 8 * (4 * (g) + u_); const int key_ = 16 * kt_ + fr; \
                    _Pragma("unroll") for (int grp = 0; grp < 2; ++grp) { float s_ = 0.f; \
                        _Pragma("unroll") for (int hf = 0; hf < 2; ++hf) { \
                            s_ = __builtin_amdgcn_fdot2(__builtin_elementwise_max(pkrtz(d_[u_][grp][hf][0], d_[u_][grp][hf][1]), hz), wq[grp][2 * hf], s_, false); \
                            s_ = __builtin_amdgcn_fdot2(__builtin_elementwise_max(pkrtz(d_[u_][grp][hf][2], d_[u_][grp][hf][3]), hz), wq[grp][2 * hf + 1], s_, false); } \
                        const int q_ = 4 * grp + fq; const unsigned kk_ = (key_ <= p0 + q_) ? score_key(s_) : 0u; \
                        if (kt_ < NT) *(LAS unsigned short*)(lds + q_ * DS_SCP + key_ * 2) = (unsigned short)kk_; } } } while (0)
            DS_A_LOAD(ka, 0);
            DS_A_LOAD(kb, 1);
            for (int g = 0; g < ng; g += 2) {
                DS_A_COMP(ka, g);
                DS_A_LOAD(ka, g + 2);
                if (g + 1 < ng) DS_A_COMP(kb, g + 1);
                DS_A_LOAD(kb, g + 3);
            }
#undef DS_A_LOAD
#undef DS_A_COMP
        }
        LDS_WAIT();
        __syncthreads();
        const int p = p0 + wave, nvalid = p + 1;
        LAS unsigned* idx = (LAS unsigned*)(lds + DS_IDX + wave * 1024);
        int nsel = 1;
        if (!(mask & 2)) { }
        else if (nvalid <= TOPK) {
#pragma unroll
            for (int r = 0; r < 4; ++r) { const int s = lane0 + 64 * r; idx[s] = (unsigned)(s < nvalid ? s : 0) << 8; }
            nsel = nvalid;
        } else {
            int lane = lane0; asm volatile("" : "+v"(lane));
            const LAS unsigned char* row = lds + wave * DS_SCP;
            const int nit = (nk16 + 511) >> 9;
            unsigned kp[8][4];
#pragma unroll
            for (int it = 0; it < 8; ++it) { v4u v = (v4u){0u, 0u, 0u, 0u};
                if (it < nit) { const int e0 = it * 512 + lane * 8; if (e0 < nk16) v = *(const LAS v4u*)(row + e0 * 2); }
#pragma unroll
                for (int x = 0; x < 4; ++x) kp[it][x] = v[x]; }
            const unsigned h1w = DS_H1 + wave * 4096, h2w = DS_H2 + wave * 2048;
#pragma unroll
            for (int r = 0; r < 4; ++r) *(LAS v4u*)(lds + h1w + r * 1024 + lane * 16) = (v4u){0u, 0u, 0u, 0u};
#pragma unroll
            for (int r = 0; r < 2; ++r) *(LAS v4u*)(lds + h2w + r * 1024 + lane * 16) = (v4u){0u, 0u, 0u, 0u};
            LDS_WAIT();
            const unsigned h1l = h1w + (unsigned)(lane & 3) * 1024u;
#pragma unroll
            for (int it = 0; it < 8; ++it) if (it < nit) {
#pragma unroll
                for (int x = 0; x < 4; ++x) { const unsigned w = kp[it][x];
                    __hip_atomic_fetch_add((LAS unsigned*)(lds + h1l + ((w >> 6) & 0x3fcu)), 1u, __ATOMIC_RELAXED, __HIP_MEMORY_SCOPE_WORKGROUP);
                    __hip_atomic_fetch_add((LAS unsigned*)(lds + h1l + ((w >> 22) & 0x3fcu)), 1u, __ATOMIC_RELAXED, __HIP_MEMORY_SCOPE_WORKGROUP); } }
            LDS_WAIT();
            unsigned B1, above1, at1;
            { const v4u c0 = *(const LAS v4u*)(lds + h1w + lane * 16), c1 = *(const LAS v4u*)(lds + h1w + 1024 + lane * 16), c2 = *(const LAS v4u*)(lds + h1w + 2048 + lane * 16), c3 = *(const LAS v4u*)(lds + h1w + 3072 + lane * 16);
              hist_find4((c0 + c1) + (c2 + c3), (unsigned)TOPK, lane, B1, above1, at1); }
            const unsigned need1 = (unsigned)TOPK - above1;
            const unsigned b1p = B1 * 0x01000100u;
#pragma unroll
            for (int it = 0; it < 8; ++it) if (it < nit) {
#pragma unroll
                for (int x = 0; x < 4; ++x) { const unsigned m = pk_bin2(kp[it][x], b1p);
                    __hip_atomic_fetch_add((LAS unsigned*)(lds + h2w + ((m & 0xffffu) << 2)), 1u, __ATOMIC_RELAXED, __HIP_MEMORY_SCOPE_WORKGROUP);
                    __hip_atomic_fetch_add((LAS unsigned*)(lds + h2w + ((m >> 16) << 2)), 1u, __ATOMIC_RELAXED, __HIP_MEMORY_SCOPE_WORKGROUP); } }
            LDS_WAIT();
            unsigned B2, above2, at2;
            hist_find4(*(const LAS v4u*)(lds + h2w + lane * 16), need1, lane, B2, above2, at2);
            const unsigned T = (B1 << 8) | B2, need_eq = need1 - above2;
            if (need_eq == at2) {
                unsigned a0 = 0u, a1 = 0u, a2 = 0u, a3 = 0u; const unsigned cm = (T - 1u) * 0x10001u;
#pragma unroll
                for (int it = 0; it < 8; ++it) if (it < nit) pk_count4(a0, a1, a2, a3, kp[it][0], kp[it][1], kp[it][2], kp[it][3], cm);
                const unsigned a_ = (a0 + a1) + (a2 + a3), cl = (a_ & 0xffffu) + (a_ >> 16);
                const unsigned inc = row_scan_u32(cl);
                const unsigned t0 = (unsigned)__builtin_amdgcn_readlane((int)inc, 15), t1 = (unsigned)__builtin_amdgcn_readlane((int)inc, 31), t2 = (unsigned)__builtin_amdgcn_readlane((int)inc, 47);
                const int rw = lane >> 4;
                unsigned pa = DS_IDX + wave * 1024 + 4u * ((rw > 0 ? t0 : 0u) + (rw > 1 ? t1 : 0u) + (rw > 2 ? t2 : 0u) + (inc - cl));
                const unsigned eb = (unsigned)lane * 2048u;
#pragma unroll
                for (int it = 0; it < 8; ++it) if (it < nit) {
#pragma unroll
                    for (int k = 0; k < 8; ++k) { const unsigned kk_ = (k & 1) ? (kp[it][k >> 1] >> 16) : (kp[it][k >> 1] & 0xffffu);
                        if (kk_ >= T) { *(LAS unsigned*)(lds + pa) = eb + (unsigned)((it * 512 + k) << 8); pa += 4u; } } }
            } else {
                unsigned cnt = 0u, eqc = 0u;
#pragma unroll
                for (int it = 0; it < 8; ++it) if (it < nit) {
                    unsigned gtm = 0u, eqm = 0u;
#pragma unroll
                    for (int k = 0; k < 8; ++k) { const unsigned kk_ = (k & 1) ? (kp[it][k >> 1] >> 16) : (kp[it][k >> 1] & 0xffffu); gtm |= (kk_ > T) ? (1u << k) : 0u; eqm |= (kk_ == T) ? (1u << k) : 0u; }
                    unsigned selm = gtm;
                    if (__ballot(eqm != 0u)) { unsigned pre, tot; wave_prefix4((unsigned)__popc(eqm), pre, tot); unsigned run = eqc + pre;
#pragma unroll
                        for (int k = 0; k < 8; ++k) if ((eqm >> k) & 1u) { if (run < need_eq) selm |= (1u << k); ++run; }
                        eqc += tot; }
                    if (__ballot(selm != 0u)) { unsigned pre, tot; wave_prefix4((unsigned)__popc(selm), pre, tot); unsigned pos = cnt + pre; const int e0 = it * 512 + lane * 8;
#pragma unroll
                        for (int k = 0; k < 8; ++k) if ((selm >> k) & 1u) { idx[pos & 255u] = (unsigned)(e0 + k) << 8; ++pos; }
                        cnt += tot; }
                }
            }
            nsel = TOPK;
        }
        LDS_WAIT();
        __syncthreads();
        if (mask & 4) {
            int lane = lane0; asm volatile("" : "+v"(lane));
            const int fr = lane & 15, fq = lane >> 4;
            const unsigned kbn = DS_BNC + wave * 16384, vbn = kbn + 8192;
            const pg8::bf16x8 q0 = *(const pg8::bf16x8*)(Qb + (tokb + p) * DM + fr * 64 + 8 * fq), q1 = *(const pg8::bf16x8*)(Qb + (tokb + p) * DM + fr * 64 + 32 + 8 * fq);
            const char* kvbase = (const char*)(KVb + tokb * 128);
            const int gr = lane >> 3, gc = lane & 7;
#define DS_ROFF(g_, ro_) do { const v4u i0_ = *(const LAS v4u*)((const LAS unsigned char*)idx + (64 * (g_) + 8 * gr) * 4), i1_ = *(const LAS v4u*)((const LAS unsigned char*)idx + (64 * (g_) + 8 * gr) * 4 + 16); \
                _Pragma("unroll") for (int j = 0; j < 4; ++j) { ro_[j] = i0_[j] + (unsigned)gc * 16u; ro_[4 + j] = i1_[j] + (unsigned)gc * 16u; } } while (0)
            v4u kreg[3][8], vreg[4][8];
#pragma unroll
            for (int g = 0; g < 3; ++g) { unsigned ro[8]; DS_ROFF(g, ro);
#pragma unroll
                for (int j = 0; j < 8; ++j) kreg[g][j] = *(const v4u*)(kvbase + ro[j]); }
            pg8::bf16x8 pf[8];
            const unsigned kfr = kbn + fr * 128;
            const int ksw = (fr >> 1) & 7;
#pragma unroll
            for (int g = 0; g < 4; ++g) {
                asm volatile("s_waitcnt lgkmcnt(0)" ::: "memory");
#pragma unroll
                for (int j = 0; j < 8; ++j) { const int rl = 8 * j + gr; *(LAS v4u*)(lds + kbn + rl * 128 + ((gc ^ ((rl >> 1) & 7)) << 4)) = kreg[g == 3 ? 0 : g][j]; }
                asm volatile("s_waitcnt lgkmcnt(0)" ::: "memory");
                f32x4 pt[4];
#pragma unroll
                for (int tt = 0; tt < 4; ++tt) {
                    const pg8::bf16x8 k0 = *(const LAS pg8::bf16x8*)(lds + kfr + tt * 2048 + ((fq ^ ksw) << 4)), k1 = *(const LAS pg8::bf16x8*)(lds + kfr + tt * 2048 + (((4 + fq) ^ ksw) << 4));
                    f32x4 d = (f32x4){0.f, 0.f, 0.f, 0.f};
                    d = __builtin_amdgcn_mfma_f32_16x16x32_bf16(k0, q0, d, 0, 0, 0); pt[tt] = __builtin_amdgcn_mfma_f32_16x16x32_bf16(k1, q1, d, 0, 0, 0); }
#pragma unroll
                for (int tt = 0; tt < 4; ++tt) {
#pragma unroll
                    for (int r = 0; r < 4; ++r) pt[tt][r] = __builtin_amdgcn_exp2f(pt[tt][r]);
                    if (nsel < TOPK) {
#pragma unroll
                        for (int r = 0; r < 4; ++r) { const int rl = 16 * tt + 4 * fq + r; if (64 * g + 8 * (rl & 7) + (rl >> 3) >= nsel) pt[tt][r] = 0.f; } } }
#pragma unroll
                for (int h2 = 0; h2 < 2; ++h2) { v4u w; w.x = pg8::cvt_pk_bf16(pt[2 * h2][0], pt[2 * h2][1]); w.y = pg8::cvt_pk_bf16(pt[2 * h2][2], pt[2 * h2][3]);
                    w.z = pg8::cvt_pk_bf16(pt[2 * h2 + 1][0], pt[2 * h2 + 1][1]); w.w = pg8::cvt_pk_bf16(pt[2 * h2 + 1][2], pt[2 * h2 + 1][3]); pf[2 * g + h2] = __builtin_bit_cast(pg8::bf16x8, w); }
                if (g == 0) { unsigned ro[8]; DS_ROFF(3, ro);
#pragma unroll
                    for (int j = 0; j < 8; ++j) kreg[0][j] = *(const v4u*)(kvbase + ro[j]); }
                else { unsigned ro[8]; DS_ROFF(g - 1, ro);
#pragma unroll
                  for (int j = 0; j < 8; ++j) vreg[g - 1][j] = *(const v4u*)(kvbase + ro[j] + 128u); }
            }
            f32x4 o[4], osum = (f32x4){0.f, 0.f, 0.f, 0.f};
#pragma unroll
            for (int dt = 0; dt < 4; ++dt) o[dt] = (f32x4){0.f, 0.f, 0.f, 0.f};
            pg8::bf16x8 ones;
#pragma unroll
            for (int e = 0; e < 8; ++e) ones[e] = (short)0x3f80;
            const int trow = 4 * fq + (fr >> 2), tsw = (trow >> 1) & 3;
            const unsigned tbase = vbn + trow * 128 + (fr & 3) * 8;
#pragma unroll
            for (int g = 0; g < 4; ++g) {
                asm volatile("s_waitcnt lgkmcnt(0)" ::: "memory");
#pragma unroll
                for (int j = 0; j < 8; ++j) { const int rl = 8 * j + gr; *(LAS v4u*)(lds + vbn + rl * 128 + (((((gc >> 1) ^ ((rl >> 1) & 3)) << 1) | (gc & 1)) << 4)) = vreg[g][j]; }
                if (g == 0) { unsigned ro[8]; DS_ROFF(3, ro);
#pragma unroll
                    for (int j = 0; j < 8; ++j) vreg[3][j] = *(const v4u*)(kvbase + ro[j] + 128u); }
                asm volatile("s_waitcnt lgkmcnt(0)" ::: "memory");
#pragma unroll
                for (int s2l = 0; s2l < 2; ++s2l) {
#pragma unroll
                    for (int dt = 0; dt < 4; ++dt) { const unsigned a0 = tbase + s2l * 4096 + ((dt ^ tsw) << 5);
                        const s16x4v lo = __builtin_bit_cast(s16x4v, __builtin_amdgcn_ds_read_tr16_b64_v4i16((LAS s16x4v*)(lds + a0)));
                        const s16x4v hi = __builtin_bit_cast(s16x4v, __builtin_amdgcn_ds_read_tr16_b64_v4i16((LAS s16x4v*)(lds + a0 + 2048)));
                        const pg8::bf16x8 vf = __builtin_shufflevector(lo, hi, 0, 1, 2, 3, 4, 5, 6, 7);
                        o[dt] = __builtin_amdgcn_mfma_f32_16x16x32_bf16(vf, pf[2 * g + s2l], o[dt], 0, 0, 0); }
                    osum = __builtin_amdgcn_mfma_f32_16x16x32_bf16(ones, pf[2 * g + s2l], osum, 0, 0, 0);
                }
            }
#undef DS_ROFF
            const float rinv = 1.f / osum[0];
            bf16* op = AO + (tokb + p) * DM + fr * 64 + 4 * fq;
#pragma unroll
            for (int dt = 0; dt < 4; ++dt) { u32x2v w; w.x = pg8::cvt_pk_bf16(o[dt][0] * rinv, o[dt][1] * rinv); w.y = pg8::cvt_pk_bf16(o[dt][2] * rinv, o[dt][3] * rinv); *(u32x2v*)(op + 16 * dt) = w; }
        }
        asm volatile("s_waitcnt vmcnt(0) lgkmcnt(0)" ::: "memory");
        __syncthreads();
    }
}

struct Args { const float* in[21]; float* out; unsigned char* ws; RopeInv rinv; int ph_lo, ph_hi, dsa_mask, pad; };
static_assert(sizeof(Args) == 21 * 8 + 8 + 8 + 128 + 16, "Args has no padding");

__global__ void __launch_bounds__(NTHREADS, 2) mk_fwd(Args args) {
    extern __shared__ __attribute__((aligned(16))) unsigned char lds_raw[];
    LAS unsigned char* lds = (LAS unsigned char*)lds_raw;
    const int tid = threadIdx.x, lane = tid & 63, wave = __builtin_amdgcn_readfirstlane(tid >> 6);
    const int G = gridDim.x, bx = blockIdx.x;
    const int vcu = (G % 8 == 0) ? (bx % 8) * (G / 8) + bx / 8 : bx;
    unsigned char* ws = args.ws;
    volatile LAS unsigned* MISC = (volatile LAS unsigned*)(lds + MISC_OFF);
    if (tid < 64) MISC[tid] = 0u;
    __syncthreads();
    const int lo = args.ph_lo, hi = args.ph_hi;
    XcdBarrier bar; bar.bar = (unsigned*)(ws + WS_CTL) + CW_BAR; bar.x = 0; bar.st = nullptr;
    if (hi - lo > 1) bar = xcd_barrier_post((unsigned*)(ws + WS_CTL) + CW_BAR, MISC + 8);
#define IN(k) (lo <= (k) && (k) < hi)
#define SEAM(k) do { if (IN(k) && IN((k) + 1)) xcd_barrier(bar); } while (0)
    const float* mod = (const float*)(ws + WS_MOD);
    bf16* H = (bf16*)(ws + WS_H);
    const float* x_in = args.in[0]; float* xo = args.out;
    bf16* XR = (bf16*)(ws + WS_XR);

    if (IN(0)) { phase_prep<0>(args.in, ws, lds, args.rinv, tid, lane, wave, bx, G); } SEAM(0);
    if (IN(1)) { phase_norm<false>(x_in, args.in[2], mod + 0 * DM, mod + 1 * DM, H, lane, wave, vcu, G); phase_prep<1>(args.in, ws, lds, args.rinv, tid, lane, wave, bx, G); } SEAM(1);
    if (IN(2)) { pg8::Gemm g{H, (const bf16*)(ws + WS_WAIN), MTOK, 2 * DRNN, DM}; pg8::StaticOrder S; S.init(MTOK, 2 * DRNN, G, bx);
        pg8::EpiXbGate E{(bf16*)(ws + WS_XB), (bf16*)(ws + WS_GATE)};
        pg8::gemm_phase<pg8::EpiXbGate, pg8::StaticOrder, true, true>(lds, g, S, E); } SEAM(2);
    if (IN(3)) { if (bx < 160) phase_rglru(args.in, ws, lds, tid, lane, wave, bx); else phase_prep<2>(args.in, ws, lds, args.rinv, tid, lane, wave, bx - 160, G - 160); } SEAM(3);
    if (IN(4)) { pg8::Gemm g{(const bf16*)(ws + WS_Y), (const bf16*)(ws + WS_WAOUT), MTOK, DM, DRNN}; pg8::StaticOrder S; S.init(MTOK, DM, G, bx);
        pg8::EpiRes<false, true> E{x_in, XR, mod + 2 * DM};
        pg8::gemm_phase<pg8::EpiRes<false, true>, pg8::StaticOrder, true, true>(lds, g, S, E); } SEAM(4);
    if (IN(5)) { phase_norm<true>(XR, args.in[3], mod + 3 * DM, mod + 4 * DM, H, lane, wave, vcu, G); } SEAM(5);
    if (IN(6)) { pg8::Gemm g{H, (const bf16*)(ws + WS_W1), MTOK, DFF, DM}; pg8::StaticOrder S; S.init(MTOK, DFF, G, bx);
        pg8::EpiRelu2 E{(bf16*)(ws + WS_BIG)};
        pg8::gemm_phase<pg8::EpiRelu2, pg8::StaticOrder, true, true>(lds, g, S, E); } SEAM(6);
    if (IN(7)) { pg8::Gemm g{(const bf16*)(ws + WS_BIG), (const bf16*)(ws + WS_W2), MTOK, DM, DFF, 1, 1}; pg8::StaticOrder S; S.init(MTOK, DM, G, bx);
        pg8::EpiRes<true, true> E{XR, XR, mod + 5 * DM};
        pg8::gemm_phase<pg8::EpiRes<true, true>, pg8::StaticOrder, true, true>(lds, g, S, E); } SEAM(7);
    const float* mod1 = mod + NB * NMOD;
    if (IN(8)) { phase_norm<true>(XR, args.in[2] + DM, mod1 + 0 * DM, mod1 + 1 * DM, H, lane, wave, vcu, G); } SEAM(8);
    if (IN(9)) { pg8::Gemm g{H, (const bf16*)(ws + WS_WBIN), MTOK, BINP, DM}; pg8::StaticOrder S; S.init(MTOK, BINP, G, bx);
        pg8::EpiIn1 E{(bf16*)(ws + WS_Q), (bf16*)(ws + WS_QI), (bf16*)(ws + WS_KV), (bf16*)(ws + WS_KV) + 64, (bf16*)(ws + WS_KI), (float*)(ws + WS_WI), (const float*)(ws + WS_ROPE), args.in[16], args.in[17]};
        pg8::gemm_phase<pg8::EpiIn1, pg8::StaticOrder, true, true>(lds, g, S, E); } SEAM(9);
    if (IN(10)) { phase_dsa(ws, lds, tid, lane, wave, bx, G, args.dsa_mask); } SEAM(10);
    if (IN(11)) { pg8::Gemm g{(const bf16*)(ws + WS_AO), (const bf16*)(ws + WS_WBOUT), MTOK, DM, DM}; pg8::StaticOrder S; S.init(MTOK, DM, G, bx);
        pg8::EpiRes<true, true> E{XR, XR, mod1 + 2 * DM};
        pg8::gemm_phase<pg8::EpiRes<true, true>, pg8::StaticOrder, true, true>(lds, g, S, E); } SEAM(11);
    if (IN(12)) { phase_norm<true>(XR, args.in[3] + DM, mod1 + 3 * DM, mod1 + 4 * DM, H, lane, wave, vcu, G); } SEAM(12);
    if (IN(13)) { pg8::Gemm g{H, (const bf16*)(ws + WS_W1) + (size_t)DFF * DM, MTOK, DFF, DM}; pg8::StaticOrder S; S.init(MTOK, DFF, G, bx);
        pg8::EpiRelu2 E{(bf16*)(ws + WS_BIG)};
        pg8::gemm_phase<pg8::EpiRelu2, pg8::StaticOrder, true, true>(lds, g, S, E); } SEAM(13);
    if (IN(14)) { pg8::Gemm g{(const bf16*)(ws + WS_BIG), (const bf16*)(ws + WS_W2) + (size_t)DM * DFF, MTOK, DM, DFF, 1, 1}; pg8::StaticOrder S; S.init(MTOK, DM, G, bx);
        pg8::EpiRes<true, false> E{XR, xo, mod1 + 5 * DM};
        pg8::gemm_phase<pg8::EpiRes<true, false>, pg8::StaticOrder, true, true>(lds, g, S, E); }
#undef IN
#undef SEAM
}

extern "C" void kernel_launch(void* const* d_in, const int* in_sizes, int n_in, void* d_out, int out_size, void* d_ws, size_t ws_size, hipStream_t stream) {
    static int grid = 0;
    if (grid == 0) {
        if (n_in != 21 || in_sizes[0] != MTOK * DM || out_size != MTOK * DM || ws_size < WS_END) {
            fprintf(stderr, "kernel_launch: unexpected shapes: n_in %d in0 %d out %d ws %zu (need >= %zu); nothing launched\n", n_in, n_in > 0 ? in_sizes[0] : -1, out_size, ws_size, (size_t)WS_END); grid = -1; return; }
        int dev = 0, cus = 0, per_cu = 0;
        if (hipGetDevice(&dev) != hipSuccess || hipDeviceGetAttribute(&cus, hipDeviceAttributeMultiprocessorCount, dev) != hipSuccess) { fprintf(stderr, "kernel_launch: device query failed\n"); grid = -1; return; }
        if (hipFuncSetAttribute((const void*)mk_fwd, hipFuncAttributeMaxDynamicSharedMemorySize, LDS_BYTES) != hipSuccess) { fprintf(stderr, "kernel_launch: hipFuncSetAttribute(%d B LDS) failed\n", LDS_BYTES); grid = -1; return; }
        if (hipOccupancyMaxActiveBlocksPerMultiprocessor(&per_cu, (const void*)mk_fwd, NTHREADS, LDS_BYTES) != hipSuccess || per_cu < 1)
            fprintf(stderr, "kernel_launch: note: occupancy query reports %d workgroups per CU\n", per_cu);
        (void)hipGetLastError();
        grid = cus;
    }
    if (grid < 0) return;
    if (hipMemsetAsync((char*)d_ws + WS_CTL, 0, CTL_ZERO_BYTES, stream) != hipSuccess) { fprintf(stderr, "kernel_launch: memset failed\n"); return; }
    Args a{};
    for (int i = 0; i < 21; ++i) a.in[i] = (const float*)d_in[i];
    a.out = (float*)d_out; a.ws = (unsigned char*)d_ws; a.dsa_mask = 7;
    for (int i = 0; i < 32; ++i) a.rinv.v[i] = powf(10000.0f, -(float)(2 * i) / 64.0f);
    for (int li = 0; li < N_LAUNCHES; ++li) {
        if (N_LAUNCHES == 1) { a.ph_lo = 0; a.ph_hi = N_PHASES; } else { a.ph_lo = li; a.ph_hi = li + 1; }
        const int reps = (N_LAUNCHES != 1 && li == PROBE_PH) ? PROBE_N : 1;
        for (int r = 0; r < reps; ++r) {
            a.dsa_mask = (r + 1 < reps) ? PROBE_MASK : 7;
            hipLaunchKernelGGL(mk_fwd, dim3(grid), dim3(NTHREADS), LDS_BYTES, stream, a);
            const hipError_t le = hipPeekAtLastError();
            if (le != hipSuccess) { fprintf(stderr, "kernel_launch: launch %d failed: %s\n", li, hipGetErrorName(le)); break; }
        }
    }
}
```

```cpp
#include <hip/hip_runtime.h>
#include <cstdio>
#include <cstdint>
#include <cmath>
#define MK_N_LAUNCHES 1
#define PROBE_PH -1
#define PROBE_N 1
#define PROBE_MASK 7
namespace pg8 {
#define PG8_LAS __attribute__((address_space(3)))
typedef unsigned short bf16_t;
typedef short bf16x8 __attribute__((ext_vector_type(8)));
typedef float f32x4 __attribute__((ext_vector_type(4)));
typedef unsigned u32x4 __attribute__((ext_vector_type(4)));
constexpr int BM = 256, BK = 64, HALF = 128, HTB = HALF * BK * 2  , STAGE_BYTES = 8 * HTB, NXCD = 8, WGM = 8;

__host__ __device__ __forceinline__ int lds_byte(int r, int c) { const int st = (r >> 4) * 2 + (c >> 5), rr = r & 15, cc = c & 31, ob = rr * 64 + cc * 2; return st * 1024 + (ob ^ (((ob >> 9) & 1) << 5)); }
__host__ __device__ __forceinline__ void stage_rc(int b, int& R, int& C) { const int st = b / 1024, sb = b % 1024, swz = sb ^ (((sb >> 9) & 1) << 5); R = (st >> 1) * 16 + swz / 64; C = (st & 1) * 32 + (swz % 64) / 2; }
__host__ __device__ __forceinline__ int perm32(int rho) { const int n = rho >> 4, i = rho & 15; return 8 * (i >> 2) + 4 * n + (i & 3); }

struct Unit { int pm, pn; };
struct Gemm { const bf16_t* A; const bf16_t* Bt; int M, N, K; int tiledA, tiledB; };

struct StaticOrder {
    int nM, nN, nwg, G, c;
    __host__ __device__ void init(int M, int N, int G_, int c_) { nM = M / BM; nN = N / BM; nwg = nM * nN; G = G_; c = c_; }
    __host__ __device__ bool next(int i, Unit& u) const {
        const long L = (long)i * G + c; if (L >= nwg) return false;
        int wgid = (int)L; { const int q = nwg / NXCD, r = nwg % NXCD, xcd = wgid % NXCD, off = wgid / NXCD; wgid = (xcd < r ? xcd * (q + 1) : r * (q + 1) + (xcd - r) * q) + off; }
        const int nig = WGM * nN, gid = wgid / nig, fm = gid * WGM, gsz = (nM - fm) < WGM ? (nM - fm) : WGM;
        u.pm = fm + ((wgid % nig) % gsz); u.pn = (wgid % nig) / gsz; return true;
    }
    __device__ __forceinline__ void a_ready(const Unit&) const {}
    __device__ __forceinline__ void done(const Unit&) const {}
};

__device__ __forceinline__ unsigned cvt_pk_bf16(float lo, float hi) { unsigned r; asm volatile("v_cvt_pk_bf16_f32 %0, %1, %2" : "=v"(r) : "v"(lo), "v"(hi)); return r; }
typedef float f32x2 __attribute__((ext_vector_type(2)));
template <class Epi, class Sched, bool ALIGN_EPI = false, bool SP2 = false>
__device__ __forceinline__ void gemm_phase(PG8_LAS unsigned char* lds, const Gemm g, const Sched& S, const Epi& E) {
    const int tid = threadIdx.x, wid = __builtin_amdgcn_readfirstlane(tid >> 6), lane = tid & 63, wr = wid >> 2, wc = wid & 3, fr = lane & 15, fq = lane >> 4;
    const int K = g.K, nt = K / BK;
    constexpr int NVM = ALIGN_EPI ? Epi::NVM : 0;
    unsigned voffA[2], voffB[2];
#pragma unroll
    for (int i = 0; i < 2; ++i) { int R, C; stage_rc(tid * 16 + i * 8192, R, C); const int Rb = Epi::PERM ? ((R & ~31) + perm32(R & 31)) : R;
        voffA[i] = (unsigned)(R * (g.tiledA ? BK : K) + C) * 2u; voffB[i] = (unsigned)(Rb * (g.tiledB ? BK : K) + C) * 2u; }
    const size_t kstepA = g.tiledA ? (size_t)BM * BK * 2 : (size_t)(BK * 2), hstepA = g.tiledA ? (size_t)HALF * BK * 2 : (size_t)HALF * K * 2, tstepA = (size_t)BM * K * 2;
    const size_t kstepB = g.tiledB ? (size_t)BM * BK * 2 : (size_t)(BK * 2), hstepB = g.tiledB ? (size_t)HALF * BK * 2 : (size_t)HALF * K * 2, tstepB = (size_t)BM * K * 2;
    const unsigned ldsw = (unsigned)wid * 1024u;
    const int aoff = lds_byte(wr * 64 + fr, fq * 8), boff = lds_byte(wc * 32 + fr, fq * 8);
#define PG8_SA(b, h) (((b) * 2 + (h)) * HTB)
#define PG8_SB(b, h) ((4 + (b) * 2 + (h)) * HTB)
#define PG8_STAGE(bufoff, gbase, voff) do { const char* gb_ = (const char*)(gbase); asm volatile("" : "+s"(gb_));     \
        _Pragma("unroll") for (int _i = 0; _i < 2; ++_i) \
        __builtin_amdgcn_global_load_lds((const unsigned*)(gb_ + (voff)[_i]), (PG8_LAS unsigned*)(lds + (bufoff) + ldsw + _i * 8192), 16, 0, 0); } while (0)
#define PG8_LDA(dst, b, h) do { _Pragma("unroll") for (int m = 0; m < 4; ++m) _Pragma("unroll") for (int k = 0; k < 2; ++k) dst[m][k] = *(const PG8_LAS bf16x8*)(lds + PG8_SA(b, h) + aoff + m * 2048 + k * 1024); } while (0)
#define PG8_LDB(dst, b, h) do { _Pragma("unroll") for (int n = 0; n < 2; ++n) _Pragma("unroll") for (int k = 0; k < 2; ++k) dst[n][k] = *(const PG8_LAS bf16x8*)(lds + PG8_SB(b, h) + boff + n * 2048 + k * 1024); } while (0)
#define PG8_MMA(ai, bj, At, Bt) do { __builtin_amdgcn_s_setprio(1); _Pragma("unroll") for (int m = 0; m < 4; ++m) _Pragma("unroll") for (int n = 0; n < 2; ++n) _Pragma("unroll") for (int k = 0; k < 2; ++k) \
        acc[ai][bj][m][n] = __builtin_amdgcn_mfma_f32_16x16x32_bf16(Bt[n][k], At[m][k], acc[ai][bj][m][n], 0, 0, 0); __builtin_amdgcn_s_setprio(0); } while (0)
#define PG8_MMA0(ai, bj, At, Bt) do { __builtin_amdgcn_s_setprio(1); _Pragma("unroll") for (int m = 0; m < 4; ++m) _Pragma("unroll") for (int n = 0; n < 2; ++n) \
        acc[ai][bj][m][n] = __builtin_amdgcn_mfma_f32_16x16x32_bf16(Bt[n][0], At[m][0], (f32x4){0.f, 0.f, 0.f, 0.f}, 0, 0, 0); \
        _Pragma("unroll") for (int m = 0; m < 4; ++m) _Pragma("unroll") for (int n = 0; n < 2; ++n) \
        acc[ai][bj][m][n] = __builtin_amdgcn_mfma_f32_16x16x32_bf16(Bt[n][1], At[m][1], acc[ai][bj][m][n], 0, 0, 0); __builtin_amdgcn_s_setprio(0); } while (0)
#define PG8_WAIT_V(n) asm volatile("s_waitcnt vmcnt(" #n ")" ::: "memory")
#define PG8_WAIT_VN(n) asm volatile("s_waitcnt vmcnt(%0)" :: "n"(n) : "memory")
#define PG8_WAIT_L(n) asm volatile("s_waitcnt lgkmcnt(" #n ")" ::: "memory")
#define PG8_BAR __builtin_amdgcn_s_barrier()
#define PG8_SCHED __builtin_amdgcn_sched_barrier(0)
    Unit cur, nxt; int ui = 0;
    if (!S.next(0, cur)) return;
    f32x4 acc[2][2][4][2];
    bf16x8 At[4][2], B0[2][2], B1[2][2];
    const char* cA = (const char*)g.A + (size_t)cur.pm * tstepA; const char* cB = (const char*)g.Bt + (size_t)cur.pn * tstepB;
    S.a_ready(cur);
    static_assert(SP2 && ALIGN_EPI, "only the two-super-phase loop with aligned epilogues is kept");
    PG8_STAGE(PG8_SB(0, 0), cB, voffB); PG8_STAGE(PG8_SB(0, 1), cB + hstepB, voffB); PG8_STAGE(PG8_SA(0, 0), cA, voffA); PG8_STAGE(PG8_SA(0, 1), cA + hstepA, voffA);
    PG8_STAGE(PG8_SB(1, 0), cB + kstepB, voffB); PG8_STAGE(PG8_SA(1, 0), cA + kstepA, voffA); PG8_STAGE(PG8_SB(1, 1), cB + hstepB + kstepB, voffB); PG8_STAGE(PG8_SA(1, 1), cA + hstepA + kstepA, voffA);
    if (wr == 1) PG8_BAR;
    PG8_WAIT_V(0); PG8_BAR;
    PG8_BAR;
    for (;;) {
        const bool has_next = S.next(ui + 1, nxt);
        const char* nA = has_next ? (const char*)g.A + (size_t)nxt.pm * tstepA : cA; const char* nB = has_next ? (const char*)g.Bt + (size_t)nxt.pn * tstepB : cB;
        {   const char* a2 = cA + (size_t)2 * kstepA; const char* b2 = cB + (size_t)2 * kstepB; const char* a3 = a2 + kstepA; const char* b3 = b2 + kstepB;
            PG8_LDB(B0, 0, 0); PG8_LDB(B1, 0, 1); PG8_SCHED; PG8_LDA(At, 0, 0);
            PG8_WAIT_VN(8 + NVM); PG8_WAIT_L(0); PG8_BAR; PG8_MMA0(0, 0, At, B0); PG8_MMA0(0, 1, At, B1); PG8_BAR; PG8_SCHED;
            PG8_LDA(At, 0, 1); PG8_STAGE(PG8_SB(0, 0), b2, voffB); PG8_STAGE(PG8_SB(0, 1), b2 + hstepB, voffB); PG8_STAGE(PG8_SA(0, 0), a2, voffA);
            PG8_WAIT_VN(8 + NVM); PG8_WAIT_L(0); PG8_BAR; PG8_MMA0(1, 0, At, B0); PG8_MMA0(1, 1, At, B1); PG8_BAR; PG8_SCHED;
            PG8_LDB(B0, 1, 0); PG8_LDB(B1, 1, 1); PG8_SCHED; PG8_LDA(At, 1, 0); PG8_STAGE(PG8_SA(0, 1), a2 + hstepA, voffA);
            PG8_WAIT_VN(8 + NVM); PG8_WAIT_L(0); PG8_BAR; PG8_MMA(0, 0, At, B0); PG8_MMA(0, 1, At, B1); PG8_BAR; PG8_SCHED;
            PG8_LDA(At, 1, 1); PG8_STAGE(PG8_SB(1, 0), b3, voffB); PG8_STAGE(PG8_SB(1, 1), b3 + hstepB, voffB); PG8_STAGE(PG8_SA(1, 0), a3, voffA);
            PG8_WAIT_V(8); PG8_WAIT_L(0); PG8_BAR; PG8_MMA(1, 0, At, B0); PG8_MMA(1, 1, At, B1); PG8_BAR; PG8_SCHED;
        }
        for (int t = 2; t < nt; t += 2) {
            const bool last = (t == nt - 2);
            const char* a1 = cA + (size_t)(t + 1) * kstepA;
            const char* a2 = last ? nA : cA + (size_t)(t + 2) * kstepA; const char* b2 = last ? nB : cB + (size_t)(t + 2) * kstepB;
            const char* a3 = a2 + kstepA; const char* b3 = b2 + kstepB;
            if (last && has_next) S.a_ready(nxt);
            if constexpr (SP2) {
            PG8_LDB(B0, 0, 0); PG8_LDB(B1, 0, 1); PG8_SCHED; PG8_LDA(At, 0, 0); PG8_STAGE(PG8_SA(1, 1), a1 + hstepA, voffA);
            PG8_WAIT_V(8); PG8_WAIT_L(0); PG8_BAR; PG8_MMA(0, 0, At, B0); PG8_MMA(0, 1, At, B1); PG8_BAR; PG8_SCHED;
            PG8_LDA(At, 0, 1); PG8_STAGE(PG8_SB(0, 0), b2, voffB); PG8_STAGE(PG8_SB(0, 1), b2 + hstepB, voffB); PG8_STAGE(PG8_SA(0, 0), a2, voffA);
            PG8_WAIT_V(8); PG8_WAIT_L(0); PG8_BAR; PG8_MMA(1, 0, At, B0); PG8_MMA(1, 1, At, B1); PG8_BAR; PG8_SCHED;
            PG8_LDB(B0, 1, 0); PG8_LDB(B1, 1, 1); PG8_SCHED; PG8_LDA(At, 1, 0); PG8_STAGE(PG8_SA(0, 1), a2 + hstepA, voffA);
            PG8_WAIT_V(8); PG8_WAIT_L(0); PG8_BAR; PG8_MMA(0, 0, At, B0); PG8_MMA(0, 1, At, B1); PG8_BAR; PG8_SCHED;
            PG8_LDA(At, 1, 1); PG8_STAGE(PG8_SB(1, 0), b3, voffB); PG8_STAGE(PG8_SB(1, 1), b3 + hstepB, voffB); PG8_STAGE(PG8_SA(1, 0), a3, voffA);
            PG8_WAIT_V(8); PG8_WAIT_L(0); PG8_BAR; PG8_MMA(1, 0, At, B0); PG8_MMA(1, 1, At, B1); PG8_BAR; PG8_SCHED;
            } else {
            PG8_LDB(B0, 0, 0); PG8_SCHED; PG8_LDA(At, 0, 0); PG8_STAGE(PG8_SA(1, 1), a1 + hstepA, voffA);
            PG8_WAIT_L(8); PG8_BAR; PG8_WAIT_L(0); PG8_MMA(0, 0, At, B0); PG8_BAR; PG8_SCHED;
            PG8_LDB(B1, 0, 1); PG8_STAGE(PG8_SB(0, 0), b2, voffB);
            PG8_BAR; PG8_WAIT_L(0); PG8_MMA(0, 1, At, B1); PG8_BAR;
            PG8_LDA(At, 0, 1); PG8_STAGE(PG8_SA(0, 0), a2, voffA);
            PG8_BAR; PG8_WAIT_L(0); PG8_MMA(1, 0, At, B0); PG8_BAR; PG8_SCHED;
            PG8_STAGE(PG8_SB(0, 1), b2 + hstepB, voffB);
            PG8_WAIT_V(6); PG8_BAR; PG8_MMA(1, 1, At, B1); PG8_BAR;
            PG8_LDB(B0, 1, 0); PG8_SCHED; PG8_LDA(At, 1, 0); PG8_STAGE(PG8_SA(0, 1), a2 + hstepA, voffA);
            PG8_WAIT_L(8); PG8_BAR; PG8_WAIT_L(0); PG8_MMA(0, 0, At, B0); PG8_BAR; PG8_SCHED;
            PG8_LDB(B1, 1, 1); PG8_STAGE(PG8_SB(1, 0), b3, voffB);
            PG8_BAR; PG8_WAIT_L(0); PG8_MMA(0, 1, At, B1); PG8_BAR;
            PG8_LDA(At, 1, 1); PG8_STAGE(PG8_SA(1, 0), a3, voffA);
            PG8_BAR; PG8_WAIT_L(0); PG8_MMA(1, 0, At, B0); PG8_BAR; PG8_SCHED;
            PG8_STAGE(PG8_SB(1, 1), b3 + hstepB, voffB);
            PG8_WAIT_V(6); PG8_BAR; PG8_MMA(1, 1, At, B1); PG8_BAR;
            }
        }
        if constexpr (ALIGN_EPI) { if (wr == 0) PG8_BAR; }
        PG8_STAGE(PG8_SA(1, 1), nA + kstepA + hstepA, voffA); PG8_SCHED;
        if constexpr (!Epi::AFTER_DRAIN) { int fr_ = fr, fq_ = fq; asm volatile("" : "+v"(fr_), "+v"(fq_));
            E(acc, cur, wr, wc, fr_, fq_); S.done(cur); }
        if (!has_next) break;
        cur = nxt; cA = nA; cB = nB; ++ui;
        if constexpr (ALIGN_EPI) { if (wr == 1) PG8_BAR; }
    }
    PG8_WAIT_V(0);
    if constexpr (!ALIGN_EPI) { if (wr == 0) PG8_BAR; }
    PG8_BAR;
    if constexpr (Epi::AFTER_DRAIN) { E.fused(acc, cur, wr, wc, fr, fq, lds, wid, lane); S.done(cur); }
#undef PG8_SA
#undef PG8_SB
#undef PG8_STAGE
#undef PG8_LDA
#undef PG8_LDB
#undef PG8_MMA
#undef PG8_MMA0
#undef PG8_WAIT_V
#undef PG8_WAIT_VN
#undef PG8_WAIT_L
#undef PG8_BAR
#undef PG8_SCHED
}
}
#define GAS __attribute__((address_space(1)))
#define LAS __attribute__((address_space(3)))
typedef unsigned short bf16;
typedef unsigned v4u __attribute__((ext_vector_type(4)));
typedef float f32x4 __attribute__((ext_vector_type(4)));
typedef short bf16x8 __attribute__((ext_vector_type(8)));
typedef GAS unsigned gu32;
typedef GAS unsigned long long gu64;
#define RLX_AGENT __ATOMIC_RELAXED, __HIP_MEMORY_SCOPE_AGENT
#define LDS_WAIT() asm volatile("s_waitcnt lgkmcnt(0)" ::: "memory")
#define VM_WAIT() asm volatile("s_waitcnt vmcnt(0)" ::: "memory")
__device__ __forceinline__ unsigned long long rt() { return __builtin_amdgcn_s_memrealtime(); }
__device__ __forceinline__ unsigned f2bf(float f) { unsigned u = __builtin_bit_cast(unsigned, f); return (u + 0x7fffu + ((u >> 16) & 1u)) >> 16; }
__device__ __forceinline__ unsigned pk2(float lo, float hi) { return f2bf(lo) | (f2bf(hi) << 16); }

#define XB_TMO      128
#define XB_XCNT(j)  (256  + 64 * (j))
#define XB_XSUB(j)  (1280 + 64 * (j))
#define XB_XGEN(j)  (2304 + 64 * (j))
#define XB_TOP      3328
#define XB_TOPGEN   3392
#define XCD_BAR_WORDS 3456
#define XB_SPIN_CAP (1u << 18)

__device__ __forceinline__ unsigned xb_ld(unsigned* p)              { return __hip_atomic_load(p, __ATOMIC_RELAXED, __HIP_MEMORY_SCOPE_AGENT); }
__device__ __forceinline__ unsigned xb_add(unsigned* p, unsigned v) { return __hip_atomic_fetch_add(p, v, __ATOMIC_RELAXED, __HIP_MEMORY_SCOPE_AGENT); }
__device__ __forceinline__ unsigned xb_xcc_id() { return (unsigned)__builtin_amdgcn_s_getreg((3 << 11) | 20) & 0xFu; }
#define XB_SPIN(cond, bar) do { unsigned _sp = 0; while (cond) { __builtin_amdgcn_s_sleep(1); \
    if ((++_sp & 255u) == 0u) { if (xb_ld(&(bar)[XB_TMO])) break; if (_sp > XB_SPIN_CAP) { atomicAdd(&(bar)[XB_TMO], 1u); break; } } } } while (0)

struct XcdBarrier {
    unsigned* bar; unsigned x;
    volatile LAS unsigned* st;
};

__device__ __forceinline__ XcdBarrier xcd_barrier_post(unsigned* bar, volatile LAS unsigned* st) {
    XcdBarrier b; b.bar = bar; b.x = xb_xcc_id(); b.st = st;
    if (threadIdx.x == 0) (void)xb_add(&bar[XB_XCNT(b.x)], 1u);
    return b;
}
__device__ __forceinline__ void xcd_barrier_complete(unsigned* bar, unsigned x, unsigned& nloc, unsigned& nx) {
    const unsigned G = gridDim.x * gridDim.y * gridDim.z;
    unsigned sum, cnt, mine, sp = 0u;
    for (;;) {
        sum = 0u; cnt = 0u; mine = 0u;
#pragma unroll
        for (unsigned j = 0; j < 16; ++j) { const unsigned c = xb_ld(&bar[XB_XCNT(j)]); sum += c; cnt += (c > 0u) ? 1u : 0u; mine = (j == x) ? c : mine; }
        if (sum == G) break;
        __builtin_amdgcn_s_sleep(1);
        if ((++sp & 255u) == 0u) { if (xb_ld(&bar[XB_TMO])) break; if (sp > XB_SPIN_CAP) { atomicAdd(&bar[XB_TMO], 1u); break; } }
    }
    nloc = mine > 0u ? mine : 1u; nx = cnt > 0u ? cnt : 1u;
}

__device__ __forceinline__ void xcd_barrier(const XcdBarrier& b) {
    asm volatile("s_waitcnt vmcnt(0)" ::: "memory");
    __syncthreads();
    if (threadIdx.x == 0) {
        unsigned* bar = b.bar;
        __builtin_amdgcn_s_waitcnt(0);
        unsigned nloc = b.st[0], nx = b.st[1];
        if (nloc == 0u) { xcd_barrier_complete(bar, b.x, nloc, nx); b.st[0] = nloc; b.st[1] = nx; }
        const unsigned old = xb_add(&bar[XB_XSUB(b.x)], 1u);
        const unsigned gen = old / nloc;
        if (old + 1u == (gen + 1u) * nloc) {
            __builtin_amdgcn_fence(__ATOMIC_RELEASE, "agent");
            asm volatile("s_waitcnt vmcnt(0)" ::: "memory");
            const unsigned og = xb_add(&bar[XB_TOP], 1u);
            const unsigned tg = og / nx;
            if (og + 1u == (tg + 1u) * nx) xb_add(&bar[XB_TOPGEN], 1u);
            else XB_SPIN(xb_ld(&bar[XB_TOPGEN]) == tg, bar);
            __builtin_amdgcn_fence(__ATOMIC_ACQUIRE, "agent");
            xb_add(&bar[XB_XGEN(b.x)], 1u);
            asm volatile("s_waitcnt vmcnt(0)" ::: "memory");
        } else {
            XB_SPIN(xb_ld(&bar[XB_XGEN(b.x)]) == gen, bar);
            __builtin_amdgcn_fence(__ATOMIC_ACQUIRE, "agent");
            asm volatile("s_waitcnt vmcnt(0)" ::: "memory");
        }
    }
    __syncthreads();
}

constexpr int NB = 8, SEQ = 4096, DM = 1024, MTOK = NB * SEQ, DFF = 4096, DRNN = 1280, NLB = 5, LBLK = 256;
constexpr int NHEAD = 16, HD = 64, IH = 8, TOPK = 256, BIN = 1736, BINP = 1792, NMOD = 6 * DM;
constexpr float RMS_EPS = 1e-6f;
constexpr int NWAVES = 8, NTHREADS = 512;
constexpr int N_PHASES = 15;
constexpr int N_LAUNCHES = MK_N_LAUNCHES;

constexpr size_t MiB = 1u << 20;
constexpr size_t WS_CTL = 0, CTL_ZERO_BYTES = 64 * 1024;
constexpr int CW_BAR = 4096;
constexpr size_t WS_MOD = 1 * MiB;
constexpr size_t WS_ROPE = 2 * MiB;
constexpr size_t WS_WAIN = 4 * MiB;
constexpr size_t WS_WAOUT = 9 * MiB;
constexpr size_t WS_WGATE = 12 * MiB;
constexpr size_t WS_WBIN = 14 * MiB;
constexpr size_t WS_WBOUT = 18 * MiB;
constexpr size_t WS_W1 = 20 * MiB;
constexpr size_t WS_W2 = 36 * MiB;
constexpr size_t WS_H = 64 * MiB;
constexpr size_t WS_BIG = 128 * MiB;
constexpr size_t WS_XB = WS_BIG, WS_GATE = WS_BIG + 80 * MiB, WS_Y = WS_BIG + 160 * MiB;
constexpr size_t WS_Q = WS_BIG, WS_QI = WS_BIG + 64 * MiB, WS_KV = WS_BIG + 96 * MiB  , WS_KI = WS_BIG + 104 * MiB, WS_WI = WS_BIG + 108 * MiB, WS_AO = WS_BIG + 112 * MiB;
constexpr size_t WS_XR = 384 * MiB;
constexpr size_t WS_END = 448 * MiB;

constexpr int LDS_BYTES = 163840;
constexpr int MISC_OFF = LDS_BYTES - 256;

typedef float f32x2v __attribute__((ext_vector_type(2)));
typedef __bf16 bf16x2_t __attribute__((ext_vector_type(2)));
__device__ __forceinline__ unsigned cvtpk(float lo, float hi) { const f32x2v v = {lo, hi}; return __builtin_bit_cast(unsigned, __builtin_convertvector(v, bf16x2_t)); }
#define pk2 cvtpk
typedef unsigned u32x2v __attribute__((ext_vector_type(2)));
typedef short s16x4v __attribute__((ext_vector_type(4)));

__device__ __forceinline__ float wave_sum(float v) {
#pragma unroll
    for (int o = 1; o < 64; o <<= 1) v += __shfl_xor(v, o);
    return v;
}
__device__ __forceinline__ float bf2f(unsigned short h) { return __builtin_bit_cast(float, (unsigned)h << 16); }
__device__ __forceinline__ float bflo(unsigned w) { return __builtin_bit_cast(float, w << 16); }
__device__ __forceinline__ float bfhi(unsigned w) { return __builtin_bit_cast(float, w & 0xffff0000u); }
__device__ __forceinline__ float sigmoidf_(float x) { return __builtin_amdgcn_rcpf(1.f + __builtin_amdgcn_exp2f(-1.4426950408889634f * x)); }

namespace pg8 {
__device__ __forceinline__ f32x2 gelu_tanh2(f32x2 x) {
    f32x2 u = (x * ((x * x) * 0.044715f + 1.0f)) * -2.302208198f;
    u.x = __builtin_amdgcn_exp2f(u.x); u.y = __builtin_amdgcn_exp2f(u.y); u = u + 1.0f;
    f32x2 r; r.x = __builtin_amdgcn_rcpf(u.x); r.y = __builtin_amdgcn_rcpf(u.y); return x * r;
}
struct EpiXbGate {
    static constexpr bool PERM = true, AFTER_DRAIN = false; static constexpr int NVM = 16;
    bf16_t* XB; bf16_t* GT;
    __device__ __forceinline__ void operator()(const f32x4 (&acc)[2][2][4][2], const Unit& u, int wr, int wc, int fr, int fq) const {
        const bool isg = u.pn >= 5;
        char* ub = (char*)(isg ? GT : XB) + ((size_t)u.pm * BM * DRNN + (size_t)(isg ? u.pn - 5 : u.pn) * BM) * 2;
        unsigned lo = (unsigned)(((wr * 64 + fr) * DRNN + wc * 32 + 8 * fq) * 2); asm volatile("" : "+v"(lo));
#pragma unroll
        for (int ai = 0; ai < 2; ++ai)
#pragma unroll
            for (int m = 0; m < 4; ++m) {
#pragma unroll
                for (int bj = 0; bj < 2; ++bj) { const f32x4 v0 = acc[ai][bj][m][0], v1 = acc[ai][bj][m][1];
                    f32x2 p0 = (f32x2){v0[0], v0[1]}, p1 = (f32x2){v0[2], v0[3]}, p2 = (f32x2){v1[0], v1[1]}, p3 = (f32x2){v1[2], v1[3]};
                    if (isg) { p0 = gelu_tanh2(p0); p1 = gelu_tanh2(p1); p2 = gelu_tanh2(p2); p3 = gelu_tanh2(p3); }
                    u32x4 w; w.x = cvtpk(p0.x, p0.y); w.y = cvtpk(p1.x, p1.y); w.z = cvtpk(p2.x, p2.y); w.w = cvtpk(p3.x, p3.y);
                    *(u32x4*)(ub + (lo + (unsigned)(((ai * HALF + m * 16) * DRNN + bj * HALF) * 2))) = w; } }
    }
};
template <bool RB, bool OB> struct EpiRes {
    static constexpr bool PERM = OB, AFTER_DRAIN = false; static constexpr int NVM = OB ? 16 : 32;
    const void* res; void* out; const float* gate;
    __device__ __forceinline__ static f32x2 bfpair(unsigned w) { return (f32x2){__builtin_bit_cast(float, w << 16), __builtin_bit_cast(float, w & 0xffff0000u)}; }
    __device__ __forceinline__ void operator()(const f32x4 (&acc)[2][2][4][2], const Unit& u, int wr, int wc, int fr, int fq) const {
        constexpr int nst = PERM ? 4 : 16, RS = RB ? 2 : 4, OS = OB ? 2 : 4;
        const size_t ue = (size_t)u.pm * BM * DM + (size_t)u.pn * BM;
        const char* rb = (const char*)res + ue * RS; char* ob = (char*)out + ue * OS;
        const unsigned le = (unsigned)((wr * 64 + fr) * DM + wc * 32 + (PERM ? 8 * fq : 4 * fq));
        f32x2 gv[2][2][2];
        { const float* gb = gate + (u.pm >> 4) * NMOD + u.pn * BM + wc * 32 + (PERM ? 8 * fq : 4 * fq);
#pragma unroll
          for (int bj = 0; bj < 2; ++bj)
#pragma unroll
            for (int n = 0; n < 2; ++n) { const f32x4 t = *(const f32x4*)(gb + bj * HALF + n * nst); gv[bj][n][0] = (f32x2){t[0], t[1]}; gv[bj][n][1] = (f32x2){t[2], t[3]}; } }
        constexpr int NP = RB ? 1 : 2, AP = 2 / NP;
#pragma unroll
        for (int part = 0; part < NP; ++part) {
            u32x4 rw[AP][4][2][(RB && PERM) ? 1 : 2]; f32x4 rf[AP][4][2][2];
#pragma unroll
            for (int a = 0; a < AP; ++a)
#pragma unroll
                for (int m = 0; m < 4; ++m)
#pragma unroll
                    for (int bj = 0; bj < 2; ++bj) { const unsigned eo = le + (unsigned)(((part * AP + a) * HALF + m * 16) * DM + bj * HALF);
                        if (RB && PERM) rw[a][m][bj][0] = *(const u32x4*)(rb + eo * RS);
                        else {
#pragma unroll
                            for (int n = 0; n < 2; ++n) {
                                if (RB) { const u32x2v w = *(const u32x2v*)(rb + (eo + n * nst) * RS); rw[a][m][bj][n].x = w.x; rw[a][m][bj][n].y = w.y; }
                                else rf[a][m][bj][n] = *(const f32x4*)(rb + (eo + n * nst) * RS); } } }
#pragma unroll
            for (int a = 0; a < AP; ++a)
#pragma unroll
                for (int m = 0; m < 4; ++m)
#pragma unroll
                    for (int bj = 0; bj < 2; ++bj) { const int ai = part * AP + a; const unsigned eo = le + (unsigned)((ai * HALF + m * 16) * DM + bj * HALF);
                        f32x2 o[2][2];
#pragma unroll
                        for (int n = 0; n < 2; ++n) { const f32x4 c = acc[ai][bj][m][n]; f32x2 r0, r1;
                            if (RB && PERM) { const u32x4 w = rw[a][m][bj][0]; r0 = bfpair(n ? w.z : w.x); r1 = bfpair(n ? w.w : w.y); }
                            else if (RB) { r0 = bfpair(rw[a][m][bj][n].x); r1 = bfpair(rw[a][m][bj][n].y); }
                            else { const f32x4 w = rf[a][m][bj][n]; r0 = (f32x2){w[0], w[1]}; r1 = (f32x2){w[2], w[3]}; }
                            o[n][0] = r0 + gv[bj][n][0] * (f32x2){c[0], c[1]}; o[n][1] = r1 + gv[bj][n][1] * (f32x2){c[2], c[3]}; }
                        if (OB) { u32x4 w; w.x = cvtpk(o[0][0].x, o[0][0].y); w.y = cvtpk(o[0][1].x, o[0][1].y); w.z = cvtpk(o[1][0].x, o[1][0].y); w.w = cvtpk(o[1][1].x, o[1][1].y);
                            *(u32x4*)(ob + eo * OS) = w; }
                        else { *(f32x4*)(ob + eo * OS) = (f32x4){o[0][0].x, o[0][0].y, o[0][1].x, o[0][1].y}; *(f32x4*)(ob + (eo + nst) * OS) = (f32x4){o[1][0].x, o[1][0].y, o[1][1].x, o[1][1].y}; } }
            if (part + 1 < NP) asm volatile("" ::: "memory");
        }
    }
};
struct EpiRelu2 {
    static constexpr bool PERM = true, AFTER_DRAIN = false; static constexpr int NVM = 16;
    bf16_t* O;
    __device__ __forceinline__ void operator()(const f32x4 (&acc)[2][2][4][2], const Unit& u, int wr, int wc, int fr, int fq) const {
        char* ub = (char*)O + (size_t)(u.pm * (DFF / 64) + u.pn * 4) * (256 * 64 * 2);
        unsigned lo = (unsigned)((((wc >> 1) * 256 + wr * 64 + fr) * 64 + (wc & 1) * 32 + 8 * fq) * 2); asm volatile("" : "+v"(lo));
#pragma unroll
        for (int ai = 0; ai < 2; ++ai)
#pragma unroll
            for (int m = 0; m < 4; ++m) {
#pragma unroll
                for (int bj = 0; bj < 2; ++bj) { const f32x4 v0 = acc[ai][bj][m][0], v1 = acc[ai][bj][m][1];
                    f32x2 p0 = (f32x2){__builtin_amdgcn_fmed3f(v0[0], 0.f, 3.0e38f), __builtin_amdgcn_fmed3f(v0[1], 0.f, 3.0e38f)}, p1 = (f32x2){__builtin_amdgcn_fmed3f(v0[2], 0.f, 3.0e38f), __builtin_amdgcn_fmed3f(v0[3], 0.f, 3.0e38f)};
                    f32x2 p2 = (f32x2){__builtin_amdgcn_fmed3f(v1[0], 0.f, 3.0e38f), __builtin_amdgcn_fmed3f(v1[1], 0.f, 3.0e38f)}, p3 = (f32x2){__builtin_amdgcn_fmed3f(v1[2], 0.f, 3.0e38f), __builtin_amdgcn_fmed3f(v1[3], 0.f, 3.0e38f)};
                    p0 = p0 * p0; p1 = p1 * p1; p2 = p2 * p2; p3 = p3 * p3;
                    u32x4 w; w.x = cvtpk(p0.x, p0.y); w.y = cvtpk(p1.x, p1.y); w.z = cvtpk(p2.x, p2.y); w.w = cvtpk(p3.x, p3.y);
                    *(u32x4*)(ub + (lo + (unsigned)(((ai * HALF + m * 16) * 64 + bj * 2 * 256 * 64) * 2))) = w; } }
    }
};
struct EpiIn1 {
    static constexpr bool PERM = true, AFTER_DRAIN = false; static constexpr int NVM = 0;
    bf16_t *Q, *QI, *K, *V, *KI; float* WI; const float* rope; const float *qg, *kg;
    __device__ __forceinline__ void operator()(const f32x4 (&acc)[2][2][4][2], const Unit& u, int wr, int wc, int fr, int fq) const {
        const int pn = u.pn;
        int kind;
        bf16_t* dst; int pitch, hoff;
        if (pn < 4) { kind = 0; dst = Q; pitch = DM; hoff = (4 * pn + wc) * 64; }
        else if (pn < 6) { kind = 1; dst = QI; pitch = 512; hoff = (4 * (pn - 4) + wc) * 64; }
        else if (wc == 0) { kind = 2; dst = K; pitch = 128; hoff = 0; }
        else if (wc == 1) { kind = 3; dst = KI; pitch = 64; hoff = 0; }
        else if (wc == 2) { kind = 4; dst = V; pitch = 128; hoff = 0; }
        else { kind = 5; dst = nullptr; pitch = 0; hoff = 0; }
        const bool donorm = (kind == 0 || kind == 2), dorope = (kind <= 3);
        const float osc = (kind == 0) ? 0.125f * 1.4426950408889634f : 1.f;
        f32x4 g1[2], g2[2];
#pragma unroll
        for (int n = 0; n < 2; ++n) { g1[n] = (f32x4){1.f, 1.f, 1.f, 1.f}; g2[n] = g1[n]; }
        if (kind == 0) {
#pragma unroll
            for (int n = 0; n < 2; ++n) { g1[n] = *(const f32x4*)(qg + 8 * fq + 4 * n); g2[n] = *(const f32x4*)(qg + 32 + 8 * fq + 4 * n); } }
        if (kind == 2) {
#pragma unroll
            for (int n = 0; n < 2; ++n) { g1[n] = *(const f32x4*)(kg + 8 * fq + 4 * n); g2[n] = *(const f32x4*)(kg + 32 + 8 * fq + 4 * n); } }
#pragma unroll
        for (int ai = 0; ai < 2; ++ai)
#pragma unroll
            for (int m = 0; m < 4; ++m) {
                const int row = u.pm * BM + ai * HALF + wr * 64 + m * 16 + fr, pos = row & (SEQ - 1);
                f32x4 x1[2], x2[2];
#pragma unroll
                for (int n = 0; n < 2; ++n) { x1[n] = acc[ai][0][m][n]; x2[n] = acc[ai][1][m][n]; }
                if (kind == 5) {
                    if (fq == 0) { *(f32x4*)(WI + (size_t)row * 8) = x1[0]; *(f32x4*)(WI + (size_t)row * 8 + 4) = x1[1]; }
                    continue;
                }
                if (donorm) {
                    float ss = 0.f;
#pragma unroll
                    for (int n = 0; n < 2; ++n)
#pragma unroll
                        for (int j = 0; j < 4; ++j) ss += x1[n][j] * x1[n][j] + x2[n][j] * x2[n][j];
                    ss += __shfl_xor(ss, 16); ss += __shfl_xor(ss, 32);
                    const float rs = 1.0f / sqrtf(ss * (1.f / 64.f) + RMS_EPS);
#pragma unroll
                    for (int n = 0; n < 2; ++n) { x1[n] = x1[n] * rs * g1[n]; x2[n] = x2[n] * rs * g2[n]; }
                }
                if (dorope) {
#pragma unroll
                    for (int n = 0; n < 2; ++n) { const f32x4 c = *(const f32x4*)(rope + pos * 32 + 8 * fq + 4 * n), s = *(const f32x4*)(rope + SEQ * 32 + pos * 32 + 8 * fq + 4 * n);
                        const f32x4 o1 = x1[n] * c - x2[n] * s, o2 = x2[n] * c + x1[n] * s; x1[n] = o1; x2[n] = o2; }
                }
#pragma unroll
                for (int n = 0; n < 2; ++n) { x1[n] = x1[n] * osc; x2[n] = x2[n] * osc; }
                bf16_t* rowp = (kind == 3) ? dst + (size_t)(row >> 4) * 1024 + fq * 128 + (row & 15) * 8 : dst + (size_t)row * pitch + hoff + 8 * fq;
                const int hi_off = (kind == 3) ? 512 : 32;
                u32x4 w; w.x = cvt_pk_bf16(x1[0][0], x1[0][1]); w.y = cvt_pk_bf16(x1[0][2], x1[0][3]); w.z = cvt_pk_bf16(x1[1][0], x1[1][1]); w.w = cvt_pk_bf16(x1[1][2], x1[1][3]);
                *(u32x4*)(rowp) = w;
                w.x = cvt_pk_bf16(x2[0][0], x2[0][1]); w.y = cvt_pk_bf16(x2[0][2], x2[0][3]); w.z = cvt_pk_bf16(x2[1][0], x2[1][1]); w.w = cvt_pk_bf16(x2[1][2], x2[1][3]);
                *(u32x4*)(rowp + hi_off) = w;
            }
    }
};
}

__device__ __forceinline__ int bin_row(int c) {
    if (c < 1024) { const int h = c >> 6, d = c & 63; return 256 * (h >> 2) + 128 * (d >> 5) + 32 * (h & 3) + (d & 31); }
    if (c < 1088) { const int d = c - 1024; return 1536 + 128 * (d >> 5) + (d & 31); }
    if (c < 1152) { const int d = c - 1088; return 1536 + 128 * (d >> 5) + 64 + (d & 31); }
    if (c < 1664) { const int cc = c - 1152, h = cc >> 6, d = cc & 63; return 256 * (4 + (h >> 2)) + 128 * (d >> 5) + 32 * (h & 3) + (d & 31); }
    if (c < 1728) { const int d = c - 1664; return 1536 + 128 * (d >> 5) + 32 + (d & 31); }
    return 1536 + 96 + (c - 1728);
}
template <int MODE>
__device__ __forceinline__ void tr_item(const float* W, int K, int N, bf16* WT, int item, LAS float* scr, int lane) {
    const int nblk = (N + 31) / 32, kb = item / nblk, nb = item % nblk, k0 = 64 * kb, n0 = 32 * nb;
    const int nn = n0 + (lane & 31); const bool nok = nn < N;
#pragma unroll 8
    for (int i = 0; i < 32; ++i) { const int kk = 2 * i + (lane >> 5); scr[kk * 33 + (lane & 31)] = nok ? W[(size_t)(k0 + kk) * N + nn] : 0.f; }
    LDS_WAIT(); asm volatile("" ::: "memory");
    const int c = lane & 7;
#pragma unroll
    for (int j = 0; j < 4; ++j) { const int n = (lane >> 3) + 8 * j, ncol = n0 + n; const LAS float* s = scr + (8 * c) * 33 + n;
        v4u o; o.x = pk2(s[0 * 33], s[1 * 33]); o.y = pk2(s[2 * 33], s[3 * 33]); o.z = pk2(s[4 * 33], s[5 * 33]); o.w = pk2(s[6 * 33], s[7 * 33]);
        if (ncol < N) {
            if (MODE == 3) *(GAS v4u*)(WT + ((size_t)((ncol >> 8) * (K / 64) + (k0 >> 6)) * 256 + (ncol & 255)) * 64 + 8 * c) = o;
            else { const int drow = (MODE == 0) ? ncol : bin_row(ncol); *(GAS v4u*)(WT + (size_t)drow * K + k0 + 8 * c) = o; } } }
    LDS_WAIT(); asm volatile("" ::: "memory");
}

struct RopeInv { float v[32]; };

template <int PART>
__device__ __forceinline__ void phase_prep(const float* const* in, unsigned char* ws, LAS unsigned char* lds, const RopeInv& rinv, int tid, int lane, int wave, int bx, int G) {
  constexpr bool LATE = PART == 2;
  if (PART == 0) {
    if (bx < 192) {
        LAS float* cond = (LAS float*)lds; LAS float* part = (LAS float*)(lds + 32768);
        const float* cin = in[1];
        for (int i = tid; i < NB * DM; i += NTHREADS) { const float v = cin[i]; cond[i] = v / (1.f + __expf(-v)); }
        __syncthreads();
        const int l = bx / 96, c0 = 64 * (bx % 96), cq = tid & 15, kg = tid >> 4;
        f32x4 a[NB];
#pragma unroll
        for (int b = 0; b < NB; ++b) a[b] = (f32x4){0.f, 0.f, 0.f, 0.f};
        const float* wp = in[4] + (size_t)l * DM * NMOD + c0 + 4 * cq;
#pragma unroll 4
        for (int kk = 0; kk < 32; ++kk) { const int k = kg * 32 + kk; const f32x4 w = *(const f32x4*)(wp + (size_t)k * NMOD);
#pragma unroll
            for (int b = 0; b < NB; ++b) { const float cv = cond[b * DM + k]; a[b] += w * cv; } }
#pragma unroll
        for (int b = 0; b < NB; ++b) *(LAS f32x4*)(part + (kg * NB + b) * 64 + 4 * cq) = a[b];
        __syncthreads();
        { const int b = tid >> 6, col = tid & 63; float s = 0.f;
#pragma unroll 8
          for (int k2 = 0; k2 < 32; ++k2) s += part[(k2 * NB + b) * 64 + col];
          ((float*)(ws + WS_MOD))[(size_t)(l * NB + b) * NMOD + c0 + col] = s + in[5][l * NMOD + c0 + col]; }
        __syncthreads();
    }
    return;
  }
  if (LATE) {
    { float* rope = (float*)(ws + WS_ROPE);
      for (int idx = bx * NTHREADS + tid; idx < SEQ * 32; idx += G * NTHREADS) { const int pos = idx >> 5, i = idx & 31;
          const float ang = (float)pos * rinv.v[i]; const double a = (double)ang; const double k = rint(a * 0.15915494309189535); const float x = (float)(a * 0.15915494309189535 - k);
          rope[idx] = __builtin_amdgcn_cosf(x); rope[SEQ * 32 + idx] = __builtin_amdgcn_sinf(x); } }
    { bf16* wb = (bf16*)(ws + WS_WBIN);
      for (int i = bx * NTHREADS + tid; i < 56 * 128; i += G * NTHREADS) { const int r = i >> 7, c8 = i & 127; const int row = r < 24 ? 1536 + 96 + 8 + r : 1536 + 128 + 96 + (r - 24);
          *(GAS v4u*)(wb + (size_t)row * DM + 8 * c8) = (v4u){0u, 0u, 0u, 0u}; } }
  }
    LAS float* scr = (LAS float*)(lds + wave * 16384);
    const int gw = bx * NWAVES + wave, NGW = G * NWAVES;
    constexpr int I_AIN = 16 * 80, I_AOUT = 20 * 32, I_G1 = 4 * 8, I_GATES = 10 * I_G1, I_BIN = 16 * 55, I_BOUT = 16 * 32, I_W1 = 16 * 128, I_W2 = 64 * 32;
    constexpr int NEARLY = I_AIN + I_GATES, NLATE = 2 * I_W1 + 2 * I_W2 + I_AOUT + I_BIN + I_BOUT;
    for (int it = gw; it < (LATE ? NLATE : NEARLY); it += NGW) {
        int r = it;
        if (!LATE) {
            if (r < I_AIN) { tr_item<0>(in[6], DM, 2 * DRNN, (bf16*)(ws + WS_WAIN), r, scr, lane); continue; } r -= I_AIN;
            { const int mi = r / I_G1, n = mi >> 1, gsel = mi & 1;
              tr_item<0>(in[gsel ? 11 : 9] + (size_t)n * LBLK * LBLK, LBLK, LBLK, (bf16*)(ws + WS_WGATE) + (size_t)(n * 2 + gsel) * LBLK * LBLK, r % I_G1, scr, lane); continue; }
        }
        if (r < I_W1 * 2) { const int l = r / I_W1; tr_item<0>(in[19] + (size_t)l * DM * DFF, DM, DFF, (bf16*)(ws + WS_W1) + (size_t)l * DFF * DM, r % I_W1, scr, lane); continue; } r -= 2 * I_W1;
        if (r < I_W2 * 2) { const int l = r / I_W2; tr_item<3>(in[20] + (size_t)l * DFF * DM, DFF, DM, (bf16*)(ws + WS_W2) + (size_t)l * DM * DFF, r % I_W2, scr, lane); continue; } r -= 2 * I_W2;
        if (r < I_AOUT) { tr_item<0>(in[14], DRNN, DM, (bf16*)(ws + WS_WAOUT), r, scr, lane); continue; } r -= I_AOUT;
        if (r < I_BIN) { tr_item<1>(in[15], DM, BIN, (bf16*)(ws + WS_WBIN), r, scr, lane); continue; } r -= I_BIN;
        tr_item<0>(in[18], DM, DM, (bf16*)(ws + WS_WBOUT), r, scr, lane);
    }
}

template <bool XB16>
__device__ __forceinline__ void phase_norm(const void* x, const float* g, const float* mod_sh, const float* mod_sc, bf16* H, int lane, int wave, int vcu, int G) {
    const int gw = vcu * NWAVES + wave, NGW = G * NWAVES;
    for (int r0 = gw * 16; r0 < MTOK; r0 += NGW * 16) {
        const int b = r0 >> 12;
        f32x4 al[4], be[4];
#pragma unroll
        for (int j = 0; j < 4; ++j) { const int c = XB16 ? 8 * lane + 512 * (j >> 1) + 4 * (j & 1) : 4 * lane + 256 * j;
            const f32x4 gg = *(const f32x4*)(g + c), sc = *(const f32x4*)(mod_sc + b * NMOD + c); al[j] = gg * (sc + 1.f); be[j] = *(const f32x4*)(mod_sh + b * NMOD + c); }
#pragma unroll 2
        for (int rr = 0; rr < 16; ++rr) {
            f32x4 v[4]; float s = 0.f;
            if (XB16) {
                const GAS v4u* xr = (const GAS v4u*)((const bf16*)x + (size_t)(r0 + rr) * DM) + lane;
#pragma unroll
                for (int j = 0; j < 2; ++j) { const v4u w = xr[64 * j];
                    v[2 * j] = (f32x4){bflo(w.x), bfhi(w.x), bflo(w.y), bfhi(w.y)}; v[2 * j + 1] = (f32x4){bflo(w.z), bfhi(w.z), bflo(w.w), bfhi(w.w)}; }
            } else {
                const GAS f32x4* xr = (const GAS f32x4*)((const float*)x + (size_t)(r0 + rr) * DM) + lane;
#pragma unroll
                for (int j = 0; j < 4; ++j) v[j] = xr[64 * j];
            }
#pragma unroll
            for (int j = 0; j < 4; ++j) s += (v[j].x * v[j].x + v[j].y * v[j].y) + (v[j].z * v[j].z + v[j].w * v[j].w);
            const float rstd = 1.0f / sqrtf(wave_sum(s) * (1.f / DM) + RMS_EPS);
            f32x4 y[4];
#pragma unroll
            for (int j = 0; j < 4; ++j) y[j] = v[j] * rstd * al[j] + be[j];
            if (XB16) {
                GAS v4u* o16 = (GAS v4u*)(H + (size_t)(r0 + rr) * DM) + lane;
#pragma unroll
                for (int j = 0; j < 2; ++j) { v4u o; o.x = pk2(y[2 * j].x, y[2 * j].y); o.y = pk2(y[2 * j].z, y[2 * j].w); o.z = pk2(y[2 * j + 1].x, y[2 * j + 1].y); o.w = pk2(y[2 * j + 1].z, y[2 * j + 1].w); o16[64 * j] = o; }
            } else {
                GAS unsigned long long* o8 = (GAS unsigned long long*)(H + (size_t)(r0 + rr) * DM) + lane;
#pragma unroll
                for (int j = 0; j < 4; ++j) o8[64 * j] = (unsigned long long)pk2(y[j].x, y[j].y) | ((unsigned long long)pk2(y[j].z, y[j].w) << 32);
            }
        }
    }
}

constexpr int RQ_CT = 128, RQ_AP = 528  , RQ_SP = 68  ;
constexpr int RQ_AT = 0, RQ_A = RQ_CT * RQ_AP, RQ_B = RQ_A + RQ_CT * RQ_SP * 4, RQ_SEG = RQ_B + RQ_CT * RQ_SP * 4, RQ_END = RQ_SEG + 16 * 32 * 16;
static_assert(RQ_END <= MISC_OFF, "rglru LDS map");
__device__ __forceinline__ f32x2v bf2x(unsigned w) { return (f32x2v){__builtin_bit_cast(float, w << 16), __builtin_bit_cast(float, w & 0xffff0000u)}; }
__device__ __forceinline__ void phase_rglru(const float* const* in, unsigned char* ws, LAS unsigned char* lds, int tid, int lane, int wave, int bx) {
    if (bx >= 160) return;
    const int b = bx & 7, n = (bx >> 3) >> 2, g = (bx >> 3) & 3;
    const bf16* XB = (const bf16*)(ws + WS_XB); const bf16* GT = (const bf16*)(ws + WS_GATE); bf16* Y = (bf16*)(ws + WS_Y);
    const int fr = lane & 15, fq = lane >> 4, wr = wave >> 2, wc = wave & 3;
    pg8::bf16x8 Br[8], Bi[8];
    { const bf16* wr_ = (const bf16*)(ws + WS_WGATE) + (size_t)(n * 2 + 0) * LBLK * LBLK + (size_t)(64 * g + 16 * wc + fr) * LBLK + 8 * fq;
      const bf16* wi_ = wr_ + (size_t)LBLK * LBLK;
#pragma unroll
      for (int kk = 0; kk < 8; ++kk) { Br[kk] = *(const pg8::bf16x8*)(wr_ + 32 * kk); Bi[kk] = *(const pg8::bf16x8*)(wi_ + 32 * kk); } }
    const int chl0 = 16 * wc + 4 * fq, chg0 = LBLK * n + 64 * g + chl0;
    f32x2v brv[2], biv[2], nsp[2];
    { const f32x4 x = *(const f32x4*)(in[10] + chg0), y = *(const f32x4*)(in[12] + chg0), lam = *(const f32x4*)(in[13] + chg0);
      brv[0] = (f32x2v){x[0], x[1]}; brv[1] = (f32x2v){x[2], x[3]}; biv[0] = (f32x2v){y[0], y[1]}; biv[1] = (f32x2v){y[2], y[3]};
      float t[4];
#pragma unroll
      for (int j = 0; j < 4; ++j) t[j] = -8.f * 1.4426950408889634f * log1pf(__expf(-lam[j]));
      nsp[0] = (f32x2v){t[0], t[1]}; nsp[1] = (f32x2v){t[2], t[3]}; }
    const int cq = lane;
    const int cch = LBLK * n + 4 * cq;
    f32x2v cw[4][2], cb[2];
#pragma unroll
    for (int j = 0; j < 4; ++j) { const f32x4 w0 = *(const f32x4*)(in[7] + j * DRNN + cch); cw[j][0] = (f32x2v){w0[0], w0[1]}; cw[j][1] = (f32x2v){w0[2], w0[3]}; }
    { const f32x4 b0 = *(const f32x4*)(in[8] + cch); cb[0] = (f32x2v){b0[0], b0[1]}; cb[1] = (f32x2v){b0[2], b0[3]}; }
    const int cp = tid & 31, sg = tid >> 5;
    f32x2v hin = (f32x2v){0.f, 0.f};
    const size_t tok0 = (size_t)b * SEQ;
    u32x2v xr[19];
#define RQ_LOADX(t0_) do { _Pragma("unroll") for (int i_ = 0; i_ < 19; ++i_) { const int t_ = (t0_) + 16 * wave - 3 + i_; \
        xr[i_] = (t_ >= 0) ? *(const GAS u32x2v*)(XB + (tok0 + t_) * DRNN + cch) : (u32x2v){0u, 0u}; } } while (0)
    RQ_LOADX(0);
    for (int c = 0; c < SEQ / RQ_CT; ++c) {
        const int t0 = c * RQ_CT;
        { f32x2v xf[19][2];
#pragma unroll
          for (int i = 0; i < 19; ++i) { xf[i][0] = bf2x(xr[i].x); xf[i][1] = bf2x(xr[i].y); }
#pragma unroll
          for (int tt = 0; tt < 16; ++tt) { f32x2v o0 = cb[0], o1 = cb[1];
#pragma unroll
              for (int j = 0; j < 4; ++j) { o0 += cw[j][0] * xf[tt + j][0]; o1 += cw[j][1] * xf[tt + j][1]; }
              u32x2v pk; pk.x = pk2(o0.x, o0.y); pk.y = pk2(o1.x, o1.y);
              *(LAS u32x2v*)(lds + RQ_AT + (16 * wave + tt) * RQ_AP + 8 * cq) = pk; } }
        if (c + 1 < SEQ / RQ_CT) RQ_LOADX(t0 + RQ_CT);
        unsigned gt[8];
        { const bf16* gp = GT + (tok0 + t0 + 8 * sg) * DRNN + LBLK * n + 64 * g + 2 * cp;
#pragma unroll
          for (int t = 0; t < 8; ++t) gt[t] = *(const GAS unsigned*)(gp + (size_t)t * DRNN); }
        __syncthreads();
        f32x4 ar[4], ai_[4];
#pragma unroll
        for (int m = 0; m < 4; ++m) { ar[m] = (f32x4){0.f, 0.f, 0.f, 0.f}; ai_[m] = ar[m]; }
#pragma unroll
        for (int kk = 0; kk < 8; ++kk)
#pragma unroll
            for (int m = 0; m < 4; ++m) { const pg8::bf16x8 xf = *(const LAS pg8::bf16x8*)(lds + RQ_AT + (64 * wr + 16 * m + fr) * RQ_AP + (32 * kk + 8 * fq) * 2);
                ar[m] = __builtin_amdgcn_mfma_f32_16x16x32_bf16(Br[kk], xf, ar[m], 0, 0, 0); ai_[m] = __builtin_amdgcn_mfma_f32_16x16x32_bf16(Bi[kk], xf, ai_[m], 0, 0, 0); }
#pragma unroll
        for (int m = 0; m < 4; ++m) { const int tk = 64 * wr + 16 * m + fr;
            const u32x2v xw = *(const LAS u32x2v*)(lds + RQ_AT + tk * RQ_AP + (64 * g + chl0) * 2);
            f32x4 av, bv;
#pragma unroll
            for (int h = 0; h < 2; ++h) { const f32x2v xc = bf2x(h ? xw.y : xw.x);
                f32x2v tr_ = ((f32x2v){ar[m][2 * h], ar[m][2 * h + 1]} + brv[h]) * -1.4426950408889634f, ti_ = ((f32x2v){ai_[m][2 * h], ai_[m][2 * h + 1]} + biv[h]) * -1.4426950408889634f;
                tr_.x = __builtin_amdgcn_exp2f(tr_.x); tr_.y = __builtin_amdgcn_exp2f(tr_.y); ti_.x = __builtin_amdgcn_exp2f(ti_.x); ti_.y = __builtin_amdgcn_exp2f(ti_.y);
                tr_ = tr_ + 1.0f; ti_ = ti_ + 1.0f;
                f32x2v rr, ii; rr.x = __builtin_amdgcn_rcpf(tr_.x); rr.y = __builtin_amdgcn_rcpf(tr_.y); ii.x = __builtin_amdgcn_rcpf(ti_.x); ii.y = __builtin_amdgcn_rcpf(ti_.y);
                f32x2v la = rr * nsp[h], a; a.x = __builtin_amdgcn_exp2f(la.x); a.y = __builtin_amdgcn_exp2f(la.y);
                f32x2v q = 1.0f - a * a, s; s.x = __builtin_amdgcn_sqrtf(__builtin_fabsf(q.x)); s.y = __builtin_amdgcn_sqrtf(__builtin_fabsf(q.y));
                const f32x2v bb = s * (ii * xc);
                av[2 * h] = a.x; av[2 * h + 1] = a.y; bv[2 * h] = bb.x; bv[2 * h + 1] = bb.y; }
            *(LAS f32x4*)(lds + RQ_A + (tk * RQ_SP + chl0) * 4) = av; *(LAS f32x4*)(lds + RQ_B + (tk * RQ_SP + chl0) * 4) = bv; }
        __syncthreads();
        f32x2v sa[8], sb[8];
#pragma unroll
        for (int t = 0; t < 8; ++t) { sa[t] = *(const LAS f32x2v*)(lds + RQ_A + ((8 * sg + t) * RQ_SP + 2 * cp) * 4); sb[t] = *(const LAS f32x2v*)(lds + RQ_B + ((8 * sg + t) * RQ_SP + 2 * cp) * 4); }
        { f32x2v A = sa[0], H = sb[0];
#pragma unroll
          for (int t = 1; t < 8; ++t) { A = A * sa[t]; H = sa[t] * H + sb[t]; }
          *(LAS f32x4*)(lds + RQ_SEG + (sg * 32 + cp) * 16) = (f32x4){A.x, A.y, H.x, H.y}; }
        __syncthreads();
        { f32x2v h = hin, mine = hin;
#pragma unroll
          for (int s = 0; s < 16; ++s) { const f32x4 sh = *(const LAS f32x4*)(lds + RQ_SEG + (s * 32 + cp) * 16); if (s == sg) mine = h; h = (f32x2v){sh[0], sh[1]} * h + (f32x2v){sh[2], sh[3]}; }
          hin = h;
          f32x2v hh = mine; bf16* yp = Y + (tok0 + t0 + 8 * sg) * DRNN + LBLK * n + 64 * g + 2 * cp;
#pragma unroll
          for (int t = 0; t < 8; ++t) { hh = sa[t] * hh + sb[t]; const f32x2v yv = hh * bf2x(gt[t]); *(GAS unsigned*)(yp + (size_t)t * DRNN) = pk2(yv.x, yv.y); } }
    }
#undef RQ_LOADX
}

constexpr int DS_SCP = 8224;
constexpr int DS_H1 = 8 * DS_SCP, DS_H2 = DS_H1 + 8 * 4096, DS_BNC = 0, DS_IDX = 8 * 16384, DS_DMY = DS_IDX + 8 * 1024, DS_END = DS_DMY + 8 * 256;
static_assert(DS_END <= MISC_OFF && DS_H2 + 8 * 2048 <= DS_IDX, "dsa LDS map");

__device__ __forceinline__ unsigned mbcnt64(unsigned long long m) { return __builtin_amdgcn_mbcnt_hi((unsigned)(m >> 32), __builtin_amdgcn_mbcnt_lo((unsigned)m, 0u)); }
__device__ __forceinline__ void wave_prefix4(unsigned x, unsigned& pre, unsigned& tot) {
    pre = 0u; tot = 0u;
#pragma unroll
    for (int bit = 0; bit < 4; ++bit) { const unsigned long long m = __ballot((x >> bit) & 1u); pre += mbcnt64(m) << bit; tot += (unsigned)__popcll(m) << bit; }
}
__device__ __forceinline__ unsigned row_scan_u32(unsigned v) {
    v += (unsigned)__builtin_amdgcn_update_dpp(0, (int)v, 0x111, 0xf, 0xf, true);
    v += (unsigned)__builtin_amdgcn_update_dpp(0, (int)v, 0x112, 0xf, 0xf, true);
    v += (unsigned)__builtin_amdgcn_update_dpp(0, (int)v, 0x114, 0xf, 0xf, true);
    v += (unsigned)__builtin_amdgcn_update_dpp(0, (int)v, 0x118, 0xf, 0xf, true);
    return v;
}
__device__ __forceinline__ void hist_find4(v4u c4, unsigned need, int lane, unsigned& B, unsigned& above, unsigned& atb) {
    const unsigned s = c4.x + c4.y + c4.z + c4.w;
    const unsigned inc = row_scan_u32(s);
    const unsigned t0 = (unsigned)__builtin_amdgcn_readlane((int)inc, 15), t1 = (unsigned)__builtin_amdgcn_readlane((int)inc, 31), t2 = (unsigned)__builtin_amdgcn_readlane((int)inc, 47), t3 = (unsigned)__builtin_amdgcn_readlane((int)inc, 63);
    const int row = lane >> 4;
    const unsigned before = (row > 0 ? t0 : 0u) + (row > 1 ? t1 : 0u) + (row > 2 ? t2 : 0u) + (inc - s);
    const unsigned total = (t0 + t1) + (t2 + t3);
    const unsigned S = total - before;
    const unsigned long long mk = __ballot(S >= need);
    const int L = 63 - __builtin_clzll(mk | 1ull);
    unsigned cum = S - s, bin, ab, at;
    if (cum + c4.w >= need) { bin = 4 * lane + 3; ab = cum; at = c4.w; }
    else { cum += c4.w; if (cum + c4.z >= need) { bin = 4 * lane + 2; ab = cum; at = c4.z; }
        else { cum += c4.z; if (cum + c4.y >= need) { bin = 4 * lane + 1; ab = cum; at = c4.y; } else { cum += c4.y; bin = 4 * lane; ab = cum; at = c4.x; } } }
    B = __builtin_amdgcn_readlane(bin, L); above = __builtin_amdgcn_readlane(ab, L); atb = __builtin_amdgcn_readlane(at, L);
}
__device__ __forceinline__ void pk_count4(unsigned& a0, unsigned& a1, unsigned& a2, unsigned& a3, unsigned k0, unsigned k1, unsigned k2, unsigned k3, unsigned cm) {
    unsigned t0, t1, t2, t3;
    asm("v_pk_sub_u16 %4, %8, %12 clamp\n\tv_pk_sub_u16 %5, %9, %12 clamp\n\tv_pk_sub_u16 %6, %10, %12 clamp\n\tv_pk_sub_u16 %7, %11, %12 clamp\n\t"
        "v_pk_min_u16 %4, %4, 1 op_sel_hi:[1,0]\n\tv_pk_min_u16 %5, %5, 1 op_sel_hi:[1,0]\n\tv_pk_min_u16 %6, %6, 1 op_sel_hi:[1,0]\n\tv_pk_min_u16 %7, %7, 1 op_sel_hi:[1,0]\n\t"
        "v_pk_add_u16 %0, %0, %4\n\tv_pk_add_u16 %1, %1, %5\n\tv_pk_add_u16 %2, %2, %6\n\tv_pk_add_u16 %3, %3, %7"
        : "+v"(a0), "+v"(a1), "+v"(a2), "+v"(a3), "=&v"(t0), "=&v"(t1), "=&v"(t2), "=&v"(t3) : "v"(k0), "v"(k1), "v"(k2), "v"(k3), "v"(cm));
}
__device__ __forceinline__ unsigned pk_bin2(unsigned w, unsigned b1p) {
    unsigned t, g;
    asm("v_pk_sub_u16 %0, %2, %3\n\tv_and_or_b32 %1, %0, %4, %5\n\tv_pk_min_u16 %0, %0, %1" : "=&v"(t), "=&v"(g) : "v"(w), "v"(b1p), "v"(0x00ff00ffu), "v"(0x01000100u));
    return t;
}
typedef _Float16 h16x2 __attribute__((ext_vector_type(2)));
__device__ __forceinline__ h16x2 pkrtz(float a, float b) { return __builtin_bit_cast(h16x2, __builtin_amdgcn_cvt_pkrtz(a, b)); }
__device__ __forceinline__ unsigned score_key(float s) {
    const int h = (int)(short)__builtin_bit_cast(unsigned short, (_Float16)s);
    return ((unsigned)h ^ ((unsigned)(h >> 15) | 0x8000u)) & 0xffffu;
}

__device__ __forceinline__ void phase_dsa(unsigned char* ws, LAS unsigned char* lds, int tid, int lane, int wave, int bx, int G, int mask) {
    const bf16* Qb = (const bf16*)(ws + WS_Q); const bf16* QIb = (const bf16*)(ws + WS_QI); const bf16* KVb = (const bf16*)(ws + WS_KV);
    const bf16* KIb = (const bf16*)(ws + WS_KI); const float* WIb = (const float*)(ws + WS_WI); bf16* AO = (bf16*)(ws + WS_AO);
    const int lane0 = lane;
    const int b = bx & 7, jj = bx >> 3, nj = G >> 3;
    const size_t tokb = (size_t)b * SEQ;
    for (int i = 0; ; ++i) {
        const int qb = ((i & 1) ? (nj - 1 - jj) : jj) + nj * i;
        if (qb >= SEQ / 8) break;
        const int p0 = 8 * qb, nk16 = (p0 + 8 + 15) & ~15, NT = nk16 >> 4;
        if (mask & 1) {
            int lane = lane0; asm volatile("" : "+v"(lane));
            const int fr = lane & 15, fq = lane >> 4;
            pg8::bf16x8 QA[2][2][2];
#pragma unroll
            for (int grp = 0; grp < 2; ++grp)
#pragma unroll
                for (int hf = 0; hf < 2; ++hf)
#pragma unroll
                    for (int ks = 0; ks < 2; ++ks)
                        QA[grp][hf][ks] = *(const pg8::bf16x8*)(QIb + (tokb + p0 + 4 * grp + (fr >> 2)) * 512 + (4 * hf + (fr & 3)) * 64 + 32 * ks + 8 * fq);
            h16x2 wq[2][4];
#pragma unroll
            for (int grp = 0; grp < 2; ++grp) { const f32x4 w0 = *(const f32x4*)(WIb + (tokb + p0 + 4 * grp + fq) * 8), w1 = *(const f32x4*)(WIb + (tokb + p0 + 4 * grp + fq) * 8 + 4);
                wq[grp][0] = pkrtz(w0[0], w0[1]); wq[grp][1] = pkrtz(w0[2], w0[3]); wq[grp][2] = pkrtz(w1[0], w1[1]); wq[grp][3] = pkrtz(w1[2], w1[3]); }
            const int ntw = NT > wave ? (NT - wave + 7) >> 3 : 0, ng = (ntw + 3) >> 2;
            const char* kibase = (const char*)(KIb + tokb * 64);
            const unsigned koff = (unsigned)lane * 16u;
            const h16x2 hz = {(_Float16)0.f, (_Float16)0.f};
            pg8::bf16x8 ka[4][2], kb[4][2];
#define DS_A_LOAD(buf, g) do { _Pragma("unroll") for (int u_ = 0; u_ < 4; ++u_) { int kt_ = wave + 8 * (4 * (g) + u_); kt_ = kt_ < NT ? kt_ : NT - 1; const unsigned o_ = koff + (unsigned)kt_ * 2048u; \
                buf[u_][0] = *(const pg8::bf16x8*)(kibase + o_); buf[u_][1] = *(const pg8::bf16x8*)(kibase + o_ + 1024u); } } while (0)
#define DS_A_COMP(buf, g) do { f32x4 d_[4][2][2]; \
                _Pragma("unroll") for (int u_ = 0; u_ < 4; ++u_) _Pragma("unroll") for (int grp = 0; grp < 2; ++grp) _Pragma("unroll") for (int hf = 0; hf < 2; ++hf) { \
                    f32x4 z_ = (f32x4){0.f, 0.f, 0.f, 0.f}; z_ = __builtin_amdgcn_mfma_f32_16x16x32_bf16(QA[grp][hf][0], buf[u_][0], z_, 0, 0, 0); d_[u_][grp][hf] = __builtin_amdgcn_mfma_f32_16x16x32_bf16(QA[grp][hf][1], buf[u_][1], z_, 0, 0, 0); } \
                _Pragma("unroll") for (int u_ = 0; u_ < 4; ++u_) { const int kt_ = wave + 8 * (4 * (g) + u_); const int key_ = 16 * kt_ + fr; \
                    _Pragma("unroll") for (int grp = 0; grp < 2; ++grp) { float s_ = 0.f; \
                        _Pragma("unroll") for (int hf = 0; hf < 2; ++hf) { \
                            s_ = __builtin_amdgcn_fdot2(__builtin_elementwise_max(pkrtz(d_[u_][grp][hf][0], d_[u_][grp][hf][1]), hz), wq[grp][2 * hf], s_, false); \
                            s_ = __builtin_amdgcn_fdot2(__builtin_elementwise_max(pkrtz(d_[u_][grp][hf][2], d_[u_][grp][hf][3]), hz), wq[grp][2 * hf + 1], s_, false); } \
                        const int q_ = 4 * grp + fq; const unsigned kk_ = (key_ <= p0 + q_) ? score_key(s_) : 0u; \
                        if (kt_ < NT) *(LAS unsigned short*)(lds + q_ * DS_SCP + key_ * 2) = (unsigned short)kk_; } } } while (0)
            DS_A_LOAD(ka, 0);
            DS_A_LOAD(kb, 1);
            for (int g = 0; g < ng; g += 2) {
                DS_A_COMP(ka, g);
                DS_A_LOAD(ka, g + 2);
                if (g + 1 < ng) DS_A_COMP(kb, g + 1);
                DS_A_LOAD(kb, g + 3);
            }
#undef DS_A_LOAD
#undef DS_A_COMP
        }
        LDS_WAIT();
        __syncthreads();
        const int p = p0 + wave, nvalid = p + 1;
        LAS unsigned* idx = (LAS unsigned*)(lds + DS_IDX + wave * 1024);
        int nsel = 1;
        if (!(mask & 2)) { }
        else if (nvalid <= TOPK) {
#pragma unroll
            for (int r = 0; r < 4; ++r) { const int s = lane0 + 64 * r; idx[s] = (unsigned)(s < nvalid ? s : 0) << 8; }
            nsel = nvalid;
        } else {
            int lane = lane0; asm volatile("" : "+v"(lane));
            const LAS unsigned char* row = lds + wave * DS_SCP;
            const int nit = (nk16 + 511) >> 9;
            unsigned kp[8][4];
#pragma unroll
            for (int it = 0; it < 8; ++it) { v4u v = (v4u){0u, 0u, 0u, 0u};
                if (it < nit) { const int e0 = it * 512 + lane * 8; if (e0 < nk16) v = *(const LAS v4u*)(row + e0 * 2); }
#pragma unroll
                for (int x = 0; x < 4; ++x) kp[it][x] = v[x]; }
            const unsigned h1w = DS_H1 + wave * 4096, h2w = DS_H2 + wave * 2048;
#pragma unroll
            for (int r = 0; r < 4; ++r) *(LAS v4u*)(lds + h1w + r * 1024 + lane * 16) = (v4u){0u, 0u, 0u, 0u};
#pragma unroll
            for (int r = 0; r < 2; ++r) *(LAS v4u*)(lds + h2w + r * 1024 + lane * 16) = (v4u){0u, 0u, 0u, 0u};
            LDS_WAIT();
            const unsigned h1l = h1w + (unsigned)(lane & 3) * 1024u;
#pragma unroll
            for (int it = 0; it < 8; ++it) if (it < nit) {
#pragma unroll
                for (int x = 0; x < 4; ++x) { const unsigned w = kp[it][x];
                    __hip_atomic_fetch_add((LAS unsigned*)(lds + h1l + ((w >> 6) & 0x3fcu)), 1u, __ATOMIC_RELAXED, __HIP_MEMORY_SCOPE_WORKGROUP);
                    __hip_atomic_fetch_add((LAS unsigned*)(lds + h1l + ((w >> 22) & 0x3fcu)), 1u, __ATOMIC_RELAXED, __HIP_MEMORY_SCOPE_WORKGROUP); } }
            LDS_WAIT();
            unsigned B1, above1, at1;
            { const v4u c0 = *(const LAS v4u*)(lds + h1w + lane * 16), c1 = *(const LAS v4u*)(lds + h1w + 1024 + lane * 16), c2 = *(const LAS v4u*)(lds + h1w + 2048 + lane * 16), c3 = *(const LAS v4u*)(lds + h1w + 3072 + lane * 16);
              hist_find4((c0 + c1) + (c2 + c3), (unsigned)TOPK, lane, B1, above1, at1); }
            const unsigned need1 = (unsigned)TOPK - above1;
            const unsigned b1p = B1 * 0x01000100u;
#pragma unroll
            for (int it = 0; it < 8; ++it) if (it < nit) {
#pragma unroll
                for (int x = 0; x < 4; ++x) { const unsigned m = pk_bin2(kp[it][x], b1p);
                    __hip_atomic_fetch_add((LAS unsigned*)(lds + h2w + ((m & 0xffffu) << 2)), 1u, __ATOMIC_RELAXED, __HIP_MEMORY_SCOPE_WORKGROUP);
                    __hip_atomic_fetch_add((LAS unsigned*)(lds + h2w + ((m >> 16) << 2)), 1u, __ATOMIC_RELAXED, __HIP_MEMORY_SCOPE_WORKGROUP); } }
            LDS_WAIT();
            unsigned B2, above2, at2;
            hist_find4(*(const LAS v4u*)(lds + h2w + lane * 16), need1, lane, B2, above2, at2);
            const unsigned T = (B1 << 8) | B2, need_eq = need1 - above2;
            if (need_eq == at2) {
                unsigned a0 = 0u, a1 = 0u, a2 = 0u, a3 = 0u; const unsigned cm = (T - 1u) * 0x10001u;
#pragma unroll
                for (int it = 0; it < 8; ++it) if (it < nit) pk_count4(a0, a1, a2, a3, kp[it][0], kp[it][1], kp[it][2], kp[it][3], cm);
                const unsigned a_ = (a0 + a1) + (a2 + a3), cl = (a_ & 0xffffu) + (a_ >> 16);
                const unsigned inc = row_scan_u32(cl);
                const unsigned t0 = (unsigned)__builtin_amdgcn_readlane((int)inc, 15), t1 = (unsigned)__builtin_amdgcn_readlane((int)inc, 31), t2 = (unsigned)__builtin_amdgcn_readlane((int)inc, 47);
                const int rw = lane >> 4;
                unsigned pa = DS_IDX + wave * 1024 + 4u * ((rw > 0 ? t0 : 0u) + (rw > 1 ? t1 : 0u) + (rw > 2 ? t2 : 0u) + (inc - cl));
                const unsigned eb = (unsigned)lane * 2048u;
#pragma unroll
                for (int it = 0; it < 8; ++it) if (it < nit) {
#pragma unroll
                    for (int k = 0; k < 8; ++k) { const unsigned kk_ = (k & 1) ? (kp[it][k >> 1] >> 16) : (kp[it][k >> 1] & 0xffffu);
                        if (kk_ >= T) { *(LAS unsigned*)(lds + pa) = eb + (unsigned)((it * 512 + k) << 8); pa += 4u; } } }
            } else {
                unsigned cnt = 0u, eqc = 0u;
#pragma unroll
                for (int it = 0; it < 8; ++it) if (it < nit) {
                    unsigned gtm = 0u, eqm = 0u;
#pragma unroll
                    for (int k = 0; k < 8; ++k) { const unsigned kk_ = (k & 1) ? (kp[it][k >> 1] >> 16) : (kp[it][k >> 1] & 0xffffu); gtm |= (kk_ > T) ? (1u << k) : 0u; eqm |= (kk_ == T) ? (1u << k) : 0u; }
                    unsigned selm = gtm;
                    if (__ballot(eqm != 0u)) { unsigned pre, tot; wave_prefix4((unsigned)__popc(eqm), pre, tot); unsigned run = eqc + pre;
#pragma unroll
                        for (int k = 0; k < 8; ++k) if ((eqm >> k) & 1u) { if (run < need_eq) selm |= (1u << k); ++run; }
                        eqc += tot; }
                    if (__ballot(selm != 0u)) { unsigned pre, tot; wave_prefix4((unsigned)__popc(selm), pre, tot); unsigned pos = cnt + pre; const int e0 = it * 512 + lane * 8;
#pragma unroll
                        for (int k = 0; k < 8; ++k) if ((selm >> k) & 1u) { idx[pos & 255u] = (unsigned)(e0 + k) << 8; ++pos; }
                        cnt += tot; }
                }
            }
            nsel = TOPK;
        }
        LDS_WAIT();
        __syncthreads();
        if (mask & 4) {
            int lane = lane0; asm volatile("" : "+v"(lane));
            const int fr = lane & 15, fq = lane >> 4;
            const unsigned kbn = DS_BNC + wave * 16384, vbn = kbn + 8192;
            const pg8::bf16x8 q0 = *(const pg8::bf16x8*)(Qb + (tokb + p) * DM + fr * 64 + 8 * fq), q1 = *(const pg8::bf16x8*)(Qb + (tokb + p) * DM + fr * 64 + 32 + 8 * fq);
            const char* kvbase = (const char*)(KVb + tokb * 128);
            const int gr = lane >> 3, gc = lane & 7;
#define DS_ROFF(g_, ro_) do { const v4u i0_ = *(const LAS v4u*)((const LAS unsigned char*)idx + (64 * (g_) + 8 * gr) * 4), i1_ = *(const LAS v4u*)((const LAS unsigned char*)idx + (64 * (g_) + 8 * gr) * 4 + 16); \
                _Pragma("unroll") for (int j = 0; j < 4; ++j) { ro_[j] = i0_[j] + (unsigned)gc * 16u; ro_[4 + j] = i1_[j] + (unsigned)gc * 16u; } } while (0)
            v4u kreg[3][8], vreg[4][8];
#pragma unroll
            for (int g = 0; g < 3; ++g) { unsigned ro[8]; DS_ROFF(g, ro);
#pragma unroll
                for (int j = 0; j < 8; ++j) kreg[g][j] = *(const v4u*)(kvbase + ro[j]); }
            pg8::bf16x8 pf[8];
            const unsigned kfr = kbn + fr * 128;
            const int ksw = (fr >> 1) & 7;
#pragma unroll
            for (int g = 0; g < 4; ++g) {
                asm volatile("s_waitcnt lgkmcnt(0)" ::: "memory");
#pragma unroll
                for (int j = 0; j < 8; ++j) { const int rl = 8 * j + gr; *(LAS v4u*)(lds + kbn + rl * 128 + ((gc ^ ((rl >> 1) & 7)) << 4)) = kreg[g == 3 ? 0 : g][j]; }
                asm volatile("s_waitcnt lgkmcnt(0)" ::: "memory");
                f32x4 pt[4];
#pragma unroll
                for (int tt = 0; tt < 4; ++tt) {
                    const pg8::bf16x8 k0 = *(const LAS pg8::bf16x8*)(lds + kfr + tt * 2048 + ((fq ^ ksw) << 4)), k1 = *(const LAS pg8::bf16x8*)(lds + kfr + tt * 2048 + (((4 + fq) ^ ksw) << 4));
                    f32x4 d = (f32x4){0.f, 0.f, 0.f, 0.f};
                    d = __builtin_amdgcn_mfma_f32_16x16x32_bf16(k0, q0, d, 0, 0, 0); pt[tt] = __builtin_amdgcn_mfma_f32_16x16x32_bf16(k1, q1, d, 0, 0, 0); }
#pragma unroll
                for (int tt = 0; tt < 4; ++tt) {
#pragma unroll
                    for (int r = 0; r < 4; ++r) pt[tt][r] = __builtin_amdgcn_exp2f(pt[tt][r]);
                    if (nsel < TOPK) {
#pragma unroll
                        for (int r = 0; r < 4; ++r) { const int rl = 16 * tt + 4 * fq + r; if (64 * g + 8 * (rl & 7) + (rl >> 3) >= nsel) pt[tt][r] = 0.f; } } }
#pragma unroll
                for (int h2 = 0; h2 < 2; ++h2) { v4u w; w.x = pg8::cvt_pk_bf16(pt[2 * h2][0], pt[2 * h2][1]); w.y = pg8::cvt_pk_bf16(pt[2 * h2][2], pt[2 * h2][3]);
                    w.z = pg8::cvt_pk_bf16(pt[2 * h2 + 1][0], pt[2 * h2 + 1][1]); w.w = pg8::cvt_pk_bf16(pt[2 * h2 + 1][2], pt[2 * h2 + 1][3]); pf[2 * g + h2] = __builtin_bit_cast(pg8::bf16x8, w); }
                if (g == 0) { unsigned ro[8]; DS_ROFF(3, ro);
#pragma unroll
                    for (int j = 0; j < 8; ++j) kreg[0][j] = *(const v4u*)(kvbase + ro[j]); }
                else { unsigned ro[8]; DS_ROFF(g - 1, ro);
#pragma unroll
                  for (int j = 0; j < 8; ++j) vreg[g - 1][j] = *(const v4u*)(kvbase + ro[j] + 128u); }
            }
            f32x4 o[4], osum = (f32x4){0.f, 0.f, 0.f, 0.f};
#pragma unroll
            for (int dt = 0; dt < 4; ++dt) o[dt] = (f32x4){0.f, 0.f, 0.f, 0.f};
            pg8::bf16x8 ones;
#pragma unroll
            for (int e = 0; e < 8; ++e) ones[e] = (short)0x3f80;
            const int trow = 4 * fq + (fr >> 2), tsw = (trow >> 1) & 3;
            const unsigned tbase = vbn + trow * 128 + (fr & 3) * 8;
#pragma unroll
            for (int g = 0; g < 4; ++g) {
                asm volatile("s_waitcnt lgkmcnt(0)" ::: "memory");
#pragma unroll
                for (int j = 0; j < 8; ++j) { const int rl = 8 * j + gr; *(LAS v4u*)(lds + vbn + rl * 128 + (((((gc >> 1) ^ ((rl >> 1) & 3)) << 1) | (gc & 1)) << 4)) = vreg[g][j]; }
                if (g == 0) { unsigned ro[8]; DS_ROFF(3, ro);
#pragma unroll
                    for (int j = 0; j < 8; ++j) vreg[3][j] = *(const v4u*)(kvbase + ro[j] + 128u); }
                asm volatile("s_waitcnt lgkmcnt(0)" ::: "memory");
#pragma unroll
                for (int s2l = 0; s2l < 2; ++s2l) {
#pragma unroll
                    for (int dt = 0; dt < 4; ++dt) { const unsigned a0 = tbase + s2l * 4096 + ((dt ^ tsw) << 5);
                        const s16x4v lo = __builtin_bit_cast(s16x4v, __builtin_amdgcn_ds_read_tr16_b64_v4i16((LAS s16x4v*)(lds + a0)));
                        const s16x4v hi = __builtin_bit_cast(s16x4v, __builtin_amdgcn_ds_read_tr16_b64_v4i16((LAS s16x4v*)(lds + a0 + 2048)));
                        const pg8::bf16x8 vf = __builtin_shufflevector(lo, hi, 0, 1, 2, 3, 4, 5, 6, 7);
                        o[dt] = __builtin_amdgcn_mfma_f32_16x16x32_bf16(vf, pf[2 * g + s2l], o[dt], 0, 0, 0); }
                    osum = __builtin_amdgcn_mfma_f32_16x16x32_bf16(ones, pf[2 * g + s2l], osum, 0, 0, 0);
                }
            }
#undef DS_ROFF
            const float rinv = 1.f / osum[0];
            bf16* op = AO + (tokb + p) * DM + fr * 64 + 4 * fq;
#pragma unroll
            for (int dt = 0; dt < 4; ++dt) { u32x2v w; w.x = pg8::cvt_pk_bf16(o[dt][0] * rinv, o[dt][1] * rinv); w.y = pg8::cvt_pk_bf16(o[dt][2] * rinv, o[dt][3] * rinv); *(u32x2v*)(op + 16 * dt) = w; }
        }
        asm volatile("s_waitcnt vmcnt(0) lgkmcnt(0)" ::: "memory");
        __syncthreads();
    }
}

struct Args { const float* in[21]; float* out; unsigned char* ws; RopeInv rinv; int ph_lo, ph_hi, dsa_mask, pad; };
static_assert(sizeof(Args) == 21 * 8 + 8 + 8 + 128 + 16, "Args has no padding");

__global__ void __launch_bounds__(NTHREADS, 2) mk_fwd(Args args) {
    extern __shared__ __attribute__((aligned(16))) unsigned char lds_raw[];
    LAS unsigned char* lds = (LAS unsigned char*)lds_raw;
    const int tid = threadIdx.x, lane = tid & 63, wave = __builtin_amdgcn_readfirstlane(tid >> 6);
    const int G = gridDim.x, bx = blockIdx.x;
    const int vcu = (G % 8 == 0) ? (bx % 8) * (G / 8) + bx / 8 : bx;
    unsigned char* ws = args.ws;
    volatile LAS unsigned* MISC = (volatile LAS unsigned*)(lds + MISC_OFF);
    if (tid < 64) MISC[tid] = 0u;
    __syncthreads();
    const int lo = args.ph_lo, hi = args.ph_hi;
    XcdBarrier bar; bar.bar = (unsigned*)(ws + WS_CTL) + CW_BAR; bar.x = 0; bar.st = nullptr;
    if (hi - lo > 1) bar = xcd_barrier_post((unsigned*)(ws + WS_CTL) + CW_BAR, MISC + 8);
#define IN(k) (lo <= (k) && (k) < hi)
#define SEAM(k) do { if (IN(k) && IN((k) + 1)) xcd_barrier(bar); } while (0)
    const float* mod = (const float*)(ws + WS_MOD);
    bf16* H = (bf16*)(ws + WS_H);
    const float* x_in = args.in[0]; float* xo = args.out;
    bf16* XR = (bf16*)(ws + WS_XR);

    if (IN(0)) { phase_prep<0>(args.in, ws, lds, args.rinv, tid, lane, wave, bx, G); } SEAM(0);
    if (IN(1)) { phase_norm<false>(x_in, args.in[2], mod + 0 * DM, mod + 1 * DM, H, lane, wave, vcu, G); phase_prep<1>(args.in, ws, lds, args.rinv, tid, lane, wave, bx, G); } SEAM(1);
    if (IN(2)) { pg8::Gemm g{H, (const bf16*)(ws + WS_WAIN), MTOK, 2 * DRNN, DM}; pg8::StaticOrder S; S.init(MTOK, 2 * DRNN, G, bx);
        pg8::EpiXbGate E{(bf16*)(ws + WS_XB), (bf16*)(ws + WS_GATE)};
        pg8::gemm_phase<pg8::EpiXbGate, pg8::StaticOrder, true, true>(lds, g, S, E); } SEAM(2);
    if (IN(3)) { if (bx < 160) phase_rglru(args.in, ws, lds, tid, lane, wave, bx); else phase_prep<2>(args.in, ws, lds, args.rinv, tid, lane, wave, bx - 160, G - 160); } SEAM(3);
    if (IN(4)) { pg8::Gemm g{(const bf16*)(ws + WS_Y), (const bf16*)(ws + WS_WAOUT), MTOK, DM, DRNN}; pg8::StaticOrder S; S.init(MTOK, DM, G, bx);
        pg8::EpiRes<false, true> E{x_in, XR, mod + 2 * DM};
        pg8::gemm_phase<pg8::EpiRes<false, true>, pg8::StaticOrder, true, true>(lds, g, S, E); } SEAM(4);
    if (IN(5)) { phase_norm<true>(XR, args.in[3], mod + 3 * DM, mod + 4 * DM, H, lane, wave, vcu, G); } SEAM(5);
    if (IN(6)) { pg8::Gemm g{H, (const bf16*)(ws + WS_W1), MTOK, DFF, DM}; pg8::StaticOrder S; S.init(MTOK, DFF, G, bx);
        pg8::EpiRelu2 E{(bf16*)(ws + WS_BIG)};
        pg8::gemm_phase<pg8::EpiRelu2, pg8::StaticOrder, true, true>(lds, g, S, E); } SEAM(6);
    if (IN(7)) { pg8::Gemm g{(const bf16*)(ws + WS_BIG), (const bf16*)(ws + WS_W2), MTOK, DM, DFF, 1, 1}; pg8::StaticOrder S; S.init(MTOK, DM, G, bx);
        pg8::EpiRes<true, true> E{XR, XR, mod + 5 * DM};
        pg8::gemm_phase<pg8::EpiRes<true, true>, pg8::StaticOrder, true, true>(lds, g, S, E); } SEAM(7);
    const float* mod1 = mod + NB * NMOD;
    if (IN(8)) { phase_norm<true>(XR, args.in[2] + DM, mod1 + 0 * DM, mod1 + 1 * DM, H, lane, wave, vcu, G); } SEAM(8);
    if (IN(9)) { pg8::Gemm g{H, (const bf16*)(ws + WS_WBIN), MTOK, BINP, DM}; pg8::StaticOrder S; S.init(MTOK, BINP, G, bx);
        pg8::EpiIn1 E{(bf16*)(ws + WS_Q), (bf16*)(ws + WS_QI), (bf16*)(ws + WS_KV), (bf16*)(ws + WS_KV) + 64, (bf16*)(ws + WS_KI), (float*)(ws + WS_WI), (const float*)(ws + WS_ROPE), args.in[16], args.in[17]};
        pg8::gemm_phase<pg8::EpiIn1, pg8::StaticOrder, true, true>(lds, g, S, E); } SEAM(9);
    if (IN(10)) { phase_dsa(ws, lds, tid, lane, wave, bx, G, args.dsa_mask); } SEAM(10);
    if (IN(11)) { pg8::Gemm g{(const bf16*)(ws + WS_AO), (const bf16*)(ws + WS_WBOUT), MTOK, DM, DM}; pg8::StaticOrder S; S.init(MTOK, DM, G, bx);
        pg8::EpiRes<true, true> E{XR, XR, mod1 + 2 * DM};
        pg8::gemm_phase<pg8::EpiRes<true, true>, pg8::StaticOrder, true, true>(lds, g, S, E); } SEAM(11);
    if (IN(12)) { phase_norm<true>(XR, args.in[3] + DM, mod1 + 3 * DM, mod1 + 4 * DM, H, lane, wave, vcu, G); } SEAM(12);
    if (IN(13)) { pg8::Gemm g{H, (const bf16*)(ws + WS_W1) + (size_t)DFF * DM, MTOK, DFF, DM}; pg8::StaticOrder S; S.init(MTOK, DFF, G, bx);
        pg8::EpiRelu2 E{(bf16*)(ws + WS_BIG)};
        pg8::gemm_phase<pg8::EpiRelu2, pg8::StaticOrder, true, true>(lds, g, S, E); } SEAM(13);
    if (IN(14)) { pg8::Gemm g{(const bf16*)(ws + WS_BIG), (const bf16*)(ws + WS_W2) + (size_t)DM * DFF, MTOK, DM, DFF, 1, 1}; pg8::StaticOrder S; S.init(MTOK, DM, G, bx);
        pg8::EpiRes<true, false> E{XR, xo, mod1 + 5 * DM};
        pg8::gemm_phase<pg8::EpiRes<true, false>, pg8::StaticOrder, true, true>(lds, g, S, E); }
#undef IN
#undef SEAM
}

extern "C" void kernel_launch(void* const* d_in, const int* in_sizes, int n_in, void* d_out, int out_size, void* d_ws, size_t ws_size, hipStream_t stream) {
    static int grid = 0;
    if (grid == 0) {
        if (n_in != 21 || in_sizes[0] != MTOK * DM || out_size != MTOK * DM || ws_size < WS_END) {
            fprintf(stderr, "kernel_launch: unexpected shapes: n_in %d in0 %d out %d ws %zu (need >= %zu); nothing launched\n", n_in, n_in > 0 ? in_sizes[0] : -1, out_size, ws_size, (size_t)WS_END); grid = -1; return; }
        int dev = 0, cus = 0, per_cu = 0;
        if (hipGetDevice(&dev) != hipSuccess || hipDeviceGetAttribute(&cus, hipDeviceAttributeMultiprocessorCount, dev) != hipSuccess) { fprintf(stderr, "kernel_launch: device query failed\n"); grid = -1; return; }
        if (hipFuncSetAttribute((const void*)mk_fwd, hipFuncAttributeMaxDynamicSharedMemorySize, LDS_BYTES) != hipSuccess) { fprintf(stderr, "kernel_launch: hipFuncSetAttribute(%d B LDS) failed\n", LDS_BYTES); grid = -1; return; }
        if (hipOccupancyMaxActiveBlocksPerMultiprocessor(&per_cu, (const void*)mk_fwd, NTHREADS, LDS_BYTES) != hipSuccess || per_cu < 1)
            fprintf(stderr, "kernel_launch: note: occupancy query reports %d workgroups per CU\n", per_cu);
        (void)hipGetLastError();
        grid = cus;
    }
    if (grid < 0) return;
    if (hipMemsetAsync((char*)d_ws + WS_CTL, 0, CTL_ZERO_BYTES, stream) != hipSuccess) { fprintf(stderr, "kernel_launch: memset failed\n"); return; }
    Args a{};
    for (int i = 0; i < 21; ++i) a.in[i] = (const float*)d_in[i];
    a.out = (float*)d_out; a.ws = (unsigned char*)d_ws; a.dsa_mask = 7;
    for (int i = 0; i < 32; ++i) a.rinv.v[i] = powf(10000.0f, -(float)(2 * i) / 64.0f);
    for (int li = 0; li < N_LAUNCHES; ++li) {
        if (N_LAUNCHES == 1) { a.ph_lo = 0; a.ph_hi = N_PHASES; } else { a.ph_lo = li; a.ph_hi = li + 1; }
        const int reps = (N_LAUNCHES != 1 && li == PROBE_PH) ? PROBE_N : 1;
        for (int r = 0; r < reps; ++r) {
            a.dsa_mask = (r + 1 < reps) ? PROBE_MASK : 7;
            hipLaunchKernelGGL(mk_fwd, dim3(grid), dim3(NTHREADS), LDS_BYTES, stream, a);
            const hipError_t le = hipPeekAtLastError();
            if (le != hipSuccess) { fprintf(stderr, "kernel_launch: launch %d failed: %s\n", li, hipGetErrorName(le)); break; }
        }
    }
}
```

```cpp
#include <hip/hip_runtime.h>
#include <cstdio>
#include <cstdint>
#include <cmath>
#define MK_N_LAUNCHES 1
#define PROBE_PH -1
#define PROBE_N 1
#define PROBE_MASK 7
namespace pg8 {
#define PG8_LAS __attribute__((address_space(3)))
typedef unsigned short bf16_t;
typedef short bf16x8 __attribute__((ext_vector_type(8)));
typedef float f32x4 __attribute__((ext_vector_type(4)));
typedef unsigned u32x4 __attribute__((ext_vector_type(4)));
constexpr int BM = 256, BK = 64, HALF = 128, HTB = HALF * BK * 2  , STAGE_BYTES = 8 * HTB, NXCD = 8, WGM = 8;

__host__ __device__ __forceinline__ int lds_byte(int r, int c) { const int st = (r >> 4) * 2 + (c >> 5), rr = r & 15, cc = c & 31, ob = rr * 64 + cc * 2; return st * 1024 + (ob ^ (((ob >> 9) & 1) << 5)); }
__host__ __device__ __forceinline__ void stage_rc(int b, int& R, int& C) { const int st = b / 1024, sb = b % 1024, swz = sb ^ (((sb >> 9) & 1) << 5); R = (st >> 1) * 16 + swz / 64; C = (st & 1) * 32 + (swz % 64) / 2; }
__host__ __device__ __forceinline__ int perm32(int rho) { const int n = rho >> 4, i = rho & 15; return 8 * (i >> 2) + 4 * n + (i & 3); }

struct Unit { int pm, pn; };
struct Gemm { const bf16_t* A; const bf16_t* Bt; int M, N, K; int tiledA, tiledB; };

struct StaticOrder {
    int nM, nN, nwg, G, c;
    __host__ __device__ void init(int M, int N, int G_, int c_) { nM = M / BM; nN = N / BM; nwg = nM * nN; G = G_; c = c_; }
    __host__ __device__ bool next(int i, Unit& u) const {
        const long L = (long)i * G + c; if (L >= nwg) return false;
        int wgid = (int)L; { const int q = nwg / NXCD, r = nwg % NXCD, xcd = wgid % NXCD, off = wgid / NXCD; wgid = (xcd < r ? xcd * (q + 1) : r * (q + 1) + (xcd - r) * q) + off; }
        const int nig = WGM * nN, gid = wgid / nig, fm = gid * WGM, gsz = (nM - fm) < WGM ? (nM - fm) : WGM;
        u.pm = fm + ((wgid % nig) % gsz); u.pn = (wgid % nig) / gsz; return true;
    }
    __device__ __forceinline__ void a_ready(const Unit&) const {}
    __device__ __forceinline__ void done(const Unit&) const {}
};

struct FlowOrder {
    int b, y, nround, t0, tlim; const unsigned* rdy;
    __device__ __forceinline__ bool next(int i, Unit& u) const { if (i >= nround) return false; const int t = t0 + 12 * i + y; if (t >= tlim) return false; u.pm = 16 * b + (t >> 2); u.pn = t & 3; return true; }
    __device__ __forceinline__ void a_ready(const Unit& u) const {
        const unsigned* p = rdy + u.pm;
        for (unsigned sp = 0; __hip_atomic_load(p, __ATOMIC_RELAXED, __HIP_MEMORY_SCOPE_AGENT) < 20u && sp < (1u << 22); ++sp) __builtin_amdgcn_s_sleep(4);
        asm volatile("" ::: "memory");
    }
    __device__ __forceinline__ void done(const Unit&) const {}
};

__device__ __forceinline__ unsigned cvt_pk_bf16(float lo, float hi) { unsigned r; asm volatile("v_cvt_pk_bf16_f32 %0, %1, %2" : "=v"(r) : "v"(lo), "v"(hi)); return r; }
typedef float f32x2 __attribute__((ext_vector_type(2)));
template <class Epi, class Sched, bool ALIGN_EPI = false, bool SP2 = false>
__device__ __forceinline__ void gemm_phase(PG8_LAS unsigned char* lds, const Gemm g, const Sched& S, const Epi& E) {
    const int tid = threadIdx.x, wid = __builtin_amdgcn_readfirstlane(tid >> 6), lane = tid & 63, wr = wid >> 2, wc = wid & 3, fr = lane & 15, fq = lane >> 4;
    const int K = g.K, nt = K / BK;
    constexpr int NVM = ALIGN_EPI ? Epi::NVM : 0;
    unsigned voffA[2], voffB[2];
#pragma unroll
    for (int i = 0; i < 2; ++i) { int R, C; stage_rc(tid * 16 + i * 8192, R, C); const int Rb = Epi::PERM ? ((R & ~31) + perm32(R & 31)) : R;
        voffA[i] = (unsigned)(R * (g.tiledA ? BK : K) + C) * 2u; voffB[i] = (unsigned)(Rb * (g.tiledB ? BK : K) + C) * 2u; }
    const size_t kstepA = g.tiledA ? (size_t)BM * BK * 2 : (size_t)(BK * 2), hstepA = g.tiledA ? (size_t)HALF * BK * 2 : (size_t)HALF * K * 2, tstepA = (size_t)BM * K * 2;
    const size_t kstepB = g.tiledB ? (size_t)BM * BK * 2 : (size_t)(BK * 2), hstepB = g.tiledB ? (size_t)HALF * BK * 2 : (size_t)HALF * K * 2, tstepB = (size_t)BM * K * 2;
    const unsigned ldsw = (unsigned)wid * 1024u;
    const int aoff = lds_byte(wr * 64 + fr, fq * 8), boff = lds_byte(wc * 32 + fr, fq * 8);
#define PG8_SA(b, h) (((b) * 2 + (h)) * HTB)
#define PG8_SB(b, h) ((4 + (b) * 2 + (h)) * HTB)
#define PG8_STAGE(bufoff, gbase, voff) do { const char* gb_ = (const char*)(gbase); asm volatile("" : "+s"(gb_));     \
        _Pragma("unroll") for (int _i = 0; _i < 2; ++_i) \
        __builtin_amdgcn_global_load_lds((const unsigned*)(gb_ + (voff)[_i]), (PG8_LAS unsigned*)(lds + (bufoff) + ldsw + _i * 8192), 16, 0, 0); } while (0)
#define PG8_LDA(dst, b, h) do { _Pragma("unroll") for (int m = 0; m < 4; ++m) _Pragma("unroll") for (int k = 0; k < 2; ++k) dst[m][k] = *(const PG8_LAS bf16x8*)(lds + PG8_SA(b, h) + aoff + m * 2048 + k * 1024); } while (0)
#define PG8_LDB(dst, b, h) do { _Pragma("unroll") for (int n = 0; n < 2; ++n) _Pragma("unroll") for (int k = 0; k < 2; ++k) dst[n][k] = *(const PG8_LAS bf16x8*)(lds + PG8_SB(b, h) + boff + n * 2048 + k * 1024); } while (0)
#define PG8_MMA(ai, bj, At, Bt) do { __builtin_amdgcn_s_setprio(1); _Pragma("unroll") for (int m = 0; m < 4; ++m) _Pragma("unroll") for (int n = 0; n < 2; ++n) _Pragma("unroll") for (int k = 0; k < 2; ++k) \
        acc[ai][bj][m][n] = __builtin_amdgcn_mfma_f32_16x16x32_bf16(Bt[n][k], At[m][k], acc[ai][bj][m][n], 0, 0, 0); __builtin_amdgcn_s_setprio(0); } while (0)
#define PG8_MMA0(ai, bj, At, Bt) do { __builtin_amdgcn_s_setprio(1); _Pragma("unroll") for (int m = 0; m < 4; ++m) _Pragma("unroll") for (int n = 0; n < 2; ++n) \
        acc[ai][bj][m][n] = __builtin_amdgcn_mfma_f32_16x16x32_bf16(Bt[n][0], At[m][0], (f32x4){0.f, 0.f, 0.f, 0.f}, 0, 0, 0); \
        _Pragma("unroll") for (int m = 0; m < 4; ++m) _Pragma("unroll") for (int n = 0; n < 2; ++n) \
        acc[ai][bj][m][n] = __builtin_amdgcn_mfma_f32_16x16x32_bf16(Bt[n][1], At[m][1], acc[ai][bj][m][n], 0, 0, 0); __builtin_amdgcn_s_setprio(0); } while (0)
#define PG8_WAIT_V(n) asm volatile("s_waitcnt vmcnt(" #n ")" ::: "memory")
#define PG8_WAIT_VN(n) asm volatile("s_waitcnt vmcnt(%0)" :: "n"(n) : "memory")
#define PG8_WAIT_L(n) asm volatile("s_waitcnt lgkmcnt(" #n ")" ::: "memory")
#define PG8_BAR __builtin_amdgcn_s_barrier()
#define PG8_SCHED __builtin_amdgcn_sched_barrier(0)
    Unit cur, nxt; int ui = 0;
    if (!S.next(0, cur)) return;
    f32x4 acc[2][2][4][2];
    bf16x8 At[4][2], B0[2][2], B1[2][2];
    const char* cA = (const char*)g.A + (size_t)cur.pm * tstepA; const char* cB = (const char*)g.Bt + (size_t)cur.pn * tstepB;
    S.a_ready(cur);
    static_assert(SP2 && ALIGN_EPI, "only the two-super-phase loop with aligned epilogues is kept");
    PG8_STAGE(PG8_SB(0, 0), cB, voffB); PG8_STAGE(PG8_SB(0, 1), cB + hstepB, voffB); PG8_STAGE(PG8_SA(0, 0), cA, voffA); PG8_STAGE(PG8_SA(0, 1), cA + hstepA, voffA);
    PG8_STAGE(PG8_SB(1, 0), cB + kstepB, voffB); PG8_STAGE(PG8_SA(1, 0), cA + kstepA, voffA); PG8_STAGE(PG8_SB(1, 1), cB + hstepB + kstepB, voffB); PG8_STAGE(PG8_SA(1, 1), cA + hstepA + kstepA, voffA);
    if (wr == 1) PG8_BAR;
    PG8_WAIT_V(0); PG8_BAR;
    PG8_BAR;
    for (;;) {
        const bool has_next = S.next(ui + 1, nxt);
        const char* nA = has_next ? (const char*)g.A + (size_t)nxt.pm * tstepA : cA; const char* nB = has_next ? (const char*)g.Bt + (size_t)nxt.pn * tstepB : cB;
        {   const char* a2 = cA + (size_t)2 * kstepA; const char* b2 = cB + (size_t)2 * kstepB; const char* a3 = a2 + kstepA; const char* b3 = b2 + kstepB;
            PG8_LDB(B0, 0, 0); PG8_LDB(B1, 0, 1); PG8_SCHED; PG8_LDA(At, 0, 0);
            PG8_WAIT_VN(8 + NVM); PG8_WAIT_L(0); PG8_BAR; PG8_MMA0(0, 0, At, B0); PG8_MMA0(0, 1, At, B1); PG8_BAR; PG8_SCHED;
            PG8_LDA(At, 0, 1); PG8_STAGE(PG8_SB(0, 0), b2, voffB); PG8_STAGE(PG8_SB(0, 1), b2 + hstepB, voffB); PG8_STAGE(PG8_SA(0, 0), a2, voffA);
            PG8_WAIT_VN(8 + NVM); PG8_WAIT_L(0); PG8_BAR; PG8_MMA0(1, 0, At, B0); PG8_MMA0(1, 1, At, B1); PG8_BAR; PG8_SCHED;
            PG8_LDB(B0, 1, 0); PG8_LDB(B1, 1, 1); PG8_SCHED; PG8_LDA(At, 1, 0); PG8_STAGE(PG8_SA(0, 1), a2 + hstepA, voffA);
            PG8_WAIT_VN(8 + NVM); PG8_WAIT_L(0); PG8_BAR; PG8_MMA(0, 0, At, B0); PG8_MMA(0, 1, At, B1); PG8_BAR; PG8_SCHED;
            PG8_LDA(At, 1, 1); PG8_STAGE(PG8_SB(1, 0), b3, voffB); PG8_STAGE(PG8_SB(1, 1), b3 + hstepB, voffB); PG8_STAGE(PG8_SA(1, 0), a3, voffA);
            PG8_WAIT_V(8); PG8_WAIT_L(0); PG8_BAR; PG8_MMA(1, 0, At, B0); PG8_MMA(1, 1, At, B1); PG8_BAR; PG8_SCHED;
        }
        for (int t = 2; t < nt; t += 2) {
            const bool last = (t == nt - 2);
            const char* a1 = cA + (size_t)(t + 1) * kstepA;
            const char* a2 = last ? nA : cA + (size_t)(t + 2) * kstepA; const char* b2 = last ? nB : cB + (size_t)(t + 2) * kstepB;
            const char* a3 = a2 + kstepA; const char* b3 = b2 + kstepB;
            if (last && has_next) S.a_ready(nxt);
            if constexpr (SP2) {
            PG8_LDB(B0, 0, 0); PG8_LDB(B1, 0, 1); PG8_SCHED; PG8_LDA(At, 0, 0); PG8_STAGE(PG8_SA(1, 1), a1 + hstepA, voffA);
            PG8_WAIT_V(8); PG8_WAIT_L(0); PG8_BAR; PG8_MMA(0, 0, At, B0); PG8_MMA(0, 1, At, B1); PG8_BAR; PG8_SCHED;
            PG8_LDA(At, 0, 1); PG8_STAGE(PG8_SB(0, 0), b2, voffB); PG8_STAGE(PG8_SB(0, 1), b2 + hstepB, voffB); PG8_STAGE(PG8_SA(0, 0), a2, voffA);
            PG8_WAIT_V(8); PG8_WAIT_L(0); PG8_BAR; PG8_MMA(1, 0, At, B0); PG8_MMA(1, 1, At, B1); PG8_BAR; PG8_SCHED;
            PG8_LDB(B0, 1, 0); PG8_LDB(B1, 1, 1); PG8_SCHED; PG8_LDA(At, 1, 0); PG8_STAGE(PG8_SA(0, 1), a2 + hstepA, voffA);
            PG8_WAIT_V(8); PG8_WAIT_L(0); PG8_BAR; PG8_MMA(0, 0, At, B0); PG8_MMA(0, 1, At, B1); PG8_BAR; PG8_SCHED;
            PG8_LDA(At, 1, 1); PG8_STAGE(PG8_SB(1, 0), b3, voffB); PG8_STAGE(PG8_SB(1, 1), b3 + hstepB, voffB); PG8_STAGE(PG8_SA(1, 0), a3, voffA);
            PG8_WAIT_V(8); PG8_WAIT_L(0); PG8_BAR; PG8_MMA(1, 0, At, B0); PG8_MMA(1, 1, At, B1); PG8_BAR; PG8_SCHED;
            } else {
            PG8_LDB(B0, 0, 0); PG8_SCHED; PG8_LDA(At, 0, 0); PG8_STAGE(PG8_SA(1, 1), a1 + hstepA, voffA);
            PG8_WAIT_L(8); PG8_BAR; PG8_WAIT_L(0); PG8_MMA(0, 0, At, B0); PG8_BAR; PG8_SCHED;
            PG8_LDB(B1, 0, 1); PG8_STAGE(PG8_SB(0, 0), b2, voffB);
            PG8_BAR; PG8_WAIT_L(0); PG8_MMA(0, 1, At, B1); PG8_BAR;
            PG8_LDA(At, 0, 1); PG8_STAGE(PG8_SA(0, 0), a2, voffA);
            PG8_BAR; PG8_WAIT_L(0); PG8_MMA(1, 0, At, B0); PG8_BAR; PG8_SCHED;
            PG8_STAGE(PG8_SB(0, 1), b2 + hstepB, voffB);
            PG8_WAIT_V(6); PG8_BAR; PG8_MMA(1, 1, At, B1); PG8_BAR;
            PG8_LDB(B0, 1, 0); PG8_SCHED; PG8_LDA(At, 1, 0); PG8_STAGE(PG8_SA(0, 1), a2 + hstepA, voffA);
            PG8_WAIT_L(8); PG8_BAR; PG8_WAIT_L(0); PG8_MMA(0, 0, At, B0); PG8_BAR; PG8_SCHED;
            PG8_LDB(B1, 1, 1); PG8_STAGE(PG8_SB(1, 0), b3, voffB);
            PG8_BAR; PG8_WAIT_L(0); PG8_MMA(0, 1, At, B1); PG8_BAR;
            PG8_LDA(At, 1, 1); PG8_STAGE(PG8_SA(1, 0), a3, voffA);
            PG8_BAR; PG8_WAIT_L(0); PG8_MMA(1, 0, At, B0); PG8_BAR; PG8_SCHED;
            PG8_STAGE(PG8_SB(1, 1), b3 + hstepB, voffB);
            PG8_WAIT_V(6); PG8_BAR; PG8_MMA(1, 1, At, B1); PG8_BAR;
            }
        }
        if constexpr (ALIGN_EPI) { if (wr == 0) PG8_BAR; }
        PG8_STAGE(PG8_SA(1, 1), nA + kstepA + hstepA, voffA); PG8_SCHED;
        if constexpr (!Epi::AFTER_DRAIN) { int fr_ = fr, fq_ = fq; asm volatile("" : "+v"(fr_), "+v"(fq_));
            E(acc, cur, wr, wc, fr_, fq_); S.done(cur); }
        if (!has_next) break;
        cur = nxt; cA = nA; cB = nB; ++ui;
        if constexpr (ALIGN_EPI) { if (wr == 1) PG8_BAR; }
    }
    PG8_WAIT_V(0);
    if constexpr (!ALIGN_EPI) { if (wr == 0) PG8_BAR; }
    PG8_BAR;
    if constexpr (Epi::AFTER_DRAIN) { E.fused(acc, cur, wr, wc, fr, fq, lds, wid, lane); S.done(cur); }
#undef PG8_SA
#undef PG8_SB
#undef PG8_STAGE
#undef PG8_LDA
#undef PG8_LDB
#undef PG8_MMA
#undef PG8_MMA0
#undef PG8_WAIT_V
#undef PG8_WAIT_VN
#undef PG8_WAIT_L
#undef PG8_BAR
#undef PG8_SCHED
}
}
#define GAS __attribute__((address_space(1)))
#define LAS __attribute__((address_space(3)))
typedef unsigned short bf16;
typedef unsigned v4u __attribute__((ext_vector_type(4)));
typedef float f32x4 __attribute__((ext_vector_type(4)));
typedef short bf16x8 __attribute__((ext_vector_type(8)));
typedef GAS unsigned gu32;
typedef GAS unsigned long long gu64;
#define RLX_AGENT __ATOMIC_RELAXED, __HIP_MEMORY_SCOPE_AGENT
#define LDS_WAIT() asm volatile("s_waitcnt lgkmcnt(0)" ::: "memory")
#define VM_WAIT() asm volatile("s_waitcnt vmcnt(0)" ::: "memory")
__device__ __forceinline__ unsigned long long rt() { return __builtin_amdgcn_s_memrealtime(); }
__device__ __forceinline__ unsigned f2bf(float f) { unsigned u = __builtin_bit_cast(unsigned, f); return (u + 0x7fffu + ((u >> 16) & 1u)) >> 16; }
__device__ __forceinline__ unsigned pk2(float lo, float hi) { return f2bf(lo) | (f2bf(hi) << 16); }

#define XB_TMO      128
#define XB_XCNT(j)  (256  + 64 * (j))
#define XB_XSUB(j)  (1280 + 64 * (j))
#define XB_XGEN(j)  (2304 + 64 * (j))
#define XB_TOP      3328
#define XB_TOPGEN   3392
#define XCD_BAR_WORDS 3456
#define XB_SPIN_CAP (1u << 18)

__device__ __forceinline__ unsigned xb_ld(unsigned* p)              { return __hip_atomic_load(p, __ATOMIC_RELAXED, __HIP_MEMORY_SCOPE_AGENT); }
__device__ __forceinline__ unsigned xb_add(unsigned* p, unsigned v) { return __hip_atomic_fetch_add(p, v, __ATOMIC_RELAXED, __HIP_MEMORY_SCOPE_AGENT); }
__device__ __forceinline__ unsigned xb_xcc_id() { return (unsigned)__builtin_amdgcn_s_getreg((3 << 11) | 20) & 0xFu; }
#define XB_SPIN(cond, bar) do { unsigned _sp = 0; while (cond) { __builtin_amdgcn_s_sleep(1); \
    if ((++_sp & 255u) == 0u) { if (xb_ld(&(bar)[XB_TMO])) break; if (_sp > XB_SPIN_CAP) { atomicAdd(&(bar)[XB_TMO], 1u); break; } } } } while (0)

struct XcdBarrier {
    unsigned* bar; unsigned x;
    volatile LAS unsigned* st;
};

__device__ __forceinline__ XcdBarrier xcd_barrier_post(unsigned* bar, volatile LAS unsigned* st) {
    XcdBarrier b; b.bar = bar; b.x = xb_xcc_id(); b.st = st;
    if (threadIdx.x == 0) (void)xb_add(&bar[XB_XCNT(b.x)], 1u);
    return b;
}
__device__ __forceinline__ void xcd_barrier_complete(unsigned* bar, unsigned x, unsigned& nloc, unsigned& nx) {
    const unsigned G = gridDim.x * gridDim.y * gridDim.z;
    unsigned sum, cnt, mine, sp = 0u;
    for (;;) {
        sum = 0u; cnt = 0u; mine = 0u;
#pragma unroll
        for (unsigned j = 0; j < 16; ++j) { const unsigned c = xb_ld(&bar[XB_XCNT(j)]); sum += c; cnt += (c > 0u) ? 1u : 0u; mine = (j == x) ? c : mine; }
        if (sum == G) break;
        __builtin_amdgcn_s_sleep(1);
        if ((++sp & 255u) == 0u) { if (xb_ld(&bar[XB_TMO])) break; if (sp > XB_SPIN_CAP) { atomicAdd(&bar[XB_TMO], 1u); break; } }
    }
    nloc = mine > 0u ? mine : 1u; nx = cnt > 0u ? cnt : 1u;
}

__device__ __forceinline__ void xcd_barrier(const XcdBarrier& b) {
    asm volatile("s_waitcnt vmcnt(0)" ::: "memory");
    __syncthreads();
    if (threadIdx.x == 0) {
        unsigned* bar = b.bar;
        __builtin_amdgcn_s_waitcnt(0);
        unsigned nloc = b.st[0], nx = b.st[1];
        if (nloc == 0u) { xcd_barrier_complete(bar, b.x, nloc, nx); b.st[0] = nloc; b.st[1] = nx; }
        const unsigned old = xb_add(&bar[XB_XSUB(b.x)], 1u);
        const unsigned gen = old / nloc;
        if (old + 1u == (gen + 1u) * nloc) {
            __builtin_amdgcn_fence(__ATOMIC_RELEASE, "agent");
            asm volatile("s_waitcnt vmcnt(0)" ::: "memory");
            const unsigned og = xb_add(&bar[XB_TOP], 1u);
            const unsigned tg = og / nx;
            if (og + 1u == (tg + 1u) * nx) xb_add(&bar[XB_TOPGEN], 1u);
            else XB_SPIN(xb_ld(&bar[XB_TOPGEN]) == tg, bar);
            __builtin_amdgcn_fence(__ATOMIC_ACQUIRE, "agent");
            xb_add(&bar[XB_XGEN(b.x)], 1u);
            asm volatile("s_waitcnt vmcnt(0)" ::: "memory");
        } else {
            XB_SPIN(xb_ld(&bar[XB_XGEN(b.x)]) == gen, bar);
            __builtin_amdgcn_fence(__ATOMIC_ACQUIRE, "agent");
            asm volatile("s_waitcnt vmcnt(0)" ::: "memory");
        }
    }
    __syncthreads();
}

__device__ __forceinline__ void grp_barrier(unsigned* bar, unsigned* xtab, unsigned* grp, volatile LAS unsigned* pure_w, int bx) {
    asm volatile("s_waitcnt vmcnt(0)" ::: "memory");
    __syncthreads();
    if (threadIdx.x == 0) {
        __builtin_amdgcn_s_waitcnt(0);
        unsigned pure = *pure_w;
        if (pure == 0u) {
            const unsigned mine = xb_ld(xtab + bx); unsigned ok = (mine != 0u) ? 1u : 0u;
            for (int k = 0; k < 32; ++k) ok &= (xb_ld(xtab + (bx & 7) + 8 * k) == mine) ? 1u : 0u;
            pure = ok ? 1u : 2u; *pure_w = pure; }
        unsigned* cnt = grp + 64 * (bx & 7);
        if (pure != 1u) { __builtin_amdgcn_fence(__ATOMIC_RELEASE, "agent"); asm volatile("s_waitcnt vmcnt(0)" ::: "memory"); }
        const unsigned old = xb_add(cnt, 1u), target = (old / 32u + 1u) * 32u;
        XB_SPIN(xb_ld(cnt) < target, bar);
        __builtin_amdgcn_fence(__ATOMIC_ACQUIRE, "agent");
        asm volatile("s_waitcnt vmcnt(0)" ::: "memory");
    }
    __syncthreads();
}

constexpr int NB = 8, SEQ = 4096, DM = 1024, MTOK = NB * SEQ, DFF = 4096, DRNN = 1280, NLB = 5, LBLK = 256;
constexpr int NHEAD = 16, HD = 64, IH = 8, TOPK = 256, BIN = 1736, BINP = 1792, NMOD = 6 * DM;
constexpr float RMS_EPS = 1e-6f;
constexpr int NWAVES = 8, NTHREADS = 512;
constexpr int N_PHASES = 15;
constexpr int N_LAUNCHES = MK_N_LAUNCHES;

constexpr size_t MiB = 1u << 20;
constexpr size_t WS_CTL = 0, CTL_ZERO_BYTES = 64 * 1024;
constexpr int CW_PREP2 = 15424;
constexpr int CW_XTAB = 14336, CW_GRP = 14848;
constexpr int FLOW_NC = 352;
constexpr int CW_RDY = 12288;
constexpr int CW_BAR = 4096;
constexpr size_t WS_MOD = 1 * MiB;
constexpr size_t WS_ROPE = 2 * MiB;
constexpr size_t WS_WAIN = 4 * MiB;
constexpr size_t WS_WAOUT = 9 * MiB;
constexpr size_t WS_WGATE = 12 * MiB;
constexpr size_t WS_WBIN = 14 * MiB;
constexpr size_t WS_WBOUT = 18 * MiB;
constexpr size_t WS_W1 = 20 * MiB;
constexpr size_t WS_W2 = 36 * MiB;
constexpr size_t WS_H = 64 * MiB;
constexpr size_t WS_BIG = 128 * MiB;
constexpr size_t L0_XB = 0, L0_GATE = 10 * MiB, L0_Y = 20 * MiB, NAT_L0 = 10 * MiB;
constexpr size_t L1_SLAB = 32 * MiB, L1_Q = 0, L1_QI = 8 * MiB, L1_KV = 12 * MiB, L1_KI = 13 * MiB, L1_WI = 13 * MiB + 512 * 1024, L1_AO = 14 * MiB;
constexpr size_t NAT_Q = 8 * MiB, NAT_QI = 4 * MiB, NAT_KV = 1 * MiB, NAT_KI = 512 * 1024, NAT_WI = 128 * 1024, NAT_AO = 8 * MiB;
#define L1_PTR(ws_, b_, off_, nat_) ((ws_) + WS_BIG + (size_t)(b_) * (L1_SLAB - (nat_)) + (off_))
constexpr size_t WS_XR = 384 * MiB;
constexpr size_t WS_END = 448 * MiB;

constexpr int LDS_BYTES = 163840;
constexpr int MISC_OFF = LDS_BYTES - 256;

typedef float f32x2v __attribute__((ext_vector_type(2)));
typedef __bf16 bf16x2_t __attribute__((ext_vector_type(2)));
__device__ __forceinline__ unsigned cvtpk(float lo, float hi) { const f32x2v v = {lo, hi}; return __builtin_bit_cast(unsigned, __builtin_convertvector(v, bf16x2_t)); }
#define pk2 cvtpk
typedef unsigned u32x2v __attribute__((ext_vector_type(2)));
typedef short s16x4v __attribute__((ext_vector_type(4)));

__device__ __forceinline__ float wave_sum(float v) {
#pragma unroll
    for (int o = 1; o < 64; o <<= 1) v += __shfl_xor(v, o);
    return v;
}
__device__ __forceinline__ float bf2f(unsigned short h) { return __builtin_bit_cast(float, (unsigned)h << 16); }
__device__ __forceinline__ float bflo(unsigned w) { return __builtin_bit_cast(float, w << 16); }
__device__ __forceinline__ float bfhi(unsigned w) { return __builtin_bit_cast(float, w & 0xffff0000u); }
__device__ __forceinline__ float sigmoidf_(float x) { return __builtin_amdgcn_rcpf(1.f + __builtin_amdgcn_exp2f(-1.4426950408889634f * x)); }

namespace pg8 {
__device__ __forceinline__ f32x2 gelu_tanh2(f32x2 x) {
    f32x2 u = (x * ((x * x) * 0.044715f + 1.0f)) * -2.302208198f;
    u.x = __builtin_amdgcn_exp2f(u.x); u.y = __builtin_amdgcn_exp2f(u.y); u = u + 1.0f;
    f32x2 r; r.x = __builtin_amdgcn_rcpf(u.x); r.y = __builtin_amdgcn_rcpf(u.y); return x * r;
}
struct EpiXbGate {
    static constexpr bool PERM = true, AFTER_DRAIN = false; static constexpr int NVM = 16;
    bf16_t* XB; bf16_t* GT;
    __device__ __forceinline__ void operator()(const f32x4 (&acc)[2][2][4][2], const Unit& u, int wr, int wc, int fr, int fq) const {
        const bool isg = u.pn >= 5;
        char* ub = (char*)(isg ? GT : XB) + ((size_t)u.pm * BM * DRNN + (size_t)(isg ? u.pn - 5 : u.pn) * BM) * 2;
        unsigned lo = (unsigned)(((wr * 64 + fr) * DRNN + wc * 32 + 8 * fq) * 2); asm volatile("" : "+v"(lo));
#pragma unroll
        for (int ai = 0; ai < 2; ++ai)
#pragma unroll
            for (int m = 0; m < 4; ++m) {
#pragma unroll
                for (int bj = 0; bj < 2; ++bj) { const f32x4 v0 = acc[ai][bj][m][0], v1 = acc[ai][bj][m][1];
                    f32x2 p0 = (f32x2){v0[0], v0[1]}, p1 = (f32x2){v0[2], v0[3]}, p2 = (f32x2){v1[0], v1[1]}, p3 = (f32x2){v1[2], v1[3]};
                    if (isg) { p0 = gelu_tanh2(p0); p1 = gelu_tanh2(p1); p2 = gelu_tanh2(p2); p3 = gelu_tanh2(p3); }
                    u32x4 w; w.x = cvtpk(p0.x, p0.y); w.y = cvtpk(p1.x, p1.y); w.z = cvtpk(p2.x, p2.y); w.w = cvtpk(p3.x, p3.y);
                    *(u32x4*)(ub + (lo + (unsigned)(((ai * HALF + m * 16) * DRNN + bj * HALF) * 2))) = w; } }
    }
};
template <bool RB, bool OB> struct EpiRes {
    static constexpr bool PERM = OB, AFTER_DRAIN = false; static constexpr int NVM = OB ? 16 : 32;
    const void* res; void* out; const float* gate;
    __device__ __forceinline__ static f32x2 bfpair(unsigned w) { return (f32x2){__builtin_bit_cast(float, w << 16), __builtin_bit_cast(float, w & 0xffff0000u)}; }
    __device__ __forceinline__ void operator()(const f32x4 (&acc)[2][2][4][2], const Unit& u, int wr, int wc, int fr, int fq) const {
        constexpr int nst = PERM ? 4 : 16, RS = RB ? 2 : 4, OS = OB ? 2 : 4;
        const size_t ue = (size_t)u.pm * BM * DM + (size_t)u.pn * BM;
        const char* rb = (const char*)res + ue * RS; char* ob = (char*)out + ue * OS;
        const unsigned le = (unsigned)((wr * 64 + fr) * DM + wc * 32 + (PERM ? 8 * fq : 4 * fq));
        f32x2 gv[2][2][2];
        { const float* gb = gate + (u.pm >> 4) * NMOD + u.pn * BM + wc * 32 + (PERM ? 8 * fq : 4 * fq);
#pragma unroll
          for (int bj = 0; bj < 2; ++bj)
#pragma unroll
            for (int n = 0; n < 2; ++n) { const f32x4 t = *(const f32x4*)(gb + bj * HALF + n * nst); gv[bj][n][0] = (f32x2){t[0], t[1]}; gv[bj][n][1] = (f32x2){t[2], t[3]}; } }
        constexpr int NP = RB ? 1 : 2, AP = 2 / NP;
#pragma unroll
        for (int part = 0; part < NP; ++part) {
            u32x4 rw[AP][4][2][(RB && PERM) ? 1 : 2]; f32x4 rf[AP][4][2][2];
#pragma unroll
            for (int a = 0; a < AP; ++a)
#pragma unroll
                for (int m = 0; m < 4; ++m)
#pragma unroll
                    for (int bj = 0; bj < 2; ++bj) { const unsigned eo = le + (unsigned)(((part * AP + a) * HALF + m * 16) * DM + bj * HALF);
                        if (RB && PERM) rw[a][m][bj][0] = *(const u32x4*)(rb + eo * RS);
                        else {
#pragma unroll
                            for (int n = 0; n < 2; ++n) {
                                if (RB) { const u32x2v w = *(const u32x2v*)(rb + (eo + n * nst) * RS); rw[a][m][bj][n].x = w.x; rw[a][m][bj][n].y = w.y; }
                                else rf[a][m][bj][n] = *(const f32x4*)(rb + (eo + n * nst) * RS); } } }
#pragma unroll
            for (int a = 0; a < AP; ++a)
#pragma unroll
                for (int m = 0; m < 4; ++m)
#pragma unroll
                    for (int bj = 0; bj < 2; ++bj) { const int ai = part * AP + a; const unsigned eo = le + (unsigned)((ai * HALF + m * 16) * DM + bj * HALF);
                        f32x2 o[2][2];
#pragma unroll
                        for (int n = 0; n < 2; ++n) { const f32x4 c = acc[ai][bj][m][n]; f32x2 r0, r1;
                            if (RB && PERM) { const u32x4 w = rw[a][m][bj][0]; r0 = bfpair(n ? w.z : w.x); r1 = bfpair(n ? w.w : w.y); }
                            else if (RB) { r0 = bfpair(rw[a][m][bj][n].x); r1 = bfpair(rw[a][m][bj][n].y); }
                            else { const f32x4 w = rf[a][m][bj][n]; r0 = (f32x2){w[0], w[1]}; r1 = (f32x2){w[2], w[3]}; }
                            o[n][0] = r0 + gv[bj][n][0] * (f32x2){c[0], c[1]}; o[n][1] = r1 + gv[bj][n][1] * (f32x2){c[2], c[3]}; }
                        if (OB) { u32x4 w; w.x = cvtpk(o[0][0].x, o[0][0].y); w.y = cvtpk(o[0][1].x, o[0][1].y); w.z = cvtpk(o[1][0].x, o[1][0].y); w.w = cvtpk(o[1][1].x, o[1][1].y);
                            *(u32x4*)(ob + eo * OS) = w; }
                        else { *(f32x4*)(ob + eo * OS) = (f32x4){o[0][0].x, o[0][0].y, o[0][1].x, o[0][1].y}; *(f32x4*)(ob + (eo + nst) * OS) = (f32x4){o[1][0].x, o[1][0].y, o[1][1].x, o[1][1].y}; } }
            if (part + 1 < NP) asm volatile("" ::: "memory");
        }
    }
};
struct EpiRelu2 {
    static constexpr bool PERM = true, AFTER_DRAIN = false; static constexpr int NVM = 16;
    bf16_t* O;
    __device__ __forceinline__ void operator()(const f32x4 (&acc)[2][2][4][2], const Unit& u, int wr, int wc, int fr, int fq) const {
        char* ub = (char*)O + (size_t)(u.pm * (DFF / 64) + u.pn * 4) * (256 * 64 * 2);
        unsigned lo = (unsigned)((((wc >> 1) * 256 + wr * 64 + fr) * 64 + (wc & 1) * 32 + 8 * fq) * 2); asm volatile("" : "+v"(lo));
#pragma unroll
        for (int ai = 0; ai < 2; ++ai)
#pragma unroll
            for (int m = 0; m < 4; ++m) {
#pragma unroll
                for (int bj = 0; bj < 2; ++bj) { const f32x4 v0 = acc[ai][bj][m][0], v1 = acc[ai][bj][m][1];
                    f32x2 p0 = (f32x2){__builtin_amdgcn_fmed3f(v0[0], 0.f, 3.0e38f), __builtin_amdgcn_fmed3f(v0[1], 0.f, 3.0e38f)}, p1 = (f32x2){__builtin_amdgcn_fmed3f(v0[2], 0.f, 3.0e38f), __builtin_amdgcn_fmed3f(v0[3], 0.f, 3.0e38f)};
                    f32x2 p2 = (f32x2){__builtin_amdgcn_fmed3f(v1[0], 0.f, 3.0e38f), __builtin_amdgcn_fmed3f(v1[1], 0.f, 3.0e38f)}, p3 = (f32x2){__builtin_amdgcn_fmed3f(v1[2], 0.f, 3.0e38f), __builtin_amdgcn_fmed3f(v1[3], 0.f, 3.0e38f)};
                    p0 = p0 * p0; p1 = p1 * p1; p2 = p2 * p2; p3 = p3 * p3;
                    u32x4 w; w.x = cvtpk(p0.x, p0.y); w.y = cvtpk(p1.x, p1.y); w.z = cvtpk(p2.x, p2.y); w.w = cvtpk(p3.x, p3.y);
                    *(u32x4*)(ub + (lo + (unsigned)(((ai * HALF + m * 16) * 64 + bj * 2 * 256 * 64) * 2))) = w; } }
    }
};
struct EpiIn1 {
    static constexpr bool PERM = true, AFTER_DRAIN = false; static constexpr int NVM = 0;
    bf16_t *Q, *QI, *K, *V, *KI; float* WI; const float* rope; const float *qg, *kg;
    __device__ __forceinline__ void operator()(const f32x4 (&acc)[2][2][4][2], const Unit& u, int wr, int wc, int fr, int fq) const {
        const int pn = u.pn;
        int kind;
        bf16_t* dst; int pitch, hoff;
        if (pn < 4) { kind = 0; dst = Q; pitch = DM; hoff = (4 * pn + wc) * 64; }
        else if (pn < 6) { kind = 1; dst = QI; pitch = 512; hoff = (4 * (pn - 4) + wc) * 64; }
        else if (wc == 0) { kind = 2; dst = K; pitch = 128; hoff = 0; }
        else if (wc == 1) { kind = 3; dst = KI; pitch = 64; hoff = 0; }
        else if (wc == 2) { kind = 4; dst = V; pitch = 128; hoff = 0; }
        else { kind = 5; dst = nullptr; pitch = 0; hoff = 0; }
        const bool donorm = (kind == 0 || kind == 2), dorope = (kind <= 3);
        const float osc = (kind == 0) ? 0.125f * 1.4426950408889634f : 1.f;
        f32x4 g1[2], g2[2];
#pragma unroll
        for (int n = 0; n < 2; ++n) { g1[n] = (f32x4){1.f, 1.f, 1.f, 1.f}; g2[n] = g1[n]; }
        if (kind == 0) {
#pragma unroll
            for (int n = 0; n < 2; ++n) { g1[n] = *(const f32x4*)(qg + 8 * fq + 4 * n); g2[n] = *(const f32x4*)(qg + 32 + 8 * fq + 4 * n); } }
        if (kind == 2) {
#pragma unroll
            for (int n = 0; n < 2; ++n) { g1[n] = *(const f32x4*)(kg + 8 * fq + 4 * n); g2[n] = *(const f32x4*)(kg + 32 + 8 * fq + 4 * n); } }
#pragma unroll
        for (int ai = 0; ai < 2; ++ai)
#pragma unroll
            for (int m = 0; m < 4; ++m) {
                const int row = u.pm * BM + ai * HALF + wr * 64 + m * 16 + fr, pos = row & (SEQ - 1);
                f32x4 x1[2], x2[2];
#pragma unroll
                for (int n = 0; n < 2; ++n) { x1[n] = acc[ai][0][m][n]; x2[n] = acc[ai][1][m][n]; }
                if (kind == 5) {
                    if (fq == 0) { *(f32x4*)(WI + (size_t)row * 8) = x1[0]; *(f32x4*)(WI + (size_t)row * 8 + 4) = x1[1]; }
                    continue;
                }
                if (donorm) {
                    float ss = 0.f;
#pragma unroll
                    for (int n = 0; n < 2; ++n)
#pragma unroll
                        for (int j = 0; j < 4; ++j) ss += x1[n][j] * x1[n][j] + x2[n][j] * x2[n][j];
                    ss += __shfl_xor(ss, 16); ss += __shfl_xor(ss, 32);
                    const float rs = 1.0f / sqrtf(ss * (1.f / 64.f) + RMS_EPS);
#pragma unroll
                    for (int n = 0; n < 2; ++n) { x1[n] = x1[n] * rs * g1[n]; x2[n] = x2[n] * rs * g2[n]; }
                }
                if (dorope) {
#pragma unroll
                    for (int n = 0; n < 2; ++n) { const f32x4 c = *(const f32x4*)(rope + pos * 32 + 8 * fq + 4 * n), s = *(const f32x4*)(rope + SEQ * 32 + pos * 32 + 8 * fq + 4 * n);
                        const f32x4 o1 = x1[n] * c - x2[n] * s, o2 = x2[n] * c + x1[n] * s; x1[n] = o1; x2[n] = o2; }
                }
#pragma unroll
                for (int n = 0; n < 2; ++n) { x1[n] = x1[n] * osc; x2[n] = x2[n] * osc; }
                bf16_t* rowp = (kind == 3) ? dst + (size_t)(row >> 4) * 1024 + fq * 128 + (row & 15) * 8 : dst + (size_t)row * pitch + hoff + 8 * fq;
                const int hi_off = (kind == 3) ? 512 : 32;
                u32x4 w; w.x = cvt_pk_bf16(x1[0][0], x1[0][1]); w.y = cvt_pk_bf16(x1[0][2], x1[0][3]); w.z = cvt_pk_bf16(x1[1][0], x1[1][1]); w.w = cvt_pk_bf16(x1[1][2], x1[1][3]);
                *(u32x4*)(rowp) = w;
                w.x = cvt_pk_bf16(x2[0][0], x2[0][1]); w.y = cvt_pk_bf16(x2[0][2], x2[0][3]); w.z = cvt_pk_bf16(x2[1][0], x2[1][1]); w.w = cvt_pk_bf16(x2[1][2], x2[1][3]);
                *(u32x4*)(rowp + hi_off) = w;
            }
    }
};
}

__device__ __forceinline__ int bin_row(int c) {
    if (c < 1024) { const int h = c >> 6, d = c & 63; return 256 * (h >> 2) + 128 * (d >> 5) + 32 * (h & 3) + (d & 31); }
    if (c < 1088) { const int d = c - 1024; return 1536 + 128 * (d >> 5) + (d & 31); }
    if (c < 1152) { const int d = c - 1088; return 1536 + 128 * (d >> 5) + 64 + (d & 31); }
    if (c < 1664) { const int cc = c - 1152, h = cc >> 6, d = cc & 63; return 256 * (4 + (h >> 2)) + 128 * (d >> 5) + 32 * (h & 3) + (d & 31); }
    if (c < 1728) { const int d = c - 1664; return 1536 + 128 * (d >> 5) + 32 + (d & 31); }
    return 1536 + 96 + (c - 1728);
}
template <int MODE>
__device__ __forceinline__ void tr_item(const float* W, int K, int N, bf16* WT, int item, LAS float* scr, int lane) {
    const int nblk = (N + 31) / 32, kb = item / nblk, nb = item % nblk, k0 = 64 * kb, n0 = 32 * nb;
    const int nn = n0 + (lane & 31); const bool nok = nn < N;
    float wv[32];
#pragma unroll
    for (int i = 0; i < 32; ++i) { const int kk = 2 * i + (lane >> 5); wv[i] = nok ? W[(size_t)(k0 + kk) * N + nn] : 0.f; }
#pragma unroll
    for (int i = 0; i < 32; ++i) { const int kk = 2 * i + (lane >> 5); scr[kk * 33 + (lane & 31)] = wv[i]; }
    LDS_WAIT(); asm volatile("" ::: "memory");
    const int c = lane & 7;
#pragma unroll
    for (int j = 0; j < 4; ++j) { const int n = (lane >> 3) + 8 * j, ncol = n0 + n; const LAS float* s = scr + (8 * c) * 33 + n;
        v4u o; o.x = pk2(s[0 * 33], s[1 * 33]); o.y = pk2(s[2 * 33], s[3 * 33]); o.z = pk2(s[4 * 33], s[5 * 33]); o.w = pk2(s[6 * 33], s[7 * 33]);
        if (ncol < N) {
            if (MODE == 3) *(GAS v4u*)(WT + ((size_t)((ncol >> 8) * (K / 64) + (k0 >> 6)) * 256 + (ncol & 255)) * 64 + 8 * c) = o;
            else { const int drow = (MODE == 0) ? ncol : bin_row(ncol); *(GAS v4u*)(WT + (size_t)drow * K + k0 + 8 * c) = o; } } }
    LDS_WAIT(); asm volatile("" ::: "memory");
}

struct RopeInv { float v[32]; };

template <int PART>
__device__ __forceinline__ void phase_prep(const float* const* in, unsigned char* ws, LAS unsigned char* lds, const RopeInv& rinv, int tid, int lane, int wave, int bx, int G) {
  constexpr bool LATE = PART == 2;
  if (PART == 0) {
    if (bx < 192) {
        LAS float* cond = (LAS float*)lds; LAS float* part = (LAS float*)(lds + 32768);
        const float* cin = in[1];
        for (int i = tid; i < NB * DM; i += NTHREADS) { const float v = cin[i]; cond[i] = v / (1.f + __expf(-v)); }
        __syncthreads();
        const int l = bx / 96, c0 = 64 * (bx % 96), cq = tid & 15, kg = tid >> 4;
        f32x4 a[NB];
#pragma unroll
        for (int b = 0; b < NB; ++b) a[b] = (f32x4){0.f, 0.f, 0.f, 0.f};
        const float* wp = in[4] + (size_t)l * DM * NMOD + c0 + 4 * cq;
#pragma unroll 4
        for (int kk = 0; kk < 32; ++kk) { const int k = kg * 32 + kk; const f32x4 w = *(const f32x4*)(wp + (size_t)k * NMOD);
#pragma unroll
            for (int b = 0; b < NB; ++b) { const float cv = cond[b * DM + k]; a[b] += w * cv; } }
#pragma unroll
        for (int b = 0; b < NB; ++b) *(LAS f32x4*)(part + (kg * NB + b) * 64 + 4 * cq) = a[b];
        __syncthreads();
        { const int b = tid >> 6, col = tid & 63; float s = 0.f;
#pragma unroll 8
          for (int k2 = 0; k2 < 32; ++k2) s += part[(k2 * NB + b) * 64 + col];
          ((float*)(ws + WS_MOD))[(size_t)(l * NB + b) * NMOD + c0 + col] = s + in[5][l * NMOD + c0 + col]; }
        __syncthreads();
    }
    return;
  }
  if (LATE) {
    { float* rope = (float*)(ws + WS_ROPE);
      for (int idx = bx * NTHREADS + tid; idx < SEQ * 32; idx += G * NTHREADS) { const int pos = idx >> 5, i = idx & 31;
          const float ang = (float)pos * rinv.v[i]; const double a = (double)ang; const double k = rint(a * 0.15915494309189535); const float x = (float)(a * 0.15915494309189535 - k);
          rope[idx] = __builtin_amdgcn_cosf(x); rope[SEQ * 32 + idx] = __builtin_amdgcn_sinf(x); } }
    { bf16* wb = (bf16*)(ws + WS_WBIN);
      for (int i = bx * NTHREADS + tid; i < 56 * 128; i += G * NTHREADS) { const int r = i >> 7, c8 = i & 127; const int row = r < 24 ? 1536 + 96 + 8 + r : 1536 + 128 + 96 + (r - 24);
          *(GAS v4u*)(wb + (size_t)row * DM + 8 * c8) = (v4u){0u, 0u, 0u, 0u}; } }
  }
    LAS float* scr = (LAS float*)(lds + wave * 16384);
    const int gw = bx * NWAVES + wave, NGW = G * NWAVES;
    constexpr int I_AIN = 16 * 80, I_AOUT = 20 * 32, I_G1 = 4 * 8, I_GATES = 10 * I_G1, I_BIN = 16 * 55, I_BOUT = 16 * 32, I_W1 = 16 * 128, I_W2 = 64 * 32;
    constexpr int NEARLY = I_AIN + I_GATES + I_AOUT, NLATE = 2 * I_W1 + 2 * I_W2 + I_BIN + I_BOUT;
    for (int it = gw; it < (LATE ? NLATE : NEARLY); it += NGW) {
        int r = it;
        if (!LATE) {
            if (r < I_AIN) { tr_item<0>(in[6], DM, 2 * DRNN, (bf16*)(ws + WS_WAIN), r, scr, lane); continue; } r -= I_AIN;
            if (r < I_GATES) { const int mi = r / I_G1, n = mi >> 1, gsel = mi & 1;
              tr_item<0>(in[gsel ? 11 : 9] + (size_t)n * LBLK * LBLK, LBLK, LBLK, (bf16*)(ws + WS_WGATE) + (size_t)(n * 2 + gsel) * LBLK * LBLK, r % I_G1, scr, lane); continue; } r -= I_GATES;
            tr_item<0>(in[14], DRNN, DM, (bf16*)(ws + WS_WAOUT), r, scr, lane); continue;
        }
        if (r < I_W1 * 2) { const int l = r / I_W1; tr_item<0>(in[19] + (size_t)l * DM * DFF, DM, DFF, (bf16*)(ws + WS_W1) + (size_t)l * DFF * DM, r % I_W1, scr, lane); continue; } r -= 2 * I_W1;
        if (r < I_W2 * 2) { const int l = r / I_W2; tr_item<3>(in[20] + (size_t)l * DFF * DM, DFF, DM, (bf16*)(ws + WS_W2) + (size_t)l * DM * DFF, r % I_W2, scr, lane); continue; } r -= 2 * I_W2;
        if (r < I_BIN) { tr_item<1>(in[15], DM, BIN, (bf16*)(ws + WS_WBIN), r, scr, lane); continue; } r -= I_BIN;
        tr_item<0>(in[18], DM, DM, (bf16*)(ws + WS_WBOUT), r, scr, lane);
    }
}

template <bool XB16>
__device__ __forceinline__ void phase_norm(const void* x, const float* g, const float* mod_sh, const float* mod_sc, bf16* H, int lane, int wave, int vcu, int G) {
    const int gw = vcu * NWAVES + wave, NGW = G * NWAVES;
    for (int r0 = gw * 16; r0 < MTOK; r0 += NGW * 16) {
        const int b = r0 >> 12;
        f32x4 al[4], be[4];
#pragma unroll
        for (int j = 0; j < 4; ++j) { const int c = XB16 ? 8 * lane + 512 * (j >> 1) + 4 * (j & 1) : 4 * lane + 256 * j;
            const f32x4 gg = *(const f32x4*)(g + c), sc = *(const f32x4*)(mod_sc + b * NMOD + c); al[j] = gg * (sc + 1.f); be[j] = *(const f32x4*)(mod_sh + b * NMOD + c); }
#pragma unroll 2
        for (int rr = 0; rr < 16; ++rr) {
            f32x4 v[4]; float s = 0.f;
            if (XB16) {
                const GAS v4u* xr = (const GAS v4u*)((const bf16*)x + (size_t)(r0 + rr) * DM) + lane;
#pragma unroll
                for (int j = 0; j < 2; ++j) { const v4u w = xr[64 * j];
                    v[2 * j] = (f32x4){bflo(w.x), bfhi(w.x), bflo(w.y), bfhi(w.y)}; v[2 * j + 1] = (f32x4){bflo(w.z), bfhi(w.z), bflo(w.w), bfhi(w.w)}; }
            } else {
                const GAS f32x4* xr = (const GAS f32x4*)((const float*)x + (size_t)(r0 + rr) * DM) + lane;
#pragma unroll
                for (int j = 0; j < 4; ++j) v[j] = xr[64 * j];
            }
#pragma unroll
            for (int j = 0; j < 4; ++j) s += (v[j].x * v[j].x + v[j].y * v[j].y) + (v[j].z * v[j].z + v[j].w * v[j].w);
            const float rstd = 1.0f / sqrtf(wave_sum(s) * (1.f / DM) + RMS_EPS);
            f32x4 y[4];
#pragma unroll
            for (int j = 0; j < 4; ++j) y[j] = v[j] * rstd * al[j] + be[j];
            if (XB16) {
                GAS v4u* o16 = (GAS v4u*)(H + (size_t)(r0 + rr) * DM) + lane;
#pragma unroll
                for (int j = 0; j < 2; ++j) { v4u o; o.x = pk2(y[2 * j].x, y[2 * j].y); o.y = pk2(y[2 * j].z, y[2 * j].w); o.z = pk2(y[2 * j + 1].x, y[2 * j + 1].y); o.w = pk2(y[2 * j + 1].z, y[2 * j + 1].w); o16[64 * j] = o; }
            } else {
                GAS unsigned long long* o8 = (GAS unsigned long long*)(H + (size_t)(r0 + rr) * DM) + lane;
#pragma unroll
                for (int j = 0; j < 4; ++j) o8[64 * j] = (unsigned long long)pk2(y[j].x, y[j].y) | ((unsigned long long)pk2(y[j].z, y[j].w) << 32);
            }
        }
    }
}

constexpr int RQ_CT = 128, RQ_AP = 528  , RQ_SP = 68  ;
constexpr int RQ_AT = 0, RQ_A = RQ_CT * RQ_AP, RQ_B = RQ_A + RQ_CT * RQ_SP * 4, RQ_SEG = RQ_B + RQ_CT * RQ_SP * 4, RQ_END = RQ_SEG + 16 * 32 * 16;
static_assert(RQ_END <= MISC_OFF, "rglru LDS map");
__device__ __forceinline__ f32x2v bf2x(unsigned w) { return (f32x2v){__builtin_bit_cast(float, w << 16), __builtin_bit_cast(float, w & 0xffff0000u)}; }
__device__ __forceinline__ void phase_rglru(const float* const* in, unsigned char* ws, LAS unsigned char* lds, int tid, int lane, int wave, int bx) {
    if (bx >= 160) return;
    const int b = bx & 7, n = (bx >> 3) >> 2, g = (bx >> 3) & 3;
    const bf16* XB = (const bf16*)L1_PTR(ws, b, L0_XB, NAT_L0); const bf16* GT = (const bf16*)L1_PTR(ws, b, L0_GATE, NAT_L0); bf16* Y = (bf16*)L1_PTR(ws, b, L0_Y, NAT_L0);
    const int fr = lane & 15, fq = lane >> 4, wr = wave >> 2, wc = wave & 3;
    pg8::bf16x8 Br[8], Bi[8];
    { const bf16* wr_ = (const bf16*)(ws + WS_WGATE) + (size_t)(n * 2 + 0) * LBLK * LBLK + (size_t)(64 * g + 16 * wc + fr) * LBLK + 8 * fq;
      const bf16* wi_ = wr_ + (size_t)LBLK * LBLK;
#pragma unroll
      for (int kk = 0; kk < 8; ++kk) { Br[kk] = *(const pg8::bf16x8*)(wr_ + 32 * kk); Bi[kk] = *(const pg8::bf16x8*)(wi_ + 32 * kk); } }
    const int chl0 = 16 * wc + 4 * fq, chg0 = LBLK * n + 64 * g + chl0;
    f32x2v brv[2], biv[2], nsp[2];
    { const f32x4 x = *(const f32x4*)(in[10] + chg0), y = *(const f32x4*)(in[12] + chg0), lam = *(const f32x4*)(in[13] + chg0);
      brv[0] = (f32x2v){x[0], x[1]}; brv[1] = (f32x2v){x[2], x[3]}; biv[0] = (f32x2v){y[0], y[1]}; biv[1] = (f32x2v){y[2], y[3]};
      float t[4];
#pragma unroll
      for (int j = 0; j < 4; ++j) t[j] = -8.f * 1.4426950408889634f * log1pf(__expf(-lam[j]));
      nsp[0] = (f32x2v){t[0], t[1]}; nsp[1] = (f32x2v){t[2], t[3]}; }
    const int cq = lane;
    const int cch = LBLK * n + 4 * cq;
    f32x2v cw[4][2], cb[2];
#pragma unroll
    for (int j = 0; j < 4; ++j) { const f32x4 w0 = *(const f32x4*)(in[7] + j * DRNN + cch); cw[j][0] = (f32x2v){w0[0], w0[1]}; cw[j][1] = (f32x2v){w0[2], w0[3]}; }
    { const f32x4 b0 = *(const f32x4*)(in[8] + cch); cb[0] = (f32x2v){b0[0], b0[1]}; cb[1] = (f32x2v){b0[2], b0[3]}; }
    const int cp = tid & 31, sg = tid >> 5;
    f32x2v hin = (f32x2v){0.f, 0.f};
    const size_t tok0 = (size_t)b * SEQ;
    u32x2v xr[19];
#define RQ_LOADX(t0_) do { _Pragma("unroll") for (int i_ = 0; i_ < 19; ++i_) { const int t_ = (t0_) + 16 * wave - 3 + i_; \
        xr[i_] = (t_ >= 0) ? *(const GAS u32x2v*)(XB + (tok0 + t_) * DRNN + cch) : (u32x2v){0u, 0u}; } } while (0)
    RQ_LOADX(0);
    unsigned* rdy = (unsigned*)(ws + WS_CTL) + CW_RDY + b * 16;
    for (int c = 0; c < SEQ / RQ_CT; ++c) {
        const int t0 = c * RQ_CT;
        if ((c & 1) && c >= 3) asm volatile("s_waitcnt vmcnt(8)" ::: "memory");
        { f32x2v xf[19][2];
#pragma unroll
          for (int i = 0; i < 19; ++i) { xf[i][0] = bf2x(xr[i].x); xf[i][1] = bf2x(xr[i].y); }
#pragma unroll
          for (int tt = 0; tt < 16; ++tt) { f32x2v o0 = cb[0], o1 = cb[1];
#pragma unroll
              for (int j = 0; j < 4; ++j) { o0 += cw[j][0] * xf[tt + j][0]; o1 += cw[j][1] * xf[tt + j][1]; }
              u32x2v pk; pk.x = pk2(o0.x, o0.y); pk.y = pk2(o1.x, o1.y);
              *(LAS u32x2v*)(lds + RQ_AT + (16 * wave + tt) * RQ_AP + 8 * cq) = pk; } }
        if (c + 1 < SEQ / RQ_CT) RQ_LOADX(t0 + RQ_CT);
        unsigned gt[8];
        { const bf16* gp = GT + (tok0 + t0 + 8 * sg) * DRNN + LBLK * n + 64 * g + 2 * cp;
#pragma unroll
          for (int t = 0; t < 8; ++t) gt[t] = *(const GAS unsigned*)(gp + (size_t)t * DRNN); }
        __syncthreads();
        if ((c & 1) && c >= 3 && tid == 0) __hip_atomic_fetch_add(rdy + ((c - 3) >> 1), 1u, __ATOMIC_RELAXED, __HIP_MEMORY_SCOPE_AGENT);
        f32x4 ar[4], ai_[4];
#pragma unroll
        for (int m = 0; m < 4; ++m) { ar[m] = (f32x4){0.f, 0.f, 0.f, 0.f}; ai_[m] = ar[m]; }
#pragma unroll
        for (int kk = 0; kk < 8; ++kk)
#pragma unroll
            for (int m = 0; m < 4; ++m) { const pg8::bf16x8 xf = *(const LAS pg8::bf16x8*)(lds + RQ_AT + (64 * wr + 16 * m + fr) * RQ_AP + (32 * kk + 8 * fq) * 2);
                ar[m] = __builtin_amdgcn_mfma_f32_16x16x32_bf16(Br[kk], xf, ar[m], 0, 0, 0); ai_[m] = __builtin_amdgcn_mfma_f32_16x16x32_bf16(Bi[kk], xf, ai_[m], 0, 0, 0); }
#pragma unroll
        for (int m = 0; m < 4; ++m) { const int tk = 64 * wr + 16 * m + fr;
            const u32x2v xw = *(const LAS u32x2v*)(lds + RQ_AT + tk * RQ_AP + (64 * g + chl0) * 2);
            f32x4 av, bv;
#pragma unroll
            for (int h = 0; h < 2; ++h) { const f32x2v xc = bf2x(h ? xw.y : xw.x);
                f32x2v tr_ = ((f32x2v){ar[m][2 * h], ar[m][2 * h + 1]} + brv[h]) * -1.4426950408889634f, ti_ = ((f32x2v){ai_[m][2 * h], ai_[m][2 * h + 1]} + biv[h]) * -1.4426950408889634f;
                tr_.x = __builtin_amdgcn_exp2f(tr_.x); tr_.y = __builtin_amdgcn_exp2f(tr_.y); ti_.x = __builtin_amdgcn_exp2f(ti_.x); ti_.y = __builtin_amdgcn_exp2f(ti_.y);
                tr_ = tr_ + 1.0f; ti_ = ti_ + 1.0f;
                f32x2v rr, ii; rr.x = __builtin_amdgcn_rcpf(tr_.x); rr.y = __builtin_amdgcn_rcpf(tr_.y); ii.x = __builtin_amdgcn_rcpf(ti_.x); ii.y = __builtin_amdgcn_rcpf(ti_.y);
                f32x2v la = rr * nsp[h], a; a.x = __builtin_amdgcn_exp2f(la.x); a.y = __builtin_amdgcn_exp2f(la.y);
                f32x2v q = 1.0f - a * a, s; s.x = __builtin_amdgcn_sqrtf(__builtin_fabsf(q.x)); s.y = __builtin_amdgcn_sqrtf(__builtin_fabsf(q.y));
                const f32x2v bb = s * (ii * xc);
                av[2 * h] = a.x; av[2 * h + 1] = a.y; bv[2 * h] = bb.x; bv[2 * h + 1] = bb.y; }
            *(LAS f32x4*)(lds + RQ_A + (tk * RQ_SP + chl0) * 4) = av; *(LAS f32x4*)(lds + RQ_B + (tk * RQ_SP + chl0) * 4) = bv; }
        __syncthreads();
        f32x2v sa[8], sb[8];
#pragma unroll
        for (int t = 0; t < 8; ++t) { sa[t] = *(const LAS f32x2v*)(lds + RQ_A + ((8 * sg + t) * RQ_SP + 2 * cp) * 4); sb[t] = *(const LAS f32x2v*)(lds + RQ_B + ((8 * sg + t) * RQ_SP + 2 * cp) * 4); }
        { f32x2v A = sa[0], H = sb[0];
#pragma unroll
          for (int t = 1; t < 8; ++t) { A = A * sa[t]; H = sa[t] * H + sb[t]; }
          *(LAS f32x4*)(lds + RQ_SEG + (sg * 32 + cp) * 16) = (f32x4){A.x, A.y, H.x, H.y}; }
        __syncthreads();
        { f32x2v h = hin, mine = hin;
#pragma unroll
          for (int s = 0; s < 16; ++s) { const f32x4 sh = *(const LAS f32x4*)(lds + RQ_SEG + (s * 32 + cp) * 16); if (s == sg) mine = h; h = (f32x2v){sh[0], sh[1]} * h + (f32x2v){sh[2], sh[3]}; }
          hin = h;
          f32x2v hh = mine; bf16* yp = Y + (tok0 + t0 + 8 * sg) * DRNN + LBLK * n + 64 * g + 2 * cp;
#pragma unroll
          for (int t = 0; t < 8; ++t) { hh = sa[t] * hh + sb[t]; const f32x2v yv = hh * bf2x(gt[t]); __hip_atomic_store((unsigned*)(yp + (size_t)t * DRNN), pk2(yv.x, yv.y), __ATOMIC_RELAXED, __HIP_MEMORY_SCOPE_AGENT); } }
    }
#undef RQ_LOADX
    asm volatile("s_waitcnt vmcnt(0)" ::: "memory");
    __syncthreads();
    if (tid == 0) { __hip_atomic_fetch_add(rdy + 15, 1u, __ATOMIC_RELAXED, __HIP_MEMORY_SCOPE_AGENT); }
}

constexpr int DS_SCP = 8224;
constexpr int DS_ROWSET = 8 * DS_SCP, DS_HIST = 2 * DS_ROWSET, DS_IDX = DS_HIST + 8 * 2048, DS_END = DS_IDX + 8 * 1024;
static_assert(DS_END <= MISC_OFF, "dsa LDS map");

__device__ __forceinline__ unsigned mbcnt64(unsigned long long m) { return __builtin_amdgcn_mbcnt_hi((unsigned)(m >> 32), __builtin_amdgcn_mbcnt_lo((unsigned)m, 0u)); }
__device__ __forceinline__ void wave_prefix4(unsigned x, unsigned& pre, unsigned& tot) {
    pre = 0u; tot = 0u;
#pragma unroll
    for (int bit = 0; bit < 4; ++bit) { const unsigned long long m = __ballot((x >> bit) & 1u); pre += mbcnt64(m) << bit; tot += (unsigned)__popcll(m) << bit; }
}
__device__ __forceinline__ unsigned row_scan_u32(unsigned v) {
    v += (unsigned)__builtin_amdgcn_update_dpp(0, (int)v, 0x111, 0xf, 0xf, true);
    v += (unsigned)__builtin_amdgcn_update_dpp(0, (int)v, 0x112, 0xf, 0xf, true);
    v += (unsigned)__builtin_amdgcn_update_dpp(0, (int)v, 0x114, 0xf, 0xf, true);
    v += (unsigned)__builtin_amdgcn_update_dpp(0, (int)v, 0x118, 0xf, 0xf, true);
    return v;
}
__device__ __forceinline__ void hist_find4(v4u c4, unsigned need, int lane, unsigned& B, unsigned& above, unsigned& atb) {
    const unsigned s = c4.x + c4.y + c4.z + c4.w;
    const unsigned inc = row_scan_u32(s);
    const unsigned t0 = (unsigned)__builtin_amdgcn_readlane((int)inc, 15), t1 = (unsigned)__builtin_amdgcn_readlane((int)inc, 31), t2 = (unsigned)__builtin_amdgcn_readlane((int)inc, 47), t3 = (unsigned)__builtin_amdgcn_readlane((int)inc, 63);
    const int row = lane >> 4;
    const unsigned before = (row > 0 ? t0 : 0u) + (row > 1 ? t1 : 0u) + (row > 2 ? t2 : 0u) + (inc - s);
    const unsigned total = (t0 + t1) + (t2 + t3);
    const unsigned S = total - before;
    const unsigned long long mk = __ballot(S >= need);
    const int L = 63 - __builtin_clzll(mk | 1ull);
    unsigned cum = S - s, bin, ab, at;
    if (cum + c4.w >= need) { bin = 4 * lane + 3; ab = cum; at = c4.w; }
    else { cum += c4.w; if (cum + c4.z >= need) { bin = 4 * lane + 2; ab = cum; at = c4.z; }
        else { cum += c4.z; if (cum + c4.y >= need) { bin = 4 * lane + 1; ab = cum; at = c4.y; } else { cum += c4.y; bin = 4 * lane; ab = cum; at = c4.x; } } }
    B = __builtin_amdgcn_readlane(bin, L); above = __builtin_amdgcn_readlane(ab, L); atb = __builtin_amdgcn_readlane(at, L);
}
__device__ __forceinline__ void pk_count4(unsigned& a0, unsigned& a1, unsigned& a2, unsigned& a3, unsigned k0, unsigned k1, unsigned k2, unsigned k3, unsigned cm) {
    unsigned t0, t1, t2, t3;
    asm("v_pk_sub_u16 %4, %8, %12 clamp\n\tv_pk_sub_u16 %5, %9, %12 clamp\n\tv_pk_sub_u16 %6, %10, %12 clamp\n\tv_pk_sub_u16 %7, %11, %12 clamp\n\t"
        "v_pk_min_u16 %4, %4, 1 op_sel_hi:[1,0]\n\tv_pk_min_u16 %5, %5, 1 op_sel_hi:[1,0]\n\tv_pk_min_u16 %6, %6, 1 op_sel_hi:[1,0]\n\tv_pk_min_u16 %7, %7, 1 op_sel_hi:[1,0]\n\t"
        "v_pk_add_u16 %0, %0, %4\n\tv_pk_add_u16 %1, %1, %5\n\tv_pk_add_u16 %2, %2, %6\n\tv_pk_add_u16 %3, %3, %7"
        : "+v"(a0), "+v"(a1), "+v"(a2), "+v"(a3), "=&v"(t0), "=&v"(t1), "=&v"(t2), "=&v"(t3) : "v"(k0), "v"(k1), "v"(k2), "v"(k3), "v"(cm));
}
__device__ __forceinline__ unsigned pk_bin2(unsigned w, unsigned b1p) {
    unsigned t, g;
    asm("v_pk_sub_u16 %0, %2, %3\n\tv_and_or_b32 %1, %0, %4, %5\n\tv_pk_min_u16 %0, %0, %1" : "=&v"(t), "=&v"(g) : "v"(w), "v"(b1p), "v"(0x00ff00ffu), "v"(0x01000100u));
    return t;
}
typedef _Float16 h16x2 __attribute__((ext_vector_type(2)));
__device__ __forceinline__ h16x2 pkrtz(float a, float b) { return __builtin_bit_cast(h16x2, __builtin_amdgcn_cvt_pkrtz(a, b)); }
__device__ __forceinline__ unsigned score_key(float s) {
    const int h = (int)(short)__builtin_bit_cast(unsigned short, (_Float16)s);
    return ((unsigned)h ^ ((unsigned)(h >> 15) | 0x8000u)) & 0xffffu;
}

__device__ __forceinline__ void phase_dsa(unsigned char* ws, LAS unsigned char* lds, int tid, int lane, int wave, int bx, int G, int mask) {
    const int bb_ = bx & 7;
    const bf16* Qb = (const bf16*)L1_PTR(ws, bb_, L1_Q, NAT_Q); const bf16* QIb = (const bf16*)L1_PTR(ws, bb_, L1_QI, NAT_QI); const bf16* KVb = (const bf16*)L1_PTR(ws, bb_, L1_KV, NAT_KV);
    const bf16* KIb = (const bf16*)L1_PTR(ws, bb_, L1_KI, NAT_KI); const float* WIb = (const float*)L1_PTR(ws, bb_, L1_WI, NAT_WI); bf16* AO = (bf16*)L1_PTR(ws, bb_, L1_AO, NAT_AO);
    const int lane0 = lane; if (wave >= 4) __builtin_amdgcn_s_setprio(1);
    const int b = bx & 7, jj = bx >> 3, nj = G >> 3;
    const size_t tokb = (size_t)b * SEQ;
    for (int i = 0; ; ++i) {
        const int qb = ((i & 1) ? (nj - 1 - jj) : jj) + nj * i;
        if (qb >= SEQ / 8) break;
        const int p0 = 8 * qb, nk16 = (p0 + 8 + 15) & ~15, NT = nk16 >> 4;
        const int rsb = (i & 1) * DS_ROWSET;
        if (mask & 1) {
            int lane = lane0; asm volatile("" : "+v"(lane));
            const int fr = lane & 15, fq = lane >> 4;
            pg8::bf16x8 QA[2][2][2];
#pragma unroll
            for (int grp = 0; grp < 2; ++grp)
#pragma unroll
                for (int hf = 0; hf < 2; ++hf)
#pragma unroll
                    for (int ks = 0; ks < 2; ++ks)
                        QA[grp][hf][ks] = *(const pg8::bf16x8*)(QIb + (tokb + p0 + 4 * grp + (fr >> 2)) * 512 + (4 * hf + (fr & 3)) * 64 + 32 * ks + 8 * fq);
            h16x2 wq[2][4];
#pragma unroll
            for (int grp = 0; grp < 2; ++grp) { const f32x4 w0 = *(const f32x4*)(WIb + (tokb + p0 + 4 * grp + fq) * 8), w1 = *(const f32x4*)(WIb + (tokb + p0 + 4 * grp + fq) * 8 + 4);
                wq[grp][0] = pkrtz(w0[0], w0[1]); wq[grp][1] = pkrtz(w0[2], w0[3]); wq[grp][2] = pkrtz(w1[0], w1[1]); wq[grp][3] = pkrtz(w1[2], w1[3]); }
            const int ntw = NT > wave ? (NT - wave + 7) >> 3 : 0, ng = (ntw + 3) >> 2;
            const char* kibase = (const char*)(KIb + tokb * 64);
            const unsigned koff = (unsigned)lane * 16u;
            const h16x2 hz = {(_Float16)0.f, (_Float16)0.f};
            pg8::bf16x8 ka[4][2], kb[4][2];
#define DS_A_LOAD(buf, g) do { _Pragma("unroll") for (int u_ = 0; u_ < 4; ++u_) { int kt_ = wave + 8 * (4 * (g) + u_); kt_ = kt_ < NT ? kt_ : NT - 1; const unsigned o_ = koff + (unsigned)kt_ * 2048u; \
                buf[u_][0] = *(const pg8::bf16x8*)(kibase + o_); buf[u_][1] = *(const pg8::bf16x8*)(kibase + o_ + 1024u); } } while (0)
#define DS_A_COMP(buf, g) do { f32x4 d_[4][2][2]; \
                _Pragma("unroll") for (int u_ = 0; u_ < 4; ++u_) _Pragma("unroll") for (int grp = 0; grp < 2; ++grp) _Pragma("unroll") for (int hf = 0; hf < 2; ++hf) { \
                    f32x4 z_ = (f32x4){0.f, 0.f, 0.f, 0.f}; z_ = __builtin_amdgcn_mfma_f32_16x16x32_bf16(QA[grp][hf][0], buf[u_][0], z_, 0, 0, 0); d_[u_][grp][hf] = __builtin_amdgcn_mfma_f32_16x16x32_bf16(QA[grp][hf][1], buf[u_][1], z_, 0, 0, 0); } \
                _Pragma("unroll") for (int u_ = 0; u_ < 4; ++u_) { const int kt_ = wave + 8 * (4 * (g) + u_); const int key_ = 16 * kt_ + fr; float s2_[2]; \
                    _Pragma("unroll") for (int grp = 0; grp < 2; ++grp) { float s_ = 0.f; \
                        _Pragma("unroll") for (int hf = 0; hf < 2; ++hf) { \
                            s_ = __builtin_amdgcn_fdot2(__builtin_elementwise_max(pkrtz(d_[u_][grp][hf][0], d_[u_][grp][hf][1]), hz), wq[grp][2 * hf], s_, false); \
                            s_ = __builtin_amdgcn_fdot2(__builtin_elementwise_max(pkrtz(d_[u_][grp][hf][2], d_[u_][grp][hf][3]), hz), wq[grp][2 * hf + 1], s_, false); } \
                        s2_[grp] = s_; } \
                      \
                    const unsigned t_ = __builtin_bit_cast(unsigned, pkrtz(s2_[0], s2_[1])); unsigned m_; \
                    asm("v_pk_ashrrev_i16 %0, %1, %2" : "=v"(m_) : "v"(0x000f000fu), "v"(t_)); \
                    const unsigned kk_ = (t_ ^ (m_ | 0x80008000u)) & ((key_ <= p0 + fq ? 0x0000ffffu : 0u) | (key_ <= p0 + 4 + fq ? 0xffff0000u : 0u)); \
                    if (kt_ < NT) { *(LAS unsigned short*)(lds + rsb + fq * DS_SCP + key_ * 2) = (unsigned short)kk_; *(LAS unsigned short*)(lds + rsb + (4 + fq) * DS_SCP + key_ * 2) = (unsigned short)(kk_ >> 16); } } } while (0)
            DS_A_LOAD(ka, 0);
            DS_A_LOAD(kb, 1);
            for (int g = 0; g < ng; g += 2) {
                DS_A_COMP(ka, g);
                DS_A_LOAD(ka, g + 2);
                if (g + 1 < ng) DS_A_COMP(kb, g + 1);
                DS_A_LOAD(kb, g + 3);
            }
#undef DS_A_LOAD
#undef DS_A_COMP
        }
        LDS_WAIT();
        __builtin_amdgcn_s_barrier(); asm volatile("" ::: "memory");
        const int p = p0 + wave, nvalid = p + 1;
        LAS unsigned* idx = (LAS unsigned*)(lds + DS_IDX + wave * 1024);
        int nsel = 1;
        if (!(mask & 2)) { }
        else if (nvalid <= TOPK) {
#pragma unroll
            for (int r = 0; r < 4; ++r) { const int s = lane0 + 64 * r; idx[s] = (unsigned)(s < nvalid ? s : 0) << 8; }
            nsel = nvalid;
        } else {
            int lane = lane0; asm volatile("" : "+v"(lane));
            const LAS unsigned char* row = lds + rsb + wave * DS_SCP;
            const int nit = (nk16 + 511) >> 9;
            unsigned kp[8][4];
#pragma unroll
            for (int it = 0; it < 8; ++it) { v4u v = (v4u){0u, 0u, 0u, 0u};
                if (it < nit) { const int e0 = it * 512 + lane * 8; if (e0 < nk16) v = *(const LAS v4u*)(row + e0 * 2); }
#pragma unroll
                for (int x = 0; x < 4; ++x) kp[it][x] = v[x]; }
            const unsigned h1w = DS_HIST + wave * 2048, h2w = h1w;
#pragma unroll
            for (int r = 0; r < 2; ++r) *(LAS v4u*)(lds + h1w + r * 1024 + lane * 16) = (v4u){0u, 0u, 0u, 0u};
            LDS_WAIT();
            const unsigned h1l = h1w + (unsigned)(lane & 3) * 512u;
#pragma unroll
            for (int it = 0; it < 8; ++it) if (it < nit) {
#pragma unroll
                for (int x = 0; x < 4; ++x) { const unsigned w = kp[it][x];
                    __hip_atomic_fetch_add((LAS unsigned*)(lds + h1l + ((w >> 6) & 0x1fcu)), 1u << ((w >> 11) & 16u), __ATOMIC_RELAXED, __HIP_MEMORY_SCOPE_WORKGROUP);
                    __hip_atomic_fetch_add((LAS unsigned*)(lds + h1l + ((w >> 22) & 0x1fcu)), 1u << ((w >> 27) & 16u), __ATOMIC_RELAXED, __HIP_MEMORY_SCOPE_WORKGROUP); } }
            LDS_WAIT();
            unsigned B1, above1, at1;
            { v4u ps = (v4u){0u, 0u, 0u, 0u};
#pragma unroll
              for (int r = 0; r < 4; ++r) ps += *(const LAS v4u*)(lds + h1w + r * 512 + (lane & 31) * 16);
              const unsigned sh = (lane >> 5) ? 16u : 0u;
              hist_find4((v4u){(ps.x >> sh) & 0xffffu, (ps.y >> sh) & 0xffffu, (ps.z >> sh) & 0xffffu, (ps.w >> sh) & 0xffffu}, (unsigned)TOPK, lane, B1, above1, at1); }
            LDS_WAIT();
#pragma unroll
            for (int r = 0; r < 2; ++r) *(LAS v4u*)(lds + h2w + r * 1024 + lane * 16) = (v4u){0u, 0u, 0u, 0u};
            LDS_WAIT();
            const unsigned need1 = (unsigned)TOPK - above1;
            const unsigned b1p = B1 * 0x01000100u;
#pragma unroll
            for (int it = 0; it < 8; ++it) if (it < nit) {
#pragma unroll
                for (int x = 0; x < 4; ++x) { const unsigned w = kp[it][x];
                    if (((w >> 8) & 0xffu) == B1) __hip_atomic_fetch_add((LAS unsigned*)(lds + h2w + ((w & 0xffu) << 2)), 1u, __ATOMIC_RELAXED, __HIP_MEMORY_SCOPE_WORKGROUP);
                    if ((w >> 24) == B1) __hip_atomic_fetch_add((LAS unsigned*)(lds + h2w + ((w >> 14) & 0x3fcu)), 1u, __ATOMIC_RELAXED, __HIP_MEMORY_SCOPE_WORKGROUP); } }
            LDS_WAIT();
            unsigned B2, above2, at2;
            hist_find4(*(const LAS v4u*)(lds + h2w + lane * 16), need1, lane, B2, above2, at2);
            const unsigned T = (B1 << 8) | B2, need_eq = need1 - above2;
            if (need_eq == at2) {
                unsigned a0 = 0u, a1 = 0u, a2 = 0u, a3 = 0u; const unsigned cm = (T - 1u) * 0x10001u;
#pragma unroll
                for (int it = 0; it < 8; ++it) if (it < nit) pk_count4(a0, a1, a2, a3, kp[it][0], kp[it][1], kp[it][2], kp[it][3], cm);
                const unsigned a_ = (a0 + a1) + (a2 + a3), cl = (a_ & 0xffffu) + (a_ >> 16);
                const unsigned inc = row_scan_u32(cl);
                const unsigned t0 = (unsigned)__builtin_amdgcn_readlane((int)inc, 15), t1 = (unsigned)__builtin_amdgcn_readlane((int)inc, 31), t2 = (unsigned)__builtin_amdgcn_readlane((int)inc, 47);
                const int rw = lane >> 4;
                unsigned pa = DS_IDX + wave * 1024 + 4u * ((rw > 0 ? t0 : 0u) + (rw > 1 ? t1 : 0u) + (rw > 2 ? t2 : 0u) + (inc - cl));
                const unsigned eb = (unsigned)lane * 2048u;
#pragma unroll
                for (int it = 0; it < 8; ++it) if (it < nit) {
#pragma unroll
                    for (int k = 0; k < 8; ++k) { const unsigned kk_ = (k & 1) ? (kp[it][k >> 1] >> 16) : (kp[it][k >> 1] & 0xffffu);
                        if (kk_ >= T) { *(LAS unsigned*)(lds + pa) = eb + (unsigned)((it * 512 + k) << 8); pa += 4u; } } }
            } else {
                unsigned cnt = 0u, eqc = 0u;
#pragma unroll
                for (int it = 0; it < 8; ++it) if (it < nit) {
                    unsigned gtm = 0u, eqm = 0u;
#pragma unroll
                    for (int k = 0; k < 8; ++k) { const unsigned kk_ = (k & 1) ? (kp[it][k >> 1] >> 16) : (kp[it][k >> 1] & 0xffffu); gtm |= (kk_ > T) ? (1u << k) : 0u; eqm |= (kk_ == T) ? (1u << k) : 0u; }
                    unsigned selm = gtm;
                    if (__ballot(eqm != 0u)) { unsigned pre, tot; wave_prefix4((unsigned)__popc(eqm), pre, tot); unsigned run = eqc + pre;
#pragma unroll
                        for (int k = 0; k < 8; ++k) if ((eqm >> k) & 1u) { if (run < need_eq) selm |= (1u << k); ++run; }
                        eqc += tot; }
                    if (__ballot(selm != 0u)) { unsigned pre, tot; wave_prefix4((unsigned)__popc(selm), pre, tot); unsigned pos = cnt + pre; const int e0 = it * 512 + lane * 8;
#pragma unroll
                        for (int k = 0; k < 8; ++k) if ((selm >> k) & 1u) { idx[pos & 255u] = (unsigned)(e0 + k) << 8; ++pos; }
                        cnt += tot; }
                }
            }
            nsel = TOPK;
        }
        LDS_WAIT();
        if (mask & 4) {
            int lane = lane0; asm volatile("" : "+v"(lane));
            const int fr = lane & 15, fq = lane >> 4;
            const unsigned kbn = (unsigned)rsb + wave * DS_SCP, vbn = kbn;
            const pg8::bf16x8 q0 = *(const pg8::bf16x8*)(Qb + (tokb + p) * DM + fr * 64 + 8 * fq), q1 = *(const pg8::bf16x8*)(Qb + (tokb + p) * DM + fr * 64 + 32 + 8 * fq);
            const char* kvbase = (const char*)(KVb + tokb * 128);
            const int gr = lane >> 3, gc = lane & 7;
#define DS_ROFF(g_, ro_) do { const v4u i0_ = *(const LAS v4u*)((const LAS unsigned char*)idx + (64 * (g_) + 8 * gr) * 4), i1_ = *(const LAS v4u*)((const LAS unsigned char*)idx + (64 * (g_) + 8 * gr) * 4 + 16); \
                _Pragma("unroll") for (int j = 0; j < 4; ++j) { ro_[j] = i0_[j] + (unsigned)gc * 16u; ro_[4 + j] = i1_[j] + (unsigned)gc * 16u; } } while (0)
            v4u kreg[3][8], vreg[4][8];
#pragma unroll
            for (int g = 0; g < 3; ++g) { unsigned ro[8]; DS_ROFF(g, ro);
#pragma unroll
                for (int j = 0; j < 8; ++j) kreg[g][j] = *(const v4u*)(kvbase + ro[j]); }
            pg8::bf16x8 pf[8];
            const unsigned kfr = kbn + fr * 128;
            const int ksw = (fr >> 1) & 7;
#pragma unroll
            for (int g = 0; g < 4; ++g) {
                asm volatile("s_waitcnt lgkmcnt(0)" ::: "memory");
#pragma unroll
                for (int j = 0; j < 8; ++j) { const int rl = 8 * j + gr; *(LAS v4u*)(lds + kbn + rl * 128 + ((gc ^ ((rl >> 1) & 7)) << 4)) = kreg[g == 3 ? 0 : g][j]; }
                asm volatile("s_waitcnt lgkmcnt(0)" ::: "memory");
                f32x4 pt[4];
#pragma unroll
                for (int tt = 0; tt < 4; ++tt) {
                    const pg8::bf16x8 k0 = *(const LAS pg8::bf16x8*)(lds + kfr + tt * 2048 + ((fq ^ ksw) << 4)), k1 = *(const LAS pg8::bf16x8*)(lds + kfr + tt * 2048 + (((4 + fq) ^ ksw) << 4));
                    f32x4 d = (f32x4){0.f, 0.f, 0.f, 0.f};
                    d = __builtin_amdgcn_mfma_f32_16x16x32_bf16(k0, q0, d, 0, 0, 0); pt[tt] = __builtin_amdgcn_mfma_f32_16x16x32_bf16(k1, q1, d, 0, 0, 0); }
#pragma unroll
                for (int tt = 0; tt < 4; ++tt) {
#pragma unroll
                    for (int r = 0; r < 4; ++r) pt[tt][r] = __builtin_amdgcn_exp2f(pt[tt][r]);
                    if (nsel < TOPK) {
#pragma unroll
                        for (int r = 0; r < 4; ++r) { const int rl = 16 * tt + 4 * fq + r; if (64 * g + 8 * (rl & 7) + (rl >> 3) >= nsel) pt[tt][r] = 0.f; } } }
#pragma unroll
                for (int h2 = 0; h2 < 2; ++h2) { v4u w; w.x = pg8::cvt_pk_bf16(pt[2 * h2][0], pt[2 * h2][1]); w.y = pg8::cvt_pk_bf16(pt[2 * h2][2], pt[2 * h2][3]);
                    w.z = pg8::cvt_pk_bf16(pt[2 * h2 + 1][0], pt[2 * h2 + 1][1]); w.w = pg8::cvt_pk_bf16(pt[2 * h2 + 1][2], pt[2 * h2 + 1][3]); pf[2 * g + h2] = __builtin_bit_cast(pg8::bf16x8, w); }
                if (g == 0) { unsigned ro[8]; DS_ROFF(3, ro);
#pragma unroll
                    for (int j = 0; j < 8; ++j) kreg[0][j] = *(const v4u*)(kvbase + ro[j]); }
                else { unsigned ro[8]; DS_ROFF(g - 1, ro);
#pragma unroll
                  for (int j = 0; j < 8; ++j) vreg[g - 1][j] = *(const v4u*)(kvbase + ro[j] + 128u); }
            }
            f32x4 o[4], osum = (f32x4){0.f, 0.f, 0.f, 0.f};
#pragma unroll
            for (int dt = 0; dt < 4; ++dt) o[dt] = (f32x4){0.f, 0.f, 0.f, 0.f};
            pg8::bf16x8 ones;
#pragma unroll
            for (int e = 0; e < 8; ++e) ones[e] = (short)0x3f80;
            const int trow = 4 * fq + (fr >> 2), tsw = (trow >> 1) & 3;
            const unsigned tbase = vbn + trow * 128 + (fr & 3) * 8;
#pragma unroll
            for (int g = 0; g < 4; ++g) {
                asm volatile("s_waitcnt lgkmcnt(0)" ::: "memory");
#pragma unroll
                for (int j = 0; j < 8; ++j) { const int rl = 8 * j + gr; *(LAS v4u*)(lds + vbn + rl * 128 + (((((gc >> 1) ^ ((rl >> 1) & 3)) << 1) | (gc & 1)) << 4)) = vreg[g][j]; }
                if (g == 0) { unsigned ro[8]; DS_ROFF(3, ro);
#pragma unroll
                    for (int j = 0; j < 8; ++j) vreg[3][j] = *(const v4u*)(kvbase + ro[j] + 128u); }
                asm volatile("s_waitcnt lgkmcnt(0)" ::: "memory");
#pragma unroll
                for (int s2l = 0; s2l < 2; ++s2l) {
#pragma unroll
                    for (int dt = 0; dt < 4; ++dt) { const unsigned a0 = tbase + s2l * 4096 + ((dt ^ tsw) << 5);
                        const s16x4v lo = __builtin_bit_cast(s16x4v, __builtin_amdgcn_ds_read_tr16_b64_v4i16((LAS s16x4v*)(lds + a0)));
                        const s16x4v hi = __builtin_bit_cast(s16x4v, __builtin_amdgcn_ds_read_tr16_b64_v4i16((LAS s16x4v*)(lds + a0 + 2048)));
                        const pg8::bf16x8 vf = __builtin_shufflevector(lo, hi, 0, 1, 2, 3, 4, 5, 6, 7);
                        o[dt] = __builtin_amdgcn_mfma_f32_16x16x32_bf16(vf, pf[2 * g + s2l], o[dt], 0, 0, 0); }
                    osum = __builtin_amdgcn_mfma_f32_16x16x32_bf16(ones, pf[2 * g + s2l], osum, 0, 0, 0);
                }
            }
#undef DS_ROFF
            const float rinv = 1.f / osum[0];
            bf16* op = AO + (tokb + p) * DM + fr * 64 + 4 * fq;
#pragma unroll
            for (int dt = 0; dt < 4; ++dt) { u32x2v w; w.x = pg8::cvt_pk_bf16(o[dt][0] * rinv, o[dt][1] * rinv); w.y = pg8::cvt_pk_bf16(o[dt][2] * rinv, o[dt][3] * rinv); *(u32x2v*)(op + 16 * dt) = w; }
        }
    }
    __builtin_amdgcn_s_setprio(0);
}

struct Args { const float* in[21]; float* out; unsigned char* ws; RopeInv rinv; int ph_lo, ph_hi, dsa_mask, pad; };
static_assert(sizeof(Args) == 21 * 8 + 8 + 8 + 128 + 16, "Args has no padding");

__global__ void __launch_bounds__(NTHREADS, 2) mk_fwd(Args args) {
    extern __shared__ __attribute__((aligned(16))) unsigned char lds_raw[];
    LAS unsigned char* lds = (LAS unsigned char*)lds_raw;
    const int tid = threadIdx.x, lane = tid & 63, wave = __builtin_amdgcn_readfirstlane(tid >> 6);
    const int G = gridDim.x, bx = blockIdx.x;
    const int vcu = (G % 8 == 0) ? (bx % 8) * (G / 8) + bx / 8 : bx;
    unsigned char* ws = args.ws;
    volatile LAS unsigned* MISC = (volatile LAS unsigned*)(lds + MISC_OFF);
    if (tid < 64) MISC[tid] = 0u;
    __syncthreads();
    const int lo = args.ph_lo, hi = args.ph_hi;
    XcdBarrier bar; bar.bar = (unsigned*)(ws + WS_CTL) + CW_BAR; bar.x = 0; bar.st = nullptr;
    if (hi - lo > 1) { bar = xcd_barrier_post((unsigned*)(ws + WS_CTL) + CW_BAR, MISC + 8);
        if (tid == 0) __hip_atomic_store((unsigned*)(ws + WS_CTL) + CW_XTAB + bx, bar.x + 1u, __ATOMIC_RELAXED, __HIP_MEMORY_SCOPE_AGENT); }
#define IN(k) (lo <= (k) && (k) < hi)
#define SEAM(k) do { if (IN(k) && IN((k) + 1)) xcd_barrier(bar); } while (0)
#define GSEAM(k) do { if (IN(k) && IN((k) + 1)) { if (G == 256) grp_barrier(bar.bar, (unsigned*)(ws + WS_CTL) + CW_XTAB, (unsigned*)(ws + WS_CTL) + CW_GRP, MISC + 12, bx); else xcd_barrier(bar); } } while (0)
    const float* mod = (const float*)(ws + WS_MOD);
    bf16* H = (bf16*)(ws + WS_H);
    const float* x_in = args.in[0]; float* xo = args.out;
    bf16* XR = (bf16*)(ws + WS_XR);

    if (IN(0)) { phase_prep<0>(args.in, ws, lds, args.rinv, tid, lane, wave, bx, G); } SEAM(0);
    if (IN(1)) { phase_norm<false>(x_in, args.in[2], mod + 0 * DM, mod + 1 * DM, H, lane, wave, vcu, G); phase_prep<1>(args.in, ws, lds, args.rinv, tid, lane, wave, bx, G); } SEAM(1);
    if (IN(2)) { pg8::Gemm g{H, (const bf16*)(ws + WS_WAIN), MTOK, 2 * DRNN, DM}; pg8::StaticOrder S; S.init(MTOK, 2 * DRNN, G, bx);
        pg8::EpiXbGate E{(bf16*)L1_PTR(ws, bx & 7, L0_XB, NAT_L0), (bf16*)L1_PTR(ws, bx & 7, L0_GATE, NAT_L0)};
        pg8::gemm_phase<pg8::EpiXbGate, pg8::StaticOrder, true, true>(lds, g, S, E); } GSEAM(2);
    if (IN(3)) { if (bx < 160) phase_rglru(args.in, ws, lds, tid, lane, wave, bx);
        else { phase_prep<2>(args.in, ws, lds, args.rinv, tid, lane, wave, bx - 160, G - 160);
            asm volatile("s_waitcnt vmcnt(0)" ::: "memory"); __syncthreads();
            if (tid == 0) { __builtin_amdgcn_fence(__ATOMIC_RELEASE, "agent"); asm volatile("s_waitcnt vmcnt(0)" ::: "memory"); __hip_atomic_fetch_add((unsigned*)(ws + WS_CTL) + CW_PREP2, 1u, __ATOMIC_RELAXED, __HIP_MEMORY_SCOPE_AGENT); } }
        __syncthreads();
        pg8::Gemm g{(const bf16*)L1_PTR(ws, bx & 7, L0_Y, NAT_L0), (const bf16*)(ws + WS_WAOUT), MTOK, DM, DRNN};
        pg8::FlowOrder S; S.rdy = (const unsigned*)(ws + WS_CTL) + CW_RDY;
        S.b = bx & 7;
        if (bx < 160) { S.y = bx >> 3; S.t0 = 44; S.tlim = 64; S.nround = 1; } else { S.y = (bx - 160) >> 3; S.t0 = 0; S.tlim = 44; S.nround = 4; }
        pg8::EpiRes<false, true> E{x_in, XR, mod + 2 * DM};
        pg8::gemm_phase<pg8::EpiRes<false, true>, pg8::FlowOrder, true, true>(lds, g, S, E); } GSEAM(3);
    if (IN(5)) { phase_norm<true>(XR, args.in[3], mod + 3 * DM, mod + 4 * DM, H, lane, wave, vcu, G);
        if (IN(3) && G == 256 && tid == 0) { unsigned* pc = (unsigned*)(ws + WS_CTL) + CW_PREP2;
            for (unsigned sp = 0; __hip_atomic_load(pc, __ATOMIC_RELAXED, __HIP_MEMORY_SCOPE_AGENT) < (unsigned)(G - 160) && sp < (1u << 22); ++sp) __builtin_amdgcn_s_sleep(4); } } GSEAM(5);
    if (IN(6)) { pg8::Gemm g{H, (const bf16*)(ws + WS_W1), MTOK, DFF, DM}; pg8::StaticOrder S; S.init(MTOK, DFF, G, bx);
        pg8::EpiRelu2 E{(bf16*)(ws + WS_BIG)};
        pg8::gemm_phase<pg8::EpiRelu2, pg8::StaticOrder, true, true>(lds, g, S, E); } GSEAM(6);
    if (IN(7)) { pg8::Gemm g{(const bf16*)(ws + WS_BIG), (const bf16*)(ws + WS_W2), MTOK, DM, DFF, 1, 1}; pg8::StaticOrder S; S.init(MTOK, DM, G, bx);
        pg8::EpiRes<true, true> E{XR, XR, mod + 5 * DM};
        pg8::gemm_phase<pg8::EpiRes<true, true>, pg8::StaticOrder, true, true>(lds, g, S, E); } GSEAM(7);
    const float* mod1 = mod + NB * NMOD;
    if (IN(8)) { phase_norm<true>(XR, args.in[2] + DM, mod1 + 0 * DM, mod1 + 1 * DM, H, lane, wave, vcu, G); } GSEAM(8);
    if (IN(9)) { pg8::Gemm g{H, (const bf16*)(ws + WS_WBIN), MTOK, BINP, DM}; pg8::StaticOrder S; S.init(MTOK, BINP, G, bx);
        const int xb = bx & 7;
        pg8::EpiIn1 E{(bf16*)L1_PTR(ws, xb, L1_Q, NAT_Q), (bf16*)L1_PTR(ws, xb, L1_QI, NAT_QI), (bf16*)L1_PTR(ws, xb, L1_KV, NAT_KV), (bf16*)L1_PTR(ws, xb, L1_KV, NAT_KV) + 64, (bf16*)L1_PTR(ws, xb, L1_KI, NAT_KI), (float*)L1_PTR(ws, xb, L1_WI, NAT_WI), (const float*)(ws + WS_ROPE), args.in[16], args.in[17]};
        pg8::gemm_phase<pg8::EpiIn1, pg8::StaticOrder, true, true>(lds, g, S, E); } GSEAM(9);
    if (IN(10)) { phase_dsa(ws, lds, tid, lane, wave, bx, G, args.dsa_mask); } GSEAM(10);
    if (IN(11)) { pg8::Gemm g{(const bf16*)L1_PTR(ws, bx & 7, L1_AO, NAT_AO), (const bf16*)(ws + WS_WBOUT), MTOK, DM, DM}; pg8::StaticOrder S; S.init(MTOK, DM, G, bx);
        pg8::EpiRes<true, true> E{XR, XR, mod1 + 2 * DM};
        pg8::gemm_phase<pg8::EpiRes<true, true>, pg8::StaticOrder, true, true>(lds, g, S, E); } GSEAM(11);
    if (IN(12)) { phase_norm<true>(XR, args.in[3] + DM, mod1 + 3 * DM, mod1 + 4 * DM, H, lane, wave, vcu, G); } GSEAM(12);
    if (IN(13)) { pg8::Gemm g{H, (const bf16*)(ws + WS_W1) + (size_t)DFF * DM, MTOK, DFF, DM}; pg8::StaticOrder S; S.init(MTOK, DFF, G, bx);
        pg8::EpiRelu2 E{(bf16*)(ws + WS_BIG)};
        pg8::gemm_phase<pg8::EpiRelu2, pg8::StaticOrder, true, true>(lds, g, S, E); } GSEAM(13);
    if (IN(14)) { pg8::Gemm g{(const bf16*)(ws + WS_BIG), (const bf16*)(ws + WS_W2) + (size_t)DM * DFF, MTOK, DM, DFF, 1, 1}; pg8::StaticOrder S; S.init(MTOK, DM, G, bx);
        pg8::EpiRes<true, false> E{XR, xo, mod1 + 5 * DM};
        pg8::gemm_phase<pg8::EpiRes<true, false>, pg8::StaticOrder, true, true>(lds, g, S, E); }
#undef IN
#undef SEAM
#undef GSEAM
}

extern "C" void kernel_launch(void* const* d_in, const int* in_sizes, int n_in, void* d_out, int out_size, void* d_ws, size_t ws_size, hipStream_t stream) {
    static int grid = 0;
    if (grid == 0) {
        if (n_in != 21 || in_sizes[0] != MTOK * DM || out_size != MTOK * DM || ws_size < WS_END) {
            fprintf(stderr, "kernel_launch: unexpected shapes: n_in %d in0 %d out %d ws %zu (need >= %zu); nothing launched\n", n_in, n_in > 0 ? in_sizes[0] : -1, out_size, ws_size, (size_t)WS_END); grid = -1; return; }
        int dev = 0, cus = 0, per_cu = 0;
        if (hipGetDevice(&dev) != hipSuccess || hipDeviceGetAttribute(&cus, hipDeviceAttributeMultiprocessorCount, dev) != hipSuccess) { fprintf(stderr, "kernel_launch: device query failed\n"); grid = -1; return; }
        if (hipFuncSetAttribute((const void*)mk_fwd, hipFuncAttributeMaxDynamicSharedMemorySize, LDS_BYTES) != hipSuccess) { fprintf(stderr, "kernel_launch: hipFuncSetAttribute(%d B LDS) failed\n", LDS_BYTES); grid = -1; return; }
        if (hipOccupancyMaxActiveBlocksPerMultiprocessor(&per_cu, (const void*)mk_fwd, NTHREADS, LDS_BYTES) != hipSuccess || per_cu < 1)
            fprintf(stderr, "kernel_launch: note: occupancy query reports %d workgroups per CU\n", per_cu);
        (void)hipGetLastError();
        grid = cus;
    }
    if (grid < 0) return;
    if (hipMemsetAsync((char*)d_ws + WS_CTL, 0, CTL_ZERO_BYTES, stream) != hipSuccess) { fprintf(stderr, "kernel_launch: memset failed\n"); return; }
    Args a{};
    for (int i = 0; i < 21; ++i) a.in[i] = (const float*)d_in[i];
    a.out = (float*)d_out; a.ws = (unsigned char*)d_ws; a.dsa_mask = 7;
    for (int i = 0; i < 32; ++i) a.rinv.v[i] = powf(10000.0f, -(float)(2 * i) / 64.0f);
    for (int li = 0; li < N_LAUNCHES; ++li) {
        if (N_LAUNCHES == 1) { a.ph_lo = 0; a.ph_hi = N_PHASES; } else { a.ph_lo = li; a.ph_hi = li + 1; }
        const int reps = (N_LAUNCHES != 1 && li == PROBE_PH) ? PROBE_N : 1;
        for (int r = 0; r < reps; ++r) {
            a.dsa_mask = (r + 1 < reps) ? PROBE_MASK : 7;
            hipLaunchKernelGGL(mk_fwd, dim3(grid), dim3(NTHREADS), LDS_BYTES, stream, a);
            const hipError_t le = hipPeekAtLastError();
            if (le != hipSuccess) { fprintf(stderr, "kernel_launch: launch %d failed: %s\n", li, hipGetErrorName(le)); break; }
        }
    }
}
```
